# Optimizing an MI355X kernel written in HIP

```python
import numpy as np
import jax
import jax.numpy as jnp
from jax import lax

D_MODEL = 4096
BATCH = 4
SEQ = 4096
DEPTH = 2

GRID_W = 64
N_BRANCH = 3
BRANCH_WIDTH = D_MODEL // 2
SHORT_CONV_K = 3
NA_HEAD_DIM = 128
NA_HEADS = BRANCH_WIDTH // NA_HEAD_DIM
NA_WIDTH = NA_HEADS * NA_HEAD_DIM
NA_WIN_ROWS = 8
NA_WIN_COLS = 16
NA_QBLOCK_COLS = 16
GLA_HEADS = 4
GLA_VALUE_WIDTH = BRANCH_WIDTH
GLA_KEY_WIDTH = BRANCH_WIDTH // 2
GLA_KEY_DIM = GLA_KEY_WIDTH // GLA_HEADS
GLA_VALUE_DIM = GLA_VALUE_WIDTH // GLA_HEADS
GLA_GATE_RANK = 16
GLA_GATE_TAU = 16.0
GLA_CHUNK = 64
D_FF = 256 * ((8 * D_MODEL // 3 + 255) // 256)
FFN_CONV_K = 3
LN_EPS = 1e-5
RMS_EPS = 1e-6
NEG_INF = -1e30
DEEPNORM_ALPHA = (2.0 * DEPTH) ** 0.25
DEEPNORM_BETA = (8.0 * DEPTH) ** -0.25
IN_SPLIT_SIZES = (
    BRANCH_WIDTH, BRANCH_WIDTH, BRANCH_WIDTH,
    NA_WIDTH, NA_WIDTH, NA_WIDTH,
    GLA_KEY_WIDTH, GLA_KEY_WIDTH,
    GLA_VALUE_WIDTH, GLA_VALUE_WIDTH,
    2 * GLA_GATE_RANK,
    N_BRANCH * D_MODEL,
)
IN_SPLIT_POINTS = tuple(int(p) for p in np.cumsum(IN_SPLIT_SIZES)[:-1])
IN_WIDTH = int(sum(IN_SPLIT_SIZES))
IN_VALUE_SEGMENTS = (2, 5, 8)

kernel_name = "hybrid_conv_natten_gla_encoder"


def layer_norm(x, g, b):
    xf = x.astype(jnp.float32)
    mu = jnp.mean(xf, axis=-1, keepdims=True)
    xc = xf - mu
    var = jnp.mean(xc * xc, axis=-1, keepdims=True)
    return (xc * lax.rsqrt(var + LN_EPS) * g.astype(jnp.float32) + b.astype(jnp.float32)).astype(x.dtype)


def dwconv_centred(x, w):
    k = w.shape[0]
    pad = k // 2
    s = x.shape[1]
    xp = jnp.pad(x, ((0, 0), (pad, pad), (0, 0)))
    return sum(xp[:, i:i + s] * w[i] for i in range(k))


def short_conv_mixer(gate_b, gate_c, h, w_conv):
    return gate_b * dwconv_centred(gate_c * h, w_conv)


def _band_indices(length, win, qblock):
    kblock = min(qblock + win - 1, length)
    nblk = length // qblock
    q_pos = np.arange(nblk)[:, None] * qblock + np.arange(qblock)[None, :]
    k_start = np.clip(np.arange(nblk) * qblock - win // 2, 0, length - kblock)
    k_pos = k_start[:, None] + np.arange(kblock)[None, :]
    w_start = np.clip(q_pos - win // 2, 0, length - win)
    rel = k_pos[:, None, :] - q_pos[:, :, None]
    valid = (k_pos[:, None, :] >= w_start[..., None]) & (k_pos[:, None, :] < w_start[..., None] + win)
    return k_pos, rel, valid


def neighbourhood_attention(q, k, v, rpb):
    bsz, s, nh, dh = q.shape
    rows = s // GRID_W
    win_r = min(NA_WIN_ROWS, rows)
    qb_r = max(d for d in range(1, win_r + 1) if rows % d == 0)
    rk, rrel, rvalid = _band_indices(rows, win_r, qb_r)
    ck, crel, cvalid = _band_indices(GRID_W, NA_WIN_COLS, NA_QBLOCK_COLS)
    nr, qr, kr = rrel.shape
    nc, qc, kc = crel.shape
    qg = q.reshape(bsz, nr, qr, nc, qc, nh, dh)
    ridx = rk[:, :, None, None]
    cidx = ck[None, None, :, :]
    kb = k.reshape(bsz, rows, GRID_W, nh, dh)[:, ridx, cidx]
    vb = v.reshape(bsz, rows, GRID_W, nh, dh)[:, ridx, cidx]
    scores = jnp.einsum('bnqmphd,bnkmjhd->bhnmqpkj', qg, kb,
                        preferred_element_type=jnp.float32) * (dh ** -0.5)
    ri = np.clip(rrel + NA_WIN_ROWS - 1, 0, 2 * NA_WIN_ROWS - 2)[:, None, :, None, :, None]
    ci = np.clip(crel + NA_WIN_COLS - 1, 0, 2 * NA_WIN_COLS - 2)[None, :, None, :, None, :]
    bias = rpb[:, ri, ci].astype(jnp.float32)
    mask = rvalid[:, None, :, None, :, None] & cvalid[None, :, None, :, None, :]
    scores = jnp.where(mask, scores + bias[None], NEG_INF)
    probs = jax.nn.softmax(scores, axis=(-2, -1)).astype(v.dtype)
    out = jnp.einsum('bhnmqpkj,bnkmjhd->bnqmphd', probs, vb)
    return out.reshape(bsz, s, nh * dh)


def gla_chunked(q, k, v, log_a):
    bsz, s, nh, dk = q.shape
    dv = v.shape[-1]
    n = s // GLA_CHUNK
    q, k, log_a = (t.reshape(bsz, n, GLA_CHUNK, nh, dk) for t in (q, k, log_a))
    v = v.reshape(bsz, n, GLA_CHUNK, nh, dv)
    cum = jnp.cumsum(log_a, axis=2)
    last = cum[:, :, -1:]
    q_in = q * jnp.exp(cum)
    k_in = k * jnp.exp(-cum)
    k_out = k * jnp.exp(last - cum)
    tri = np.tril(np.ones((GLA_CHUNK, GLA_CHUNK), dtype=bool))
    att = jnp.where(tri, jnp.einsum('bnihd,bnjhd->bnhij', q_in, k_in), 0.0)
    o_intra = jnp.einsum('bnhij,bnjhe->bnihe', att, v)

    def step(state, xs):
        qc, kc, vc, dec = xs
        o = jnp.einsum('bihd,bhde->bihe', qc, state)
        state = state * dec[..., None] + jnp.einsum('bjhd,bjhe->bhde', kc, vc)
        return state, o

    xs = (jnp.moveaxis(q_in, 1, 0), jnp.moveaxis(k_out, 1, 0), jnp.moveaxis(v, 1, 0),
          jnp.moveaxis(jnp.exp(last[:, :, 0]), 1, 0))
    _, o_inter = lax.scan(step, jnp.zeros((bsz, nh, dk, dv), jnp.float32), xs)
    return (o_intra + jnp.moveaxis(o_inter, 0, 1)).reshape(bsz, s, nh, dv)


def gla_mixer(q, k, v, r, a_lr, w_decay, b_decay, norm_g):
    bsz, s, _ = q.shape
    f32 = jnp.float32
    qh = q.astype(f32).reshape(bsz, s, GLA_HEADS, GLA_KEY_DIM) * (GLA_KEY_DIM ** -0.5)
    kh = k.astype(f32).reshape(bsz, s, GLA_HEADS, GLA_KEY_DIM)
    vh = v.astype(f32).reshape(bsz, s, GLA_HEADS, GLA_VALUE_DIM)
    z = jnp.einsum('bsgr,grk->bsgk', a_lr.reshape(bsz, s, 2, GLA_GATE_RANK), w_decay) + b_decay
    log_a = (jax.nn.log_sigmoid(z.astype(f32)) / GLA_GATE_TAU).reshape(bsz, s, 2, GLA_HEADS, GLA_KEY_DIM)
    o_fwd = gla_chunked(qh, kh, vh, log_a[:, :, 0])
    o_bwd = jnp.flip(gla_chunked(jnp.flip(qh, 1), jnp.flip(kh, 1), jnp.flip(vh, 1),
                                 jnp.flip(log_a[:, :, 1], 1)), 1)
    o = o_fwd + o_bwd
    o = o * lax.rsqrt(jnp.mean(o * o, axis=-1, keepdims=True) + RMS_EPS)
    o = o.reshape(bsz, s, GLA_VALUE_WIDTH) * norm_g.astype(f32)
    return (o * jax.nn.silu(r.astype(f32))).astype(q.dtype)


def conv_glu_ffn(x, w_in, w_conv, b_conv, w_out):
    a, u = jnp.split(x @ w_in, 2, axis=-1)
    a = dwconv_centred(a, w_conv) + b_conv
    return (jax.nn.gelu(a, approximate=False) * u) @ w_out


def setup_inputs(seed: int = 0) -> dict:
    key = jax.random.key(seed)
    ks = jax.random.split(key, 20)
    d = D_MODEL
    nrm = jax.random.normal
    col_scale = np.ones((IN_WIDTH,), dtype=np.float32)
    starts = (0,) + IN_SPLIT_POINTS
    for seg in IN_VALUE_SEGMENTS:
        col_scale[starts[seg]:starts[seg] + IN_SPLIT_SIZES[seg]] = DEEPNORM_BETA
    ffn_scale = np.concatenate([np.ones((D_FF,), np.float32),
                                np.full((D_FF,), DEEPNORM_BETA, np.float32)])
    return {
        "x": nrm(ks[0], (BATCH, SEQ, d), jnp.float32),
        "w_in": nrm(ks[1], (DEPTH, d, IN_WIDTH), jnp.float32) * (col_scale * d ** -0.5),
        "b_gate": 0.1 * nrm(ks[2], (DEPTH, N_BRANCH * d), jnp.float32),
        "w_short_conv": nrm(ks[3], (DEPTH, SHORT_CONV_K, BRANCH_WIDTH), jnp.float32) * SHORT_CONV_K ** -0.5,
        "na_rpb": 0.1 * nrm(ks[4], (DEPTH, NA_HEADS, 2 * NA_WIN_ROWS - 1, 2 * NA_WIN_COLS - 1), jnp.float32),
        "gla_w_decay": nrm(ks[5], (DEPTH, 2, GLA_GATE_RANK, GLA_KEY_WIDTH), jnp.float32) * GLA_GATE_RANK ** -0.5,
        "gla_b_decay": 0.1 * nrm(ks[6], (DEPTH, 2, GLA_KEY_WIDTH), jnp.float32),
        "gla_norm_g": 1.0 + 0.02 * nrm(ks[7], (DEPTH, GLA_VALUE_WIDTH), jnp.float32),
        "w_branch": nrm(ks[8], (DEPTH, N_BRANCH, BRANCH_WIDTH, d), jnp.float32) * BRANCH_WIDTH ** -0.5,
        "w_out": nrm(ks[9], (DEPTH, d, d), jnp.float32) * (DEEPNORM_BETA * d ** -0.5),
        "ln1_g": 1.0 + 0.02 * nrm(ks[10], (DEPTH, d), jnp.float32),
        "ln1_b": 0.02 * nrm(ks[11], (DEPTH, d), jnp.float32),
        "w_ffn_in": nrm(ks[12], (DEPTH, d, 2 * D_FF), jnp.float32) * (ffn_scale * d ** -0.5),
        "w_ffn_conv": nrm(ks[13], (DEPTH, FFN_CONV_K, D_FF), jnp.float32) * FFN_CONV_K ** -0.5,
        "b_ffn_conv": 0.02 * nrm(ks[14], (DEPTH, D_FF), jnp.float32),
        "w_ffn_out": nrm(ks[15], (DEPTH, D_FF, d), jnp.float32) * (DEEPNORM_BETA * D_FF ** -0.5),
        "ln2_g": 1.0 + 0.02 * nrm(ks[16], (DEPTH, d), jnp.float32),
        "ln2_b": 0.02 * nrm(ks[17], (DEPTH, d), jnp.float32),
    }


def reference(x, w_in, b_gate, w_short_conv, na_rpb, gla_w_decay, gla_b_decay, gla_norm_g,
              w_branch, w_out, ln1_g, ln1_b, w_ffn_in, w_ffn_conv, b_ffn_conv, w_ffn_out,
              ln2_g, ln2_b):
    bsz, s, d = x.shape
    for l in range(DEPTH):
        h = x @ w_in[l]
        (c_b, c_c, c_h, na_q, na_k, na_v, g_q, g_k, g_v, g_r, g_a, gate_lin) = jnp.split(
            h, IN_SPLIT_POINTS, axis=-1)
        y_conv = short_conv_mixer(c_b, c_c, c_h, w_short_conv[l])
        y_na = neighbourhood_attention(
            na_q.reshape(bsz, s, NA_HEADS, NA_HEAD_DIM),
            na_k.reshape(bsz, s, NA_HEADS, NA_HEAD_DIM),
            na_v.reshape(bsz, s, NA_HEADS, NA_HEAD_DIM), na_rpb[l])
        y_gla = gla_mixer(g_q, g_k, g_v, g_r, g_a, gla_w_decay[l], gla_b_decay[l], gla_norm_g[l])
        gates = jax.nn.sigmoid((gate_lin + b_gate[l]).reshape(bsz, s, N_BRANCH, d))
        mixed = (gates[:, :, 0] * (y_conv @ w_branch[l, 0])
                 + gates[:, :, 1] * (y_na @ w_branch[l, 1])
                 + gates[:, :, 2] * (y_gla @ w_branch[l, 2]))
        x = layer_norm(DEEPNORM_ALPHA * x + mixed @ w_out[l], ln1_g[l], ln1_b[l])
        f = conv_glu_ffn(x, w_ffn_in[l], w_ffn_conv[l], b_ffn_conv[l], w_ffn_out[l])
        x = layer_norm(DEEPNORM_ALPHA * x + f, ln2_g[l], ln2_b[l])
    return x
```

```cpp
#include <hip/hip_runtime.h>
#include <cstdio>
#include <cstdint>
namespace pg8 {
#define PG8_LAS __attribute__((address_space(3)))
typedef unsigned short bf16_t;
typedef short bf16x8 __attribute__((ext_vector_type(8)));
typedef float f32x4 __attribute__((ext_vector_type(4)));
typedef unsigned u32x4 __attribute__((ext_vector_type(4)));
constexpr int BM = 256, BK = 64, HALF = 128, HTB = HALF * BK * 2  , STAGE_BYTES = 8 * HTB, NXCD = 8, WGM = 8;

__host__ __device__ __forceinline__ int lds_byte(int r, int c) { const int st = (r >> 4) * 2 + (c >> 5), rr = r & 15, cc = c & 31, ob = rr * 64 + cc * 2; return st * 1024 + (ob ^ (((ob >> 9) & 1) << 5)); }
__host__ __device__ __forceinline__ void stage_rc(int b, int& R, int& C) { const int st = b / 1024, sb = b % 1024, swz = sb ^ (((sb >> 9) & 1) << 5); R = (st >> 1) * 16 + swz / 64; C = (st & 1) * 32 + (swz % 64) / 2; }
__host__ __device__ __forceinline__ int perm32(int rho) { const int n = rho >> 4, i = rho & 15; return 8 * (i >> 2) + 4 * n + (i & 3); }

struct Unit { int pm, pn; };
struct Gemm { const bf16_t* A; const bf16_t* Bt; int M, N, K; };

struct StaticOrder {
    int nM, nN, nwg, G, c;
    __host__ __device__ void init(int M, int N, int G_, int c_) { nM = M / BM; nN = N / BM; nwg = nM * nN; G = G_; c = c_; }
    __host__ __device__ bool next(int i, Unit& u) const {
        const long L = (long)i * G + c; if (L >= nwg) return false;
        int wgid = (int)L; { const int q = nwg / NXCD, r = nwg % NXCD, xcd = wgid % NXCD, off = wgid / NXCD; wgid = (xcd < r ? xcd * (q + 1) : r * (q + 1) + (xcd - r) * q) + off; }
        const int nig = WGM * nN, gid = wgid / nig, fm = gid * WGM, gsz = (nM - fm) < WGM ? (nM - fm) : WGM;
        u.pm = fm + ((wgid % nig) % gsz); u.pn = (wgid % nig) / gsz; return true;
    }
    __device__ __forceinline__ void a_ready(const Unit&) const {}
    __device__ __forceinline__ void done(const Unit&) const {}
};

__device__ __forceinline__ unsigned cvt_pk_bf16(float lo, float hi) { unsigned r; asm volatile("v_cvt_pk_bf16_f32 %0, %1, %2" : "=v"(r) : "v"(lo), "v"(hi)); return r; }
typedef float f32x2 __attribute__((ext_vector_type(2)));
__device__ __forceinline__ f32x2 gelu_pk(f32x2 v) {
    const f32x2 av = __builtin_elementwise_abs(v), d = av * 0.2316418882f + 1.0f;
    f32x2 t; t.x = __builtin_amdgcn_rcpf(d.x); t.y = __builtin_amdgcn_rcpf(d.y);
    f32x2 q = t * 0.5307027145f + (-0.7265760135f); q = q * t + 0.7107068705f; q = q * t + (-0.142248368f); q = q * t + 0.127414796f; q = q * t;
    const f32x2 s = (v * v) * (-0.72134752044f);
    f32x2 e; e.x = __builtin_amdgcn_exp2f(s.x); e.y = __builtin_amdgcn_exp2f(s.y);
    const f32x2 m = v * (q * e), r = v - m;
    f32x2 o; o.x = v.x < 0.f ? m.x : r.x; o.y = v.y < 0.f ? m.y : r.y; return o;
}

__device__ __forceinline__ float bf_lo(unsigned w) { return __uint_as_float(w << 16); }
__device__ __forceinline__ float bf_hi(unsigned w) { return __uint_as_float(w & 0xffff0000u); }
__device__ __forceinline__ float sigmoidf_fast(float v) { return __builtin_amdgcn_rcpf(1.0f + __builtin_amdgcn_exp2f(-1.44269504f * v)); }

struct EpiBf16 {
    static constexpr bool PERM = true, AFTER_DRAIN = false;
    bf16_t* O; int ldc;
    __device__ __forceinline__ void operator()(const f32x4 (&acc)[2][2][4][2], const Unit& u, int wr, int wc, int fr, int fq) const {
        asm volatile("" : "+v"(fr), "+v"(fq));
        const int row0 = u.pm * BM + wr * 64 + fr, col0 = u.pn * BM + wc * 32 + 8 * fq;
#pragma unroll
        for (int ai = 0; ai < 2; ++ai)
#pragma unroll
            for (int m = 0; m < 4; ++m) { bf16_t* rowp = O + (size_t)(row0 + ai * HALF + m * 16) * ldc + col0;
#pragma unroll
                for (int bj = 0; bj < 2; ++bj) { const f32x4 v0 = acc[ai][bj][m][0], v1 = acc[ai][bj][m][1];
                    u32x4 w; w.x = cvt_pk_bf16(v0[0], v0[1]); w.y = cvt_pk_bf16(v0[2], v0[3]); w.z = cvt_pk_bf16(v1[0], v1[1]); w.w = cvt_pk_bf16(v1[2], v1[3]);
                    *(u32x4*)(rowp + bj * HALF) = w; } }
    }
};
struct EpiIn {
    static constexpr bool PERM = true, AFTER_DRAIN = false;
    bf16_t* HB; int ldh; float* GA; bf16_t* GATES; const float* bgate;
    __device__ __forceinline__ void operator()(const f32x4 (&acc)[2][2][4][2], const Unit& u, int wr, int wc, int fr, int fq) const {
        asm volatile("" : "+v"(fr), "+v"(fq));
        const int row0 = u.pm * BM + wr * 64 + fr;
        if (u.pn < 56) {
            const int col0 = u.pn * BM + wc * 32 + 8 * fq;
#pragma unroll
            for (int ai = 0; ai < 2; ++ai)
#pragma unroll
                for (int m = 0; m < 4; ++m) { bf16_t* rowp = HB + (size_t)(row0 + ai * HALF + m * 16) * ldh + col0;
#pragma unroll
                    for (int bj = 0; bj < 2; ++bj) { const f32x4 v0 = acc[ai][bj][m][0], v1 = acc[ai][bj][m][1];
                        u32x4 w; w.x = cvt_pk_bf16(v0[0], v0[1]); w.y = cvt_pk_bf16(v0[2], v0[3]); w.z = cvt_pk_bf16(v1[0], v1[1]); w.w = cvt_pk_bf16(v1[2], v1[3]);
                        *(u32x4*)(rowp + bj * HALF) = w; } }
        } else if (u.pn == 56) {
            if (wc == 0) {
#pragma unroll
                for (int ai = 0; ai < 2; ++ai)
#pragma unroll
                    for (int m = 0; m < 4; ++m) { float* rowp = GA + (size_t)(row0 + ai * HALF + m * 16) * 32 + 8 * fq;
                        *(f32x4*)rowp = acc[ai][0][m][0]; *(f32x4*)(rowp + 4) = acc[ai][0][m][1]; }
            }
        } else {
            const int col0 = (u.pn - 57) * BM + wc * 32 + 8 * fq;
#pragma unroll
            for (int ai = 0; ai < 2; ++ai)
#pragma unroll
                for (int m = 0; m < 4; ++m) { bf16_t* rowp = GATES + (size_t)(row0 + ai * HALF + m * 16) * 12288 + col0;
                    asm volatile("" ::: "memory");
#pragma unroll
                    for (int bj = 0; bj < 2; ++bj) { const f32x4 v0 = acc[ai][bj][m][0] + *(const f32x4*)(bgate + col0 + bj * HALF), v1 = acc[ai][bj][m][1] + *(const f32x4*)(bgate + col0 + bj * HALF + 4);
                        u32x4 w; w.x = cvt_pk_bf16(sigmoidf_fast(v0[0]), sigmoidf_fast(v0[1])); w.y = cvt_pk_bf16(sigmoidf_fast(v0[2]), sigmoidf_fast(v0[3]));
                        w.z = cvt_pk_bf16(sigmoidf_fast(v1[0]), sigmoidf_fast(v1[1])); w.w = cvt_pk_bf16(sigmoidf_fast(v1[2]), sigmoidf_fast(v1[3]));
                        *(u32x4*)(rowp + bj * HALF) = w; } }
        }
    }
};
template <int I> struct EpiBranch {
    static constexpr bool PERM = true, AFTER_DRAIN = false;
    bf16_t* MIXED; const bf16_t* GATES;
    __device__ __forceinline__ void operator()(const f32x4 (&acc)[2][2][4][2], const Unit& u, int wr, int wc, int fr, int fq) const {
        asm volatile("" : "+v"(fr), "+v"(fq));
        const int row0 = u.pm * BM + wr * 64 + fr, col0 = u.pn * BM + wc * 32 + 8 * fq;
#pragma unroll
        for (int ai = 0; ai < 2; ++ai)
#pragma unroll
            for (int m = 0; m < 4; ++m) { const size_t r = (size_t)(row0 + ai * HALF + m * 16);
                asm volatile("" ::: "memory");
#pragma unroll
                for (int bj = 0; bj < 2; ++bj) {
                    const u32x4 g = *(const u32x4*)(GATES + r * 12288 + I * 4096 + col0 + bj * HALF);
                    bf16_t* mp = MIXED + r * 4096 + col0 + bj * HALF;
                    u32x4 p = (u32x4){0u, 0u, 0u, 0u}; if (I) p = *(const u32x4*)mp;
                    const f32x4 a0 = acc[ai][bj][m][0], a1 = acc[ai][bj][m][1];
                    u32x4 w;
                    w.x = cvt_pk_bf16(bf_lo(p.x) + bf_lo(g.x) * a0[0], bf_hi(p.x) + bf_hi(g.x) * a0[1]);
                    w.y = cvt_pk_bf16(bf_lo(p.y) + bf_lo(g.y) * a0[2], bf_hi(p.y) + bf_hi(g.y) * a0[3]);
                    w.z = cvt_pk_bf16(bf_lo(p.z) + bf_lo(g.z) * a1[0], bf_hi(p.z) + bf_hi(g.z) * a1[1]);
                    w.w = cvt_pk_bf16(bf_lo(p.w) + bf_lo(g.w) * a1[2], bf_hi(p.w) + bf_hi(g.w) * a1[3]);
                    *(u32x4*)mp = w; } }
    }
};
struct EpiResid {
    static constexpr bool PERM = false, AFTER_DRAIN = false;
    float* V; const float* xres; int ldc; float alpha;
    __device__ __forceinline__ void operator()(const f32x4 (&acc)[2][2][4][2], const Unit& u, int wr, int wc, int fr, int fq) const {
        asm volatile("" : "+v"(fr), "+v"(fq));
        const int row0 = u.pm * BM + wr * 64 + fr, col0 = u.pn * BM + wc * 32 + 4 * fq;
#pragma unroll
        for (int ai = 0; ai < 2; ++ai)
#pragma unroll
            for (int m = 0; m < 4; ++m) { const size_t off = (size_t)(row0 + ai * HALF + m * 16) * ldc + col0;
                asm volatile("" ::: "memory");
#pragma unroll
                for (int bj = 0; bj < 2; ++bj)
#pragma unroll
                    for (int n = 0; n < 2; ++n) { const f32x4 xr = *(const f32x4*)(xres + off + bj * HALF + n * 16);
                        *(f32x4*)(V + off + bj * HALF + n * 16) = xr * alpha + acc[ai][bj][m][n]; } }
    }
};

template <class Epi, class Sched, bool ALIGN_EPI = false, bool SP2 = false>
__device__ __forceinline__ void gemm_phase(PG8_LAS unsigned char* lds, const Gemm g, const Sched& S, const Epi& E, const int wv  ) {
    int tid_ = wv * 64 + (int)__builtin_amdgcn_mbcnt_hi(~0u, __builtin_amdgcn_mbcnt_lo(~0u, 0u)); asm volatile("" : "+v"(tid_));
    const int tid = tid_, wid = __builtin_amdgcn_readfirstlane(tid >> 6), lane = tid & 63, wr = wid >> 2, wc = wid & 3, fr = lane & 15, fq = lane >> 4;
    const int K = g.K, nt = K / BK;
    unsigned voffA[2], voffB[2];
#pragma unroll
    for (int i = 0; i < 2; ++i) { int R, C; stage_rc(tid * 16 + i * 8192, R, C); const int Rb = Epi::PERM ? ((R & ~31) + perm32(R & 31)) : R;
        voffA[i] = (unsigned)(R * K + C) * 2u; voffB[i] = (unsigned)(Rb * K + C) * 2u; }
    const size_t kstep = (size_t)(BK * 2);
    const size_t hstep = (size_t)HALF * K * 2;
    const size_t tstep = 2 * hstep;
    const unsigned ldsw = (unsigned)wid * 1024u;
    const int aoff = lds_byte(wr * 64 + fr, fq * 8), boff = lds_byte(wc * 32 + fr, fq * 8);
#define PG8_SA(b, h) (((b) * 2 + (h)) * HTB)
#define PG8_SB(b, h) ((4 + (b) * 2 + (h)) * HTB)
#define PG8_STAGE(bufoff, gbase, voff) do { _Pragma("unroll") for (int _i = 0; _i < 2; ++_i) \
        __builtin_amdgcn_global_load_lds((const unsigned*)((const char*)(gbase) + (voff)[_i]), (PG8_LAS unsigned*)(lds + (bufoff) + ldsw + _i * 8192), 16, 0, 0); } while (0)
#define PG8_LDA(dst, b, h) do { _Pragma("unroll") for (int m = 0; m < 4; ++m) _Pragma("unroll") for (int k = 0; k < 2; ++k) dst[m][k] = *(const PG8_LAS bf16x8*)(lds + PG8_SA(b, h) + aoff + m * 2048 + k * 1024); } while (0)
#define PG8_LDB(dst, b, h) do { _Pragma("unroll") for (int n = 0; n < 2; ++n) _Pragma("unroll") for (int k = 0; k < 2; ++k) dst[n][k] = *(const PG8_LAS bf16x8*)(lds + PG8_SB(b, h) + boff + n * 2048 + k * 1024); } while (0)
#define PG8_MMA(ai, bj, At, Bt) do { __builtin_amdgcn_s_setprio(1); _Pragma("unroll") for (int m = 0; m < 4; ++m) _Pragma("unroll") for (int n = 0; n < 2; ++n) _Pragma("unroll") for (int k = 0; k < 2; ++k) \
        acc[ai][bj][m][n] = __builtin_amdgcn_mfma_f32_16x16x32_bf16(Bt[n][k], At[m][k], acc[ai][bj][m][n], 0, 0, 0); __builtin_amdgcn_s_setprio(0); } while (0)
#define PG8_WAIT_V(n) asm volatile("s_waitcnt vmcnt(" #n ")" ::: "memory")
#define PG8_WAIT_L(n) asm volatile("s_waitcnt lgkmcnt(" #n ")" ::: "memory")
#define PG8_BAR __builtin_amdgcn_s_barrier()
#define PG8_SCHED __builtin_amdgcn_sched_barrier(0)
    Unit cur, nxt; int ui = 0;
    if (!S.next(0, cur)) return;
    f32x4 acc[2][2][4][2];
#pragma unroll
    for (int a = 0; a < 2; ++a)
#pragma unroll
        for (int b = 0; b < 2; ++b)
#pragma unroll
            for (int m = 0; m < 4; ++m)
#pragma unroll
                for (int n = 0; n < 2; ++n) acc[a][b][m][n] = (f32x4){0.f, 0.f, 0.f, 0.f};
    bf16x8 At[4][2], B0[2][2], B1[2][2];
    const char* cA = (const char*)g.A + (size_t)cur.pm * tstep; const char* cB = (const char*)g.Bt + (size_t)cur.pn * tstep;
    S.a_ready(cur);
    if constexpr (SP2) {
        PG8_STAGE(PG8_SB(0, 0), cB, voffB); PG8_STAGE(PG8_SB(0, 1), cB + hstep, voffB); PG8_STAGE(PG8_SA(0, 0), cA, voffA); PG8_STAGE(PG8_SA(0, 1), cA + hstep, voffA);
        if (wr == 1) PG8_BAR;
        PG8_WAIT_V(2); PG8_BAR;
        PG8_STAGE(PG8_SB(1, 0), cB + kstep, voffB); PG8_STAGE(PG8_SA(1, 0), cA + kstep, voffA); PG8_STAGE(PG8_SB(1, 1), cB + hstep + kstep, voffB);
        PG8_WAIT_V(6); PG8_BAR;
    } else {
        PG8_STAGE(PG8_SB(0, 0), cB, voffB); PG8_STAGE(PG8_SA(0, 0), cA, voffA); PG8_STAGE(PG8_SB(0, 1), cB + hstep, voffB); PG8_STAGE(PG8_SA(0, 1), cA + hstep, voffA);
        if (wr == 1) PG8_BAR;
        PG8_WAIT_V(4); PG8_BAR;
        PG8_STAGE(PG8_SB(1, 0), cB + kstep, voffB); PG8_STAGE(PG8_SA(1, 0), cA + kstep, voffA); PG8_STAGE(PG8_SB(1, 1), cB + hstep + kstep, voffB);
        PG8_WAIT_V(6); PG8_BAR;
    }
    for (;;) {
        const bool has_next = S.next(ui + 1, nxt);
        const char* nA = has_next ? (const char*)g.A + (size_t)nxt.pm * tstep : cA; const char* nB = has_next ? (const char*)g.Bt + (size_t)nxt.pn * tstep : cB;
        for (int t = 0; t < nt; t += 2) {
            const bool last = (t == nt - 2);
            const char* a1 = cA + (size_t)(t + 1) * kstep;
            const char* a2 = last ? nA : cA + (size_t)(t + 2) * kstep; const char* b2 = last ? nB : cB + (size_t)(t + 2) * kstep;
            const char* a3 = a2 + kstep; const char* b3 = b2 + kstep;
            if (last && has_next) S.a_ready(nxt);
            if constexpr (SP2) {
            PG8_LDB(B0, 0, 0); PG8_LDB(B1, 0, 1); PG8_SCHED; PG8_LDA(At, 0, 0); PG8_STAGE(PG8_SA(1, 1), a1 + hstep, voffA);
            PG8_WAIT_V(8); PG8_WAIT_L(0); PG8_BAR; PG8_MMA(0, 0, At, B0); PG8_MMA(0, 1, At, B1); PG8_BAR; PG8_SCHED;
            PG8_LDA(At, 0, 1); PG8_STAGE(PG8_SB(0, 0), b2, voffB); PG8_STAGE(PG8_SB(0, 1), b2 + hstep, voffB); PG8_STAGE(PG8_SA(0, 0), a2, voffA);
            PG8_WAIT_V(8); PG8_WAIT_L(0); PG8_BAR; PG8_MMA(1, 0, At, B0); PG8_MMA(1, 1, At, B1); PG8_BAR; PG8_SCHED;
            PG8_LDB(B0, 1, 0); PG8_LDB(B1, 1, 1); PG8_SCHED; PG8_LDA(At, 1, 0); PG8_STAGE(PG8_SA(0, 1), a2 + hstep, voffA);
            PG8_WAIT_V(8); PG8_WAIT_L(0); PG8_BAR; PG8_MMA(0, 0, At, B0); PG8_MMA(0, 1, At, B1); PG8_BAR; PG8_SCHED;
            PG8_LDA(At, 1, 1); PG8_STAGE(PG8_SB(1, 0), b3, voffB); PG8_STAGE(PG8_SB(1, 1), b3 + hstep, voffB); PG8_STAGE(PG8_SA(1, 0), a3, voffA);
            PG8_WAIT_V(8); PG8_WAIT_L(0); PG8_BAR; PG8_MMA(1, 0, At, B0); PG8_MMA(1, 1, At, B1); PG8_BAR; PG8_SCHED;
            } else {
            PG8_LDB(B0, 0, 0); PG8_SCHED; PG8_LDA(At, 0, 0); PG8_STAGE(PG8_SA(1, 1), a1 + hstep, voffA);
            PG8_WAIT_L(8); PG8_BAR; PG8_WAIT_L(0); PG8_MMA(0, 0, At, B0); PG8_BAR; PG8_SCHED;
            PG8_LDB(B1, 0, 1); PG8_STAGE(PG8_SB(0, 0), b2, voffB);
            PG8_BAR; PG8_WAIT_L(0); PG8_MMA(0, 1, At, B1); PG8_BAR;
            PG8_LDA(At, 0, 1); PG8_STAGE(PG8_SA(0, 0), a2, voffA);
            PG8_BAR; PG8_WAIT_L(0); PG8_MMA(1, 0, At, B0); PG8_BAR; PG8_SCHED;
            PG8_STAGE(PG8_SB(0, 1), b2 + hstep, voffB);
            PG8_WAIT_V(6); PG8_BAR; PG8_MMA(1, 1, At, B1); PG8_BAR;
            PG8_LDB(B0, 1, 0); PG8_SCHED; PG8_LDA(At, 1, 0); PG8_STAGE(PG8_SA(0, 1), a2 + hstep, voffA);
            PG8_WAIT_L(8); PG8_BAR; PG8_WAIT_L(0); PG8_MMA(0, 0, At, B0); PG8_BAR; PG8_SCHED;
            PG8_LDB(B1, 1, 1); PG8_STAGE(PG8_SB(1, 0), b3, voffB);
            PG8_BAR; PG8_WAIT_L(0); PG8_MMA(0, 1, At, B1); PG8_BAR;
            PG8_LDA(At, 1, 1); PG8_STAGE(PG8_SA(1, 0), a3, voffA);
            PG8_BAR; PG8_WAIT_L(0); PG8_MMA(1, 0, At, B0); PG8_BAR; PG8_SCHED;
            PG8_STAGE(PG8_SB(1, 1), b3 + hstep, voffB);
            PG8_WAIT_V(6); PG8_BAR; PG8_MMA(1, 1, At, B1); PG8_BAR;
            }
        }
        if constexpr (ALIGN_EPI) { if (wr == 0) PG8_BAR; }
        if constexpr (!Epi::AFTER_DRAIN) { E(acc, cur, wr, wc, fr, fq); S.done(cur); }
        if (!has_next) break;
#pragma unroll
        for (int a = 0; a < 2; ++a)
#pragma unroll
            for (int b = 0; b < 2; ++b)
#pragma unroll
                for (int m = 0; m < 4; ++m)
#pragma unroll
                    for (int n = 0; n < 2; ++n) acc[a][b][m][n] = (f32x4){0.f, 0.f, 0.f, 0.f};
        cur = nxt; cA = nA; cB = nB; ++ui;
        if constexpr (ALIGN_EPI) { if (wr == 1) PG8_BAR; }
    }
    PG8_WAIT_V(0);
    if constexpr (!ALIGN_EPI) { if (wr == 0) PG8_BAR; }
    PG8_BAR;
    if constexpr (Epi::AFTER_DRAIN) { E.fused(acc, cur, wr, wc, fr, fq, lds, wid, lane); S.done(cur); }
#undef PG8_SA
#undef PG8_SB
#undef PG8_STAGE
#undef PG8_LDA
#undef PG8_LDB
#undef PG8_MMA
#undef PG8_WAIT_V
#undef PG8_WAIT_L
#undef PG8_BAR
#undef PG8_SCHED
}
}

constexpr int NWAVES = 8;
constexpr int NB = 4, SEQ = 4096, M = NB * SEQ, D = 4096, BW = 2048, FF = 11008, DEPTH = 2;
constexpr int IN_WIDTH = 30752;
constexpr int NIN_MAIN = 26880, NIN_PAD = 30976;
constexpr int LDH = 14336;
constexpr int H_CB = 0, H_CC = 2048, H_CH = 4096, H_NQ = 6144, H_NK = 8192, H_GQ = 10240, H_GK = 11264, H_GR = 12288;
constexpr float LN_EPS = 1e-5f, RMS_EPS = 1e-6f, ALPHA = 1.41421356237f;
#ifndef MK_MULTI
#define MK_MULTI 1
#endif
constexpr int N_PHASES = 1 + 11 * DEPTH;

constexpr size_t MiB = 1u << 20;
constexpr size_t alm(size_t x) { return (x + MiB - 1) / MiB * MiB; }
constexpr size_t WS_CTL = 0, CTL_ZERO_BYTES = 1 * MiB;
constexpr size_t SZ_WIN = alm((size_t)NIN_PAD * D * 2), SZ_WBR = alm((size_t)3 * D * BW * 2), SZ_WO = alm((size_t)D * D * 2), SZ_WFI = alm((size_t)2 * FF * D * 2), SZ_WFO = alm((size_t)D * FF * 2);
constexpr size_t OFF_WIN = 0, OFF_WBR = OFF_WIN + SZ_WIN, OFF_WO = OFF_WBR + SZ_WBR, OFF_WFI = OFF_WO + SZ_WO, OFF_WFO = OFF_WFI + SZ_WFI, SZ_WL = OFF_WFO + SZ_WFO;
constexpr size_t WS_W = 1 * MiB;
constexpr size_t WS_XB = WS_W + DEPTH * SZ_WL;
constexpr size_t WS_XR = WS_XB + alm((size_t)M * D * 2);
constexpr size_t WS_U = WS_XR + alm((size_t)M * D * 4);
constexpr size_t WS_HB = WS_U;
constexpr size_t WS_GA = WS_HB + alm((size_t)M * LDH * 2);
constexpr size_t WS_GATES = WS_GA + alm((size_t)M * 32 * 4);
constexpr size_t WS_VT = WS_GATES + alm((size_t)M * 12288 * 2);
constexpr size_t WS_YC = WS_VT + alm((size_t)4096 * M * 2);
constexpr size_t WS_YN = WS_YC + alm((size_t)M * BW * 2);
constexpr size_t WS_YG = WS_YN + alm((size_t)M * BW * 2);
constexpr size_t WS_QIN = WS_YG + alm((size_t)M * BW * 2);
constexpr size_t WS_KOT = WS_QIN + alm((size_t)2 * M * 1024 * 2);
constexpr size_t WS_ATT = WS_KOT + alm((size_t)2 * 1024 * M * 2);
constexpr size_t WS_DEC = WS_ATT + alm((size_t)2 * 4 * 4 * 64 * 64 * 64 * 2);
constexpr size_t WS_O = WS_DEC + alm((size_t)2 * 4 * 64 * 1024 * 4);
constexpr size_t WS_MIXED = WS_O + alm((size_t)2 * M * 2048 * 4);
constexpr size_t WS_END = WS_MIXED + alm((size_t)M * D * 2);
constexpr size_t WS_AU = WS_U;
constexpr size_t WS_G = WS_AU + alm((size_t)M * 2 * FF * 2);
static_assert(WS_G + alm((size_t)M * FF * 2) <= WS_MIXED, "the FFN overlay must stay below MIXED");
static_assert(WS_END <= (size_t)3844 * MiB, "d_ws budget: 4 x the largest input tensor");
constexpr int CW_BAR = 4096;

constexpr int RING_BYTES = 131072;
constexpr int LDS_BYTES = 147456;
constexpr int MISC_OFF = LDS_BYTES - 512;

#define GAS __attribute__((address_space(1)))
#define LAS __attribute__((address_space(3)))
typedef unsigned short bf16;
typedef unsigned v4u __attribute__((ext_vector_type(4)));
typedef unsigned v2u __attribute__((ext_vector_type(2)));
typedef float f32x4 __attribute__((ext_vector_type(4)));
typedef short bf16x8 __attribute__((ext_vector_type(8)));
typedef GAS unsigned gu32;
#define LDS_WAIT() asm volatile("s_waitcnt lgkmcnt(0)" ::: "memory")
#define VM_WAIT() asm volatile("s_waitcnt vmcnt(0)" ::: "memory")
__device__ __forceinline__ unsigned pk2(float lo, float hi) { return pg8::cvt_pk_bf16(lo, hi); }
__device__ __forceinline__ float bflo(unsigned w) { return __uint_as_float(w << 16); }
__device__ __forceinline__ float bfhi(unsigned w) { return __uint_as_float(w & 0xffff0000u); }
__device__ __forceinline__ float bf1(bf16 b) { return __uint_as_float(((unsigned)b) << 16); }
__device__ __forceinline__ void unpack8(const v4u w, float (&f)[8]) { f[0] = bflo(w.x); f[1] = bfhi(w.x); f[2] = bflo(w.y); f[3] = bfhi(w.y); f[4] = bflo(w.z); f[5] = bfhi(w.z); f[6] = bflo(w.w); f[7] = bfhi(w.w); }
__device__ __forceinline__ v4u pack8(const float (&f)[8]) { v4u w; w.x = pk2(f[0], f[1]); w.y = pk2(f[2], f[3]); w.z = pk2(f[4], f[5]); w.w = pk2(f[6], f[7]); return w; }
__device__ __forceinline__ float wave_sum(float v) {
#pragma unroll
    for (int o = 1; o < 64; o <<= 1) v += __shfl_xor(v, o);
    return v;
}
__device__ __forceinline__ f32x4 mfma16(bf16x8 a, bf16x8 b, f32x4 c) { return __builtin_amdgcn_mfma_f32_16x16x32_bf16(a, b, c, 0, 0, 0); }

#define XB_TMO      128
#define XB_XCNT(j)  (256  + 64 * (j))
#define XB_XSUB(j)  (1280 + 64 * (j))
#define XB_XGEN(j)  (2304 + 64 * (j))
#define XB_TOP      3328
#define XB_TOPGEN   3392
#define XCD_BAR_WORDS 3456
#define XB_SPIN_CAP (1u << 18)

__device__ __forceinline__ unsigned xb_ld(unsigned* p)              { return __hip_atomic_load(p, __ATOMIC_RELAXED, __HIP_MEMORY_SCOPE_AGENT); }
__device__ __forceinline__ unsigned xb_add(unsigned* p, unsigned v) { return __hip_atomic_fetch_add(p, v, __ATOMIC_RELAXED, __HIP_MEMORY_SCOPE_AGENT); }
__device__ __forceinline__ unsigned xb_xcc_id() { return (unsigned)__builtin_amdgcn_s_getreg((3 << 11) | 20) & 0xFu; }
#define XB_SPIN(cond, bar) do { unsigned _sp = 0; while (cond) { __builtin_amdgcn_s_sleep(1); \
    if ((++_sp & 255u) == 0u) { if (xb_ld(&(bar)[XB_TMO])) break; if (_sp > XB_SPIN_CAP) { atomicAdd(&(bar)[XB_TMO], 1u); break; } } } } while (0)

__device__ __forceinline__ unsigned xb_lane_id() { return __builtin_amdgcn_mbcnt_hi(~0u, __builtin_amdgcn_mbcnt_lo(~0u, 0u)); }
struct XcdBarrier {
    unsigned wv;
    unsigned* bar; unsigned x;
    volatile LAS unsigned* st;
};

__device__ __forceinline__ XcdBarrier xcd_barrier_post(unsigned* bar, volatile LAS unsigned* st) {
    XcdBarrier b; b.wv = 0u; b.bar = bar; b.x = xb_xcc_id(); b.st = st;
    if (threadIdx.x == 0) (void)xb_add(&bar[XB_XCNT(b.x)], 1u);
    return b;
}
__device__ __forceinline__ void xcd_barrier_complete(unsigned* bar, unsigned x, unsigned& nloc, unsigned& nx) {
    const unsigned G = gridDim.x * gridDim.y * gridDim.z;
    unsigned sum, cnt, mine, sp = 0u;
    for (;;) {
        sum = 0u; cnt = 0u; mine = 0u;
#pragma unroll
        for (unsigned j = 0; j < 16; ++j) { const unsigned c = xb_ld(&bar[XB_XCNT(j)]); sum += c; cnt += (c > 0u) ? 1u : 0u; mine = (j == x) ? c : mine; }
        if (sum == G) break;
        __builtin_amdgcn_s_sleep(1);
        if ((++sp & 255u) == 0u) { if (xb_ld(&bar[XB_TMO])) break; if (sp > XB_SPIN_CAP) { atomicAdd(&bar[XB_TMO], 1u); break; } }
    }
    nloc = mine > 0u ? mine : 1u; nx = cnt > 0u ? cnt : 1u;
}

__device__ __forceinline__ void xcd_barrier(const XcdBarrier& b) {
    asm volatile("s_waitcnt vmcnt(0)" ::: "memory");
    __syncthreads();
    if (b.wv == 0u && xb_lane_id() == 0u) {
        unsigned* bar = b.bar;
        __builtin_amdgcn_s_waitcnt(0);
        unsigned nloc = b.st[0], nx = b.st[1];
        if (nloc == 0u) { xcd_barrier_complete(bar, b.x, nloc, nx); b.st[0] = nloc; b.st[1] = nx; }
        const unsigned old = xb_add(&bar[XB_XSUB(b.x)], 1u);
        const unsigned gen = old / nloc;
        if (old + 1u == (gen + 1u) * nloc) {
            __builtin_amdgcn_fence(__ATOMIC_RELEASE, "agent");
            asm volatile("s_waitcnt vmcnt(0)" ::: "memory");
            const unsigned og = xb_add(&bar[XB_TOP], 1u);
            const unsigned tg = og / nx;
            if (og + 1u == (tg + 1u) * nx) xb_add(&bar[XB_TOPGEN], 1u);
            else XB_SPIN(xb_ld(&bar[XB_TOPGEN]) == tg, bar);
            __builtin_amdgcn_fence(__ATOMIC_ACQUIRE, "agent");
            xb_add(&bar[XB_XGEN(b.x)], 1u);
            asm volatile("s_waitcnt vmcnt(0)" ::: "memory");
        } else {
            XB_SPIN(xb_ld(&bar[XB_XGEN(b.x)]) == gen, bar);
            __builtin_amdgcn_fence(__ATOMIC_ACQUIRE, "agent");
            asm volatile("s_waitcnt vmcnt(0)" ::: "memory");
        }
    }
    __syncthreads();
}

struct Args { GAS const float* in[18]; GAS float* out; GAS unsigned char* ws; int ph_lo, ph_hi; };
typedef __attribute__((address_space(4))) const Args CArgs;
__device__ __forceinline__ CArgs* kargs() { CArgs* p = (CArgs*)__builtin_amdgcn_kernarg_segment_ptr(); asm volatile("" : "+s"(p)); return p; }
#define INP(i) ((const float*)kargs()->in[i])
#define OUTP ((float*)kargs()->out)
struct Frame { LAS unsigned char* lds; int wv; };
struct Ids { int tid, lane, wave, G, gw, NGW; };
__device__ __forceinline__ Ids phase_ids(const int wv) { Ids I; int t = wv * 64 + (int)__builtin_amdgcn_mbcnt_hi(~0u, __builtin_amdgcn_mbcnt_lo(~0u, 0u)); asm volatile("" : "+v"(t)); I.tid = t; I.lane = t & 63; I.wave = __builtin_amdgcn_readfirstlane(t >> 6);
    int g = gridDim.x; asm volatile("" : "+s"(g)); I.G = g; I.gw = blockIdx.x * NWAVES + I.wave; I.NGW = g * NWAVES; return I; }
#define WSP(T, off) ((T*)(GAS T*)(kargs()->ws + (off)))


__device__ __forceinline__ int win_src(int r) {
    if (r < 10240) return r;
    if (r < 12288) return 12288 + (r - 10240);
    if (r < 14336) return 16384 + (r - 12288);
    if (r < 14592) return r == 14336 ? 18432 : -1;
    if (r < 26880) return 18464 + (r - 14592);
    if (r < 28928) return 10240 + (r - 26880);
    return 14336 + (r - 28928);
}
__device__ __forceinline__ void tr_item(const float* W, size_t ldw, int K, int k0, int srcA, int srcB, bf16* WT, int n0, LAS float* scr, int lane) {
    const int src = lane < 32 ? srcA : srcB; const int cl = lane & 31;
    if (src >= 0) { const float* p = W + (size_t)k0 * ldw + src + cl;
#pragma unroll 16
        for (int kk = 0; kk < 64; ++kk) scr[kk * 65 + lane] = p[(size_t)kk * ldw];
    } else {
#pragma unroll 16
        for (int kk = 0; kk < 64; ++kk) scr[kk * 65 + lane] = 0.f;
    }
    LDS_WAIT(); asm volatile("" ::: "memory");
    const int c = lane & 7;
#pragma unroll
    for (int j = 0; j < 8; ++j) { const int n = (lane >> 3) + 8 * j; const LAS float* s = scr + (8 * c) * 65 + n;
        v4u o; o.x = pk2(s[0 * 65], s[1 * 65]); o.y = pk2(s[2 * 65], s[3 * 65]); o.z = pk2(s[4 * 65], s[5 * 65]); o.w = pk2(s[6 * 65], s[7 * 65]);
        *(v4u*)(WT + (size_t)(n0 + n) * K + k0 + 8 * c) = o; }
    LDS_WAIT(); asm volatile("" ::: "memory");
}
__device__ __forceinline__ void tr_matrix(const Ids& I, const float* W, int K, int N, bf16* WT, LAS float* scr) {
    const int nnb = N / 64, items = (K / 64) * nnb;
    for (int it = I.gw; it < items; it += I.NGW) { const int kb = it / nnb, nb = it % nnb; tr_item(W, (size_t)N, K, kb * 64, nb * 64, nb * 64 + 32, WT, nb * 64, scr, I.lane); }
}
__device__ __forceinline__ void p0_prologue(Frame& F) {
    const Ids I = phase_ids(F.wv);
    LAS float* scr = (LAS float*)(F.lds + I.wave * 16640);
    for (int l = 0; l < DEPTH; ++l) {
        unsigned char* wl = (unsigned char*)(kargs()->ws + WS_W + (size_t)l * SZ_WL);
        { const float* W = INP(1) + (size_t)l * D * IN_WIDTH; bf16* WT = (bf16*)(wl + OFF_WIN);
            const int nnb = NIN_PAD / 64, items = (D / 64) * nnb;
            for (int it = I.gw; it < items; it += I.NGW) { const int kb = it / nnb, nb = it % nnb; tr_item(W, (size_t)IN_WIDTH, D, kb * 64, win_src(nb * 64), win_src(nb * 64 + 32), WT, nb * 64, scr, I.lane); } }
        for (int i = 0; i < 3; ++i) tr_matrix(I, INP(8) + ((size_t)l * 3 + i) * BW * D, BW, D, (bf16*)(wl + OFF_WBR) + (size_t)i * D * BW, scr);
        tr_matrix(I, INP(9) + (size_t)l * D * D, D, D, (bf16*)(wl + OFF_WO), scr);
        tr_matrix(I, INP(12) + (size_t)l * D * 2 * FF, D, 2 * FF, (bf16*)(wl + OFF_WFI), scr);
        tr_matrix(I, INP(15) + (size_t)l * FF * D, FF, D, (bf16*)(wl + OFF_WFO), scr);
    }
    { const f32x4* x4 = (const f32x4*)INP(0); v4u* o = WSP(v4u, WS_XB); const size_t n8 = (size_t)M * D / 8, stride = (size_t)I.G * 512;
      for (size_t i = (size_t)blockIdx.x * 512 + I.tid; i < n8; i += stride) { const f32x4 a = x4[2 * i], b = x4[2 * i + 1]; v4u w; w.x = pk2(a[0], a[1]); w.y = pk2(a[2], a[3]); w.z = pk2(b[0], b[1]); w.w = pk2(b[2], b[3]); o[i] = w; } }
}

__device__ __forceinline__ void conv_mixer_phase(Frame& F, int layer) {
    const Ids I = phase_ids(F.wv);
    const bf16* HB = WSP(const bf16, WS_HB); bf16* YC = WSP(bf16, WS_YC); const float* wc = INP(3) + (size_t)layer * 3 * BW;
    const int c8 = (I.tid & 255) * 8, half = I.tid >> 8;
    float w[3][8];
#pragma unroll
    for (int i = 0; i < 3; ++i) { const f32x4 a = *(const f32x4*)(wc + i * BW + c8), b = *(const f32x4*)(wc + i * BW + c8 + 4);
        w[i][0] = a[0]; w[i][1] = a[1]; w[i][2] = a[2]; w[i][3] = a[3]; w[i][4] = b[0]; w[i][5] = b[1]; w[i][6] = b[2]; w[i][7] = b[3]; }
    for (int it = blockIdx.x; it < M / 2; it += I.G) {
        const int m = 2 * it + half, s = m & (SEQ - 1);
        const bf16* row = HB + (size_t)m * LDH + c8;
        float acc[8], cb[8], x[8], y[8];
        unpack8(*(const v4u*)(row + H_CC), x); unpack8(*(const v4u*)(row + H_CH), y);
#pragma unroll
        for (int e = 0; e < 8; ++e) acc[e] = w[1][e] * (x[e] * y[e]);
        if (s > 0) { unpack8(*(const v4u*)(row - LDH + H_CC), x); unpack8(*(const v4u*)(row - LDH + H_CH), y);
#pragma unroll
            for (int e = 0; e < 8; ++e) acc[e] += w[0][e] * (x[e] * y[e]); }
        if (s < SEQ - 1) { unpack8(*(const v4u*)(row + LDH + H_CC), x); unpack8(*(const v4u*)(row + LDH + H_CH), y);
#pragma unroll
            for (int e = 0; e < 8; ++e) acc[e] += w[2][e] * (x[e] * y[e]); }
        unpack8(*(const v4u*)(row + H_CB), cb);
#pragma unroll
        for (int e = 0; e < 8; ++e) acc[e] *= cb[e];
        *(v4u*)(YC + (size_t)m * BW + c8) = pack8(acc);
    }
}
__device__ __forceinline__ void ln_phase(Frame& F, const float* V, const float* g, const float* b, float* XF, bf16* XBo) {
    const Ids I = phase_ids(F.wv);
    for (int m = I.gw; m < M; m += I.NGW) {
        const f32x4* vr = (const f32x4*)(V + (size_t)m * D) + I.lane;
        f32x4 v[16]; float s = 0.f;
#pragma unroll
        for (int j = 0; j < 16; ++j) { v[j] = vr[64 * j]; s += (v[j][0] + v[j][1]) + (v[j][2] + v[j][3]); }
        const float mean = wave_sum(s) * (1.f / D); float s2 = 0.f;
#pragma unroll
        for (int j = 0; j < 16; ++j) { v[j] = v[j] - mean; s2 += (v[j][0] * v[j][0] + v[j][1] * v[j][1]) + (v[j][2] * v[j][2] + v[j][3] * v[j][3]); }
        const float rstd = 1.f / sqrtf(wave_sum(s2) * (1.f / D) + LN_EPS);
        f32x4* xo = (f32x4*)(XF + (size_t)m * D) + I.lane; v2u* bo = (v2u*)(XBo + (size_t)m * D) + I.lane;
#pragma unroll
        for (int j = 0; j < 16; ++j) { const f32x4 gg = ((const f32x4*)g)[I.lane + 64 * j], bb = ((const f32x4*)b)[I.lane + 64 * j];
            const f32x4 o = v[j] * rstd * gg + bb; xo[64 * j] = o; v2u w; w.x = pk2(o[0], o[1]); w.y = pk2(o[2], o[3]); bo[64 * j] = w; }
    }
}
__device__ __forceinline__ void convglu_phase(Frame& F, int layer) {
    const Ids I = phase_ids(F.wv);
    const bf16* AU = WSP(const bf16, WS_AU); bf16* G = WSP(bf16, WS_G);
    const float* wc = INP(13) + (size_t)layer * 3 * FF; const float* bc = INP(14) + (size_t)layer * FF;
    constexpr int J = FF / 8; const size_t total = (size_t)M * J, stride = (size_t)I.G * 512;
    for (size_t idx = (size_t)blockIdx.x * 512 + I.tid; idx < total; idx += stride) {
        const int m = (int)(idx / J), c8 = (int)(idx % J) * 8, s = m & (SEQ - 1);
        const bf16* row = AU + (size_t)m * (2 * FF) + c8;
        float a[8], acc[8], wv[8];
        { const f32x4 x = *(const f32x4*)(bc + c8), y = *(const f32x4*)(bc + c8 + 4); acc[0] = x[0]; acc[1] = x[1]; acc[2] = x[2]; acc[3] = x[3]; acc[4] = y[0]; acc[5] = y[1]; acc[6] = y[2]; acc[7] = y[3]; }
#define CG_TAP(i, ptr) { unpack8(*(const v4u*)(ptr), a); const f32x4 x = *(const f32x4*)(wc + (i) * FF + c8), y = *(const f32x4*)(wc + (i) * FF + c8 + 4); \
            wv[0] = x[0]; wv[1] = x[1]; wv[2] = x[2]; wv[3] = x[3]; wv[4] = y[0]; wv[5] = y[1]; wv[6] = y[2]; wv[7] = y[3]; _Pragma("unroll") for (int e = 0; e < 8; ++e) acc[e] += wv[e] * a[e]; }
        CG_TAP(1, row)
        if (s > 0) CG_TAP(0, row - 2 * FF)
        if (s < SEQ - 1) CG_TAP(2, row + 2 * FF)
#undef CG_TAP
        float u[8]; unpack8(*(const v4u*)(row + FF), u);
#pragma unroll
        for (int e = 0; e < 8; e += 2) { const pg8::f32x2 gl = pg8::gelu_pk((pg8::f32x2){acc[e], acc[e + 1]}); acc[e] = gl.x * u[e]; acc[e + 1] = gl.y * u[e + 1]; }
        *(v4u*)(G + (size_t)m * FF + c8) = pack8(acc);
    }
}
__device__ __forceinline__ void gla_combine_phase(Frame& F, int layer) {
    const Ids I = phase_ids(F.wv);
    const float* O0 = WSP(const float, WS_O); const float* O1 = O0 + (size_t)M * 2048; const bf16* HB = WSP(const bf16, WS_HB); bf16* YG = WSP(bf16, WS_YG);
    const float* ng = INP(7) + (size_t)layer * 2048;
    for (int idx = I.gw; idx < M * 4; idx += I.NGW) {
        const int m = idx >> 2, h = idx & 3; const size_t off = (size_t)m * 2048 + h * 512 + 8 * I.lane;
        const f32x4 a0 = *(const f32x4*)(O0 + off), a1 = *(const f32x4*)(O0 + off + 4), b0 = *(const f32x4*)(O1 + off), b1 = *(const f32x4*)(O1 + off + 4);
        float o[8] = {a0[0] + b0[0], a0[1] + b0[1], a0[2] + b0[2], a0[3] + b0[3], a1[0] + b1[0], a1[1] + b1[1], a1[2] + b1[2], a1[3] + b1[3]};
        float ss = 0.f;
#pragma unroll
        for (int e = 0; e < 8; ++e) ss += o[e] * o[e];
        const float rs = 1.f / sqrtf(wave_sum(ss) * (1.f / 512.f) + RMS_EPS);
        float r[8]; unpack8(*(const v4u*)(HB + (size_t)m * LDH + H_GR + h * 512 + 8 * I.lane), r);
        const f32x4 g0 = *(const f32x4*)(ng + h * 512 + 8 * I.lane), g1 = *(const f32x4*)(ng + h * 512 + 8 * I.lane + 4);
        const float gg[8] = {g0[0], g0[1], g0[2], g0[3], g1[0], g1[1], g1[2], g1[3]};
#pragma unroll
        for (int e = 0; e < 8; ++e) o[e] = o[e] * rs * gg[e] * (r[e] / (1.f + __expf(-r[e])));
        *(v4u*)(YG + off) = pack8(o);
    }
}

__device__ __forceinline__ void na_phase(Frame& F, int layer) {
    const Ids I = phase_ids(F.wv);
    const bf16* HB = WSP(const bf16, WS_HB); const bf16* VT = WSP(const bf16, WS_VT); bf16* YN = WSP(bf16, WS_YN);
    const float* rpb = INP(4) + (size_t)layer * 16 * 465;
    LAS float* rpbs = (LAS float*)F.lds;
    const int fr = I.lane & 15, q4 = I.lane >> 4;
    for (int it = blockIdx.x; it < 2048; it += I.G) {
        const int rblk = it & 7, cblk = (it >> 3) & 3, h = (it >> 5) & 15, b = it >> 9;
        __syncthreads();
        for (int i = I.tid; i < 465; i += 512) rpbs[i] = rpb[h * 465 + i];
        __syncthreads();
        const int r = rblk * 8 + I.wave, c0 = cblk * 16;
        const int rs = min(max(r - 4, 0), 56), cs = min(max(c0 - 8, 0), 32);
        const int mq = b * SEQ + r * 64 + c0 + fr;
        const bf16* qp = HB + (size_t)mq * LDH + H_NQ + h * 128 + 8 * q4;
        bf16x8 qf[4];
#pragma unroll
        for (int s = 0; s < 4; ++s) qf[s] = *(const bf16x8*)(qp + 32 * s);
        const int cq = c0 + fr, ws = min(max(cq - 8, 0), 48);
        f32x4 sc[8][2];
        float mx = -1e30f;
#pragma unroll
        for (int sp = 0; sp < 8; ++sp)
#pragma unroll
            for (int u = 0; u < 2; ++u) {
                const int coloff = 8 * (fr >> 2) + 4 * u + (fr & 3);
                const int mk = b * SEQ + (rs + sp) * 64 + cs + coloff;
                const bf16* kp = HB + (size_t)mk * LDH + H_NK + h * 128 + 8 * q4;
                f32x4 d = (f32x4){0.f, 0.f, 0.f, 0.f};
#pragma unroll
                for (int s = 0; s < 4; ++s) d = mfma16(*(const bf16x8*)(kp + 32 * s), qf[s], d);
                const int brow = (rs + sp - r + 7) * 31;
#pragma unroll
                for (int j = 0; j < 4; ++j) { const int kc = cs + 8 * q4 + 4 * u + j; const bool valid = (kc >= ws) && (kc < ws + 16);
                    const int bi = min(max(kc - cq + 15, 0), 30);
                    const float v = valid ? d[j] * 0.08838834764831845f + rpbs[brow + bi] : -1e30f;
                    sc[sp][u][j] = v; mx = fmaxf(mx, v); }
            }
        mx = fmaxf(mx, __shfl_xor(mx, 16)); mx = fmaxf(mx, __shfl_xor(mx, 32));
        float sum = 0.f;
        bf16x8 pf[8];
#pragma unroll
        for (int sp = 0; sp < 8; ++sp) { float p[8];
#pragma unroll
            for (int u = 0; u < 2; ++u)
#pragma unroll
                for (int j = 0; j < 4; ++j) { const float e = __builtin_amdgcn_exp2f((sc[sp][u][j] - mx) * 1.44269504f); p[4 * u + j] = e; sum += e; }
            const v4u w = pack8(p); pf[sp] = __builtin_bit_cast(bf16x8, w); }
        sum += __shfl_xor(sum, 16); sum += __shfl_xor(sum, 32);
        const float inv = 1.f / sum;
        const bf16* vp = VT + (size_t)(h * 128 + fr) * M + b * SEQ + rs * 64 + cs + 8 * q4;
#pragma unroll
        for (int dt = 0; dt < 8; ++dt) { f32x4 o = (f32x4){0.f, 0.f, 0.f, 0.f};
#pragma unroll
            for (int sp = 0; sp < 8; ++sp) o = mfma16(*(const bf16x8*)(vp + (size_t)(16 * dt) * M + sp * 64), pf[sp], o);
            v2u w; w.x = pk2(o[0] * inv, o[1] * inv); w.y = pk2(o[2] * inv, o[3] * inv);
            *(v2u*)(YN + (size_t)mq * BW + h * 128 + 16 * dt + 4 * q4) = w; }
    }
}

__device__ __forceinline__ float logsigmoidf_(float z) { return fminf(z, 0.f) - log1pf(__expf(-fabsf(z))); }
__device__ __forceinline__ void gla_prep_phase(Frame& F, int layer) {
    const Ids I = phase_ids(F.wv);
    constexpr int RS = 264;
    LAS bf16* qs = (LAS bf16*)F.lds; LAS bf16* ks = qs + 2 * 64 * RS; LAS float* gas = (LAS float*)(ks + 2 * 64 * RS);
    const bf16* HB = WSP(const bf16, WS_HB); const float* GA = WSP(const float, WS_GA);
    bf16* QIN = WSP(bf16, WS_QIN); bf16* KOT = WSP(bf16, WS_KOT); bf16* ATT = WSP(bf16, WS_ATT); float* DEC = WSP(float, WS_DEC);
    const float* wdec = INP(5) + (size_t)layer * 2 * 16 * 1024; const float* bdec = INP(6) + (size_t)layer * 2 * 1024;
    const int dir = I.tid >> 8, c = I.tid & 255, fr = I.lane & 15, q4 = I.lane >> 4;
    for (int it = blockIdx.x; it < 1024; it += I.G) {
        const int h = it & 3, chunk = (it >> 2) & 63, b = it >> 8, m0 = b * SEQ + chunk * 64, ch = h * 256 + c;
        __syncthreads();
        ((LAS f32x4*)gas)[I.tid] = ((const f32x4*)(GA + (size_t)m0 * 32))[I.tid];
        float w[16];
#pragma unroll
        for (int r = 0; r < 16; ++r) w[r] = wdec[(dir * 16 + r) * 1024 + ch];
        const float bd = bdec[dir * 1024 + ch];
        __syncthreads();
        const LAS float* ga = gas + dir * 16;
        float tot = 0.f;
#pragma unroll 4
        for (int t = 0; t < 64; ++t) { float z = bd;
#pragma unroll
            for (int r = 0; r < 16; ++r) z += ga[t * 32 + r] * w[r];
            tot += logsigmoidf_(z) * 0.0625f; }
        float run = 0.f; unsigned ko[32];
        const bf16* qg = HB + (size_t)m0 * LDH + H_GQ + ch; const bf16* kg = HB + (size_t)m0 * LDH + H_GK + ch;
        bf16* qo = QIN + ((size_t)dir * M + m0) * 1024 + ch;
#pragma unroll
        for (int tt = 0; tt < 32; ++tt) { float kov[2];
#pragma unroll
            for (int e = 0; e < 2; ++e) { const int t = 2 * tt + e; float z = bd;
#pragma unroll
                for (int r = 0; r < 16; ++r) z += ga[t * 32 + r] * w[r];
                const float la = logsigmoidf_(z) * 0.0625f; float cum;
                if (dir == 0) { run += la; cum = run; } else { cum = tot - run; run += la; }
                const float qv = bf1(qg[(size_t)t * LDH]), kv = bf1(kg[(size_t)t * LDH]);
                const float q_in = qv * 0.0625f * __expf(cum), k_in = kv * __expf(-cum); kov[e] = kv * __expf(tot - cum);
                const unsigned qb = pk2(q_in, 0.f) & 0xffffu, kb = pk2(k_in, 0.f) & 0xffffu;
                qs[(dir * 64 + t) * RS + c] = (bf16)qb; ks[(dir * 64 + t) * RS + c] = (bf16)kb; qo[(size_t)t * 1024] = (bf16)qb; }
            ko[tt] = pk2(kov[0], kov[1]); }
        { v4u* kd = (v4u*)(KOT + ((size_t)dir * 1024 + ch) * M + m0);
#pragma unroll
            for (int i = 0; i < 8; ++i) { v4u w4; w4.x = ko[4 * i]; w4.y = ko[4 * i + 1]; w4.z = ko[4 * i + 2]; w4.w = ko[4 * i + 3]; kd[i] = w4; } }
        DEC[(((size_t)dir * 4 + b) * 64 + chunk) * 1024 + ch] = __expf(tot);
        __syncthreads();
        { const int adir = I.wave >> 2, mt = I.wave & 3, i = 16 * mt + fr;
          const LAS bf16* qrow = qs + (adir * 64 + i) * RS + 8 * q4;
          bf16* arow = ATT + (((((size_t)adir * 4 + b) * 4 + h) * 64 + chunk) * 64 + i) * 64;
#pragma unroll
          for (int nt = 0; nt < 4; ++nt) { const LAS bf16* krow = ks + (adir * 64 + 16 * nt + fr) * RS + 8 * q4;
              f32x4 d = (f32x4){0.f, 0.f, 0.f, 0.f};
#pragma unroll
              for (int s = 0; s < 8; ++s) d = mfma16(*(const LAS bf16x8*)(krow + 32 * s), *(const LAS bf16x8*)(qrow + 32 * s), d);
              const int j0 = 16 * nt + 4 * q4; float v[4];
#pragma unroll
              for (int jj = 0; jj < 4; ++jj) { const bool keep = adir == 0 ? (j0 + jj <= i) : (j0 + jj >= i); v[jj] = keep ? d[jj] : 0.f; }
              v2u w2; w2.x = pk2(v[0], v[1]); w2.y = pk2(v[2], v[3]); *(v2u*)(arow + j0) = w2; } }
    }
}
__device__ __forceinline__ void gla_scan_phase(Frame& F) {
    const Ids I = phase_ids(F.wv);
    const bf16* VT = WSP(const bf16, WS_VT); const bf16* QIN = WSP(const bf16, WS_QIN); const bf16* KOT = WSP(const bf16, WS_KOT); const bf16* ATT = WSP(const bf16, WS_ATT);
    const float* DEC = WSP(const float, WS_DEC); float* O = WSP(float, WS_O);
    const int fr = I.lane & 15, q4 = I.lane >> 4;
    if (I.wave < 4)
    for (int task = blockIdx.x * 4 + I.wave; task < 1024; task += I.G * 4) {
        const int es = task & 31, dir = (task >> 5) & 1, h = (task >> 6) & 3, b = task >> 8;
        f32x4 st[16];
#pragma unroll
        for (int t = 0; t < 16; ++t) st[t] = (f32x4){0.f, 0.f, 0.f, 0.f};
        const bf16* vrow = VT + (size_t)(2048 + h * 512 + es * 16 + fr) * M + 8 * q4;
        for (int step = 0; step < 64; ++step) {
            const int c = dir ? 63 - step : step, m0 = b * SEQ + c * 64;
            bf16x8 sb[8];
#pragma unroll
            for (int s = 0; s < 8; ++s) { v4u w; w.x = pk2(st[2 * s][0], st[2 * s][1]); w.y = pk2(st[2 * s][2], st[2 * s][3]); w.z = pk2(st[2 * s + 1][0], st[2 * s + 1][1]); w.w = pk2(st[2 * s + 1][2], st[2 * s + 1][3]); sb[s] = __builtin_bit_cast(bf16x8, w); }
            bf16x8 vf[2];
#pragma unroll
            for (int sp = 0; sp < 2; ++sp) vf[sp] = *(const bf16x8*)(vrow + m0 + 32 * sp);
#pragma unroll
            for (int mt = 0; mt < 4; ++mt) { f32x4 o = (f32x4){0.f, 0.f, 0.f, 0.f};
                const bf16* qp = QIN + ((size_t)dir * M + m0 + 16 * mt + fr) * 1024 + h * 256 + 8 * q4;
#pragma unroll
                for (int s = 0; s < 8; ++s) o = mfma16(sb[s], *(const bf16x8*)(qp + 32 * s), o);
                const bf16* ap = ATT + (((((size_t)dir * 4 + b) * 4 + h) * 64 + c) * 64 + 16 * mt + fr) * 64 + 8 * q4;
#pragma unroll
                for (int sp = 0; sp < 2; ++sp) o = mfma16(vf[sp], *(const bf16x8*)(ap + 32 * sp), o);
                *(f32x4*)(O + ((size_t)dir * M + m0 + 16 * mt + fr) * 2048 + h * 512 + es * 16 + 4 * q4) = o; }
            const float* dp = DEC + (((size_t)dir * 4 + b) * 64 + c) * 1024 + h * 256 + 8 * q4;
#pragma unroll
            for (int s = 0; s < 8; ++s)
#pragma unroll
                for (int u = 0; u < 2; ++u) { const int t = 2 * s + u, dkrow = 32 * s + 8 * (fr >> 2) + 4 * u + (fr & 3);
                    const bf16* kp = KOT + ((size_t)dir * 1024 + h * 256 + dkrow) * M + m0 + 8 * q4;
                    const f32x4 dc = *(const f32x4*)(dp + 32 * s + 4 * u);
                    f32x4 a = st[t] * dc;
#pragma unroll
                    for (int sp = 0; sp < 2; ++sp) a = mfma16(*(const bf16x8*)(kp + 32 * sp), vf[sp], a);
                    st[t] = a; }
        }
    }
}


#ifndef PHM
#define PHM 0xffff
#endif
__global__ void __launch_bounds__(NWAVES * 64, 2) enc_fwd(Args args) {
    extern __shared__ __attribute__((aligned(16))) unsigned char lds[];
    Frame F;
    F.lds = (LAS unsigned char*)lds; F.wv = __builtin_amdgcn_readfirstlane(threadIdx.x >> 6);
    volatile LAS unsigned* MISC = (volatile LAS unsigned*)(F.lds + MISC_OFF);
    if (threadIdx.x < 128) MISC[threadIdx.x] = 0u;
    __syncthreads();
    (void)xcd_barrier_post((unsigned*)(GAS unsigned*)(args.ws + WS_CTL) + CW_BAR, MISC + 8);
#if MK_MULTI
#define IN(k) (kargs()->ph_lo <= (k) && (k) < kargs()->ph_hi)
#else
#define IN(k) true
#endif
#define SEAM(k) do { if (IN((k) + 1)) { XcdBarrier bb; bb.wv = (unsigned)F.wv; bb.bar = (unsigned*)(GAS unsigned*)(kargs()->ws + WS_CTL) + CW_BAR; bb.x = (unsigned)__builtin_amdgcn_readfirstlane((int)xb_xcc_id()); bb.st = (volatile LAS unsigned*)(F.lds + MISC_OFF) + 8; xcd_barrier(bb); } } while (0)
    LAS unsigned char* ring = F.lds;

    if (IN(0)) { if (PHM & 1) p0_prologue(F); SEAM(0); }

    for (int layer = 0; layer < DEPTH; ++layer) {
        const int pb = 1 + 11 * layer;
#define WL ((unsigned char*)(kargs()->ws + WS_W + (size_t)layer * SZ_WL))

        const pg8::bf16_t* XB = WSP(const pg8::bf16_t, WS_XB);
        if (IN(pb + 0)) { if (PHM & 2) {
            { pg8::Gemm g{XB, (const pg8::bf16_t*)(WL + OFF_WIN), M, NIN_MAIN, D}; pg8::StaticOrder S; S.init(M, NIN_MAIN, (int)gridDim.x, (int)blockIdx.x);
              pg8::EpiIn E{WSP(pg8::bf16_t, WS_HB), LDH, WSP(float, WS_GA), WSP(pg8::bf16_t, WS_GATES), INP(2) + (size_t)layer * 3 * D};
              pg8::gemm_phase<pg8::EpiIn, pg8::StaticOrder, true, true>(ring, g, S, E, F.wv); }
            { pg8::Gemm g{(const pg8::bf16_t*)(WL + OFF_WIN) + (size_t)NIN_MAIN * D, XB, 4096, M, D}; pg8::StaticOrder S; S.init(4096, M, (int)gridDim.x, (int)blockIdx.x);
              pg8::EpiBf16 E{WSP(pg8::bf16_t, WS_VT), M};
              pg8::gemm_phase<pg8::EpiBf16, pg8::StaticOrder, true, true>(ring, g, S, E, F.wv); } }
            SEAM(pb + 0);
        }
        if (IN(pb + 1)) { if (PHM & 4) conv_mixer_phase(F, layer); if (PHM & 8) gla_prep_phase(F, layer); if (PHM & 16) na_phase(F, layer); SEAM(pb + 1); }
        if (IN(pb + 2)) { if (PHM & 32) gla_scan_phase(F); SEAM(pb + 2); }
        if (IN(pb + 3)) { if (PHM & 64) gla_combine_phase(F, layer); SEAM(pb + 3); }
        if (IN(pb + 4)) { if (PHM & 128) {
            pg8::StaticOrder S; S.init(M, D, (int)gridDim.x, (int)blockIdx.x);
            { pg8::Gemm g{WSP(const pg8::bf16_t, WS_YC), (const pg8::bf16_t*)(WL + OFF_WBR), M, D, BW};
              pg8::EpiBranch<0> E{WSP(pg8::bf16_t, WS_MIXED), WSP(const pg8::bf16_t, WS_GATES)}; pg8::gemm_phase<pg8::EpiBranch<0>, pg8::StaticOrder, true, true>(ring, g, S, E, F.wv); }
            { pg8::Gemm g{WSP(const pg8::bf16_t, WS_YN), (const pg8::bf16_t*)(WL + OFF_WBR) + (size_t)D * BW, M, D, BW};
              pg8::EpiBranch<1> E{WSP(pg8::bf16_t, WS_MIXED), WSP(const pg8::bf16_t, WS_GATES)}; pg8::gemm_phase<pg8::EpiBranch<1>, pg8::StaticOrder, true, true>(ring, g, S, E, F.wv); }
            { pg8::Gemm g{WSP(const pg8::bf16_t, WS_YG), (const pg8::bf16_t*)(WL + OFF_WBR) + (size_t)2 * D * BW, M, D, BW};
              pg8::EpiBranch<2> E{WSP(pg8::bf16_t, WS_MIXED), WSP(const pg8::bf16_t, WS_GATES)}; pg8::gemm_phase<pg8::EpiBranch<2>, pg8::StaticOrder, true, true>(ring, g, S, E, F.wv); } }
            SEAM(pb + 4);
        }
        const float* xres = layer == 0 ? INP(0) : WSP(const float, WS_XR);
        if (IN(pb + 5)) { if (PHM & 256) {
            pg8::Gemm g{WSP(const pg8::bf16_t, WS_MIXED), (const pg8::bf16_t*)(WL + OFF_WO), M, D, D}; pg8::StaticOrder S; S.init(M, D, (int)gridDim.x, (int)blockIdx.x);
            pg8::EpiResid E{WSP(float, WS_XR), xres, D, ALPHA}; pg8::gemm_phase<pg8::EpiResid, pg8::StaticOrder, true, true>(ring, g, S, E, F.wv); }
            SEAM(pb + 5);
        }
        if (IN(pb + 6)) { if (PHM & 512) ln_phase(F, WSP(const float, WS_XR), INP(10) + (size_t)layer * D, INP(11) + (size_t)layer * D, WSP(float, WS_XR), WSP(bf16, WS_XB)); SEAM(pb + 6); }
        if (IN(pb + 7)) { if (PHM & 1024) {
            pg8::Gemm g{XB, (const pg8::bf16_t*)(WL + OFF_WFI), M, 2 * FF, D}; pg8::StaticOrder S; S.init(M, 2 * FF, (int)gridDim.x, (int)blockIdx.x);
            pg8::EpiBf16 E{WSP(pg8::bf16_t, WS_AU), 2 * FF}; pg8::gemm_phase<pg8::EpiBf16, pg8::StaticOrder, true, true>(ring, g, S, E, F.wv); }
            SEAM(pb + 7);
        }
        if (IN(pb + 8)) { if (PHM & 2048) convglu_phase(F, layer); SEAM(pb + 8); }
        if (IN(pb + 9)) { if (PHM & 4096) {
            pg8::Gemm g{WSP(const pg8::bf16_t, WS_G), (const pg8::bf16_t*)(WL + OFF_WFO), M, D, FF}; pg8::StaticOrder S; S.init(M, D, (int)gridDim.x, (int)blockIdx.x);
            pg8::EpiResid E{WSP(float, WS_XR), WSP(const float, WS_XR), D, ALPHA}; pg8::gemm_phase<pg8::EpiResid, pg8::StaticOrder, true, true>(ring, g, S, E, F.wv); }
            SEAM(pb + 9);
        }
        if (IN(pb + 10)) { if (PHM & 8192) ln_phase(F, WSP(const float, WS_XR), INP(16) + (size_t)layer * D, INP(17) + (size_t)layer * D, layer == DEPTH - 1 ? OUTP : WSP(float, WS_XR), WSP(bf16, WS_XB)); SEAM(pb + 10); }
    }
#undef IN
#undef SEAM
}

extern "C" void kernel_launch(void* const* d_in, const int* in_sizes, int n_in, void* d_out, int out_size, void* d_ws, size_t ws_size, hipStream_t stream) {
    static int grid = 0;
    if (grid == 0) {
        if (n_in != 18 || in_sizes[0] != M * D || out_size != M * D || ws_size < WS_END) { fprintf(stderr, "kernel_launch: unexpected sizes: n_in %d in0 %d out %d ws %zu (need %zu); nothing launched\n", n_in, n_in > 0 ? in_sizes[0] : -1, out_size, ws_size, (size_t)WS_END); grid = -1; return; }
        int dev = 0, cus = 0, per_cu = 0;
        if (hipGetDevice(&dev) != hipSuccess || hipDeviceGetAttribute(&cus, hipDeviceAttributeMultiprocessorCount, dev) != hipSuccess) { grid = -1; return; }
        if (hipFuncSetAttribute((const void*)enc_fwd, hipFuncAttributeMaxDynamicSharedMemorySize, LDS_BYTES) != hipSuccess) { fprintf(stderr, "kernel_launch: hipFuncSetAttribute failed\n"); grid = -1; return; }
        if (hipOccupancyMaxActiveBlocksPerMultiprocessor(&per_cu, (const void*)enc_fwd, NWAVES * 64, LDS_BYTES) != hipSuccess || per_cu < 1) { fprintf(stderr, "kernel_launch: occupancy query reports %d workgroups per CU\n", per_cu); grid = -1; (void)hipGetLastError(); return; }
        (void)hipGetLastError();
        grid = cus;
    }
    if (grid < 0) return;
    if (hipMemsetAsync((char*)d_ws + WS_CTL, 0, CTL_ZERO_BYTES, stream) != hipSuccess) return;
    Args a{};
    for (int i = 0; i < 18; ++i) a.in[i] = (GAS const float*)d_in[i];
    a.out = (GAS float*)d_out; a.ws = (GAS unsigned char*)d_ws;
#if MK_MULTI
    for (int p = 0; p < N_PHASES; ++p) { a.ph_lo = p; a.ph_hi = p + 1; hipLaunchKernelGGL(enc_fwd, dim3(grid), dim3(NWAVES * 64), LDS_BYTES, stream, a); }
#else
    a.ph_lo = 0; a.ph_hi = N_PHASES;
    hipLaunchKernelGGL(enc_fwd, dim3(grid), dim3(NWAVES * 64), LDS_BYTES, stream, a);
#endif
}
```

```cpp
#include <hip/hip_runtime.h>
#include <cstdio>
#include <cstdint>
namespace pg8 {
#define PG8_LAS __attribute__((address_space(3)))
typedef unsigned short bf16_t;
typedef short bf16x8 __attribute__((ext_vector_type(8)));
typedef float f32x4 __attribute__((ext_vector_type(4)));
typedef unsigned u32x4 __attribute__((ext_vector_type(4)));
constexpr int BM = 256, BK = 64, HALF = 128, HTB = HALF * BK * 2  , STAGE_BYTES = 8 * HTB, NXCD = 8, WGM = 8;

__host__ __device__ __forceinline__ int lds_byte(int r, int c) { const int st = (r >> 4) * 2 + (c >> 5), rr = r & 15, cc = c & 31, ob = rr * 64 + cc * 2; return st * 1024 + (ob ^ (((ob >> 9) & 1) << 5)); }
__host__ __device__ __forceinline__ void stage_rc(int b, int& R, int& C) { const int st = b / 1024, sb = b % 1024, swz = sb ^ (((sb >> 9) & 1) << 5); R = (st >> 1) * 16 + swz / 64; C = (st & 1) * 32 + (swz % 64) / 2; }
__host__ __device__ __forceinline__ int perm32(int rho) { const int n = rho >> 4, i = rho & 15; return 8 * (i >> 2) + 4 * n + (i & 3); }

struct Unit { int pm, pn; };
struct Gemm { const bf16_t* A; const bf16_t* Bt; int M, N, K; };

struct StaticOrder {
    int nM, nN, nwg, G, c;
    __host__ __device__ void init(int M, int N, int G_, int c_) { nM = M / BM; nN = N / BM; nwg = nM * nN; G = G_; c = c_; }
    __host__ __device__ bool next(int i, Unit& u) const {
        const long L = (long)i * G + c; if (L >= nwg) return false;
        int wgid = (int)L; { const int q = nwg / NXCD, r = nwg % NXCD, xcd = wgid % NXCD, off = wgid / NXCD; wgid = (xcd < r ? xcd * (q + 1) : r * (q + 1) + (xcd - r) * q) + off; }
        const int nig = WGM * nN, gid = wgid / nig, fm = gid * WGM, gsz = (nM - fm) < WGM ? (nM - fm) : WGM;
        u.pm = fm + ((wgid % nig) % gsz); u.pn = (wgid % nig) / gsz; return true;
    }
    __device__ __forceinline__ void a_ready(const Unit&) const {}
    __device__ __forceinline__ void done(const Unit&) const {}
};

__device__ __forceinline__ unsigned cvt_pk_bf16(float lo, float hi) { unsigned r; asm volatile("v_cvt_pk_bf16_f32 %0, %1, %2" : "=v"(r) : "v"(lo), "v"(hi)); return r; }
typedef float f32x2 __attribute__((ext_vector_type(2)));
__device__ __forceinline__ f32x2 gelu_pk(f32x2 v) {
    const f32x2 av = __builtin_elementwise_abs(v), d = av * 0.2316418882f + 1.0f;
    f32x2 t; t.x = __builtin_amdgcn_rcpf(d.x); t.y = __builtin_amdgcn_rcpf(d.y);
    f32x2 q = t * 0.5307027145f + (-0.7265760135f); q = q * t + 0.7107068705f; q = q * t + (-0.142248368f); q = q * t + 0.127414796f; q = q * t;
    const f32x2 s = (v * v) * (-0.72134752044f);
    f32x2 e; e.x = __builtin_amdgcn_exp2f(s.x); e.y = __builtin_amdgcn_exp2f(s.y);
    const f32x2 m = v * (q * e), r = v - m;
    f32x2 o; o.x = v.x < 0.f ? m.x : r.x; o.y = v.y < 0.f ? m.y : r.y; return o;
}

__device__ __forceinline__ float bf_lo(unsigned w) { return __uint_as_float(w << 16); }
__device__ __forceinline__ float bf_hi(unsigned w) { return __uint_as_float(w & 0xffff0000u); }
__device__ __forceinline__ float sigmoidf_fast(float v) { return __builtin_amdgcn_rcpf(1.0f + __builtin_amdgcn_exp2f(-1.44269504f * v)); }

struct EpiBf16 {
    static constexpr bool PERM = true, AFTER_DRAIN = false;
    bf16_t* O; int ldc;
    __device__ __forceinline__ void operator()(const f32x4 (&acc)[2][2][4][2], const Unit& u, int wr, int wc, int fr, int fq) const {
        asm volatile("" : "+v"(fr), "+v"(fq));
        const int row0 = u.pm * BM + wr * 64 + fr, col0 = u.pn * BM + wc * 32 + 8 * fq;
#pragma unroll
        for (int ai = 0; ai < 2; ++ai)
#pragma unroll
            for (int m = 0; m < 4; ++m) { bf16_t* rowp = O + (size_t)(row0 + ai * HALF + m * 16) * ldc + col0;
#pragma unroll
                for (int bj = 0; bj < 2; ++bj) { const f32x4 v0 = acc[ai][bj][m][0], v1 = acc[ai][bj][m][1];
                    u32x4 w; w.x = cvt_pk_bf16(v0[0], v0[1]); w.y = cvt_pk_bf16(v0[2], v0[3]); w.z = cvt_pk_bf16(v1[0], v1[1]); w.w = cvt_pk_bf16(v1[2], v1[3]);
                    *(u32x4*)(rowp + bj * HALF) = w; } }
    }
};
struct EpiIn {
    static constexpr bool PERM = true, AFTER_DRAIN = false;
    bf16_t* HB; int ldh; float* GA; bf16_t* GATES; const float* bgate;
    __device__ __forceinline__ void operator()(const f32x4 (&acc)[2][2][4][2], const Unit& u, int wr, int wc, int fr, int fq) const {
        asm volatile("" : "+v"(fr), "+v"(fq));
        const int row0 = u.pm * BM + wr * 64 + fr;
        if (u.pn < 56) {
            const int col0 = u.pn * BM + wc * 32 + 8 * fq;
#pragma unroll
            for (int ai = 0; ai < 2; ++ai)
#pragma unroll
                for (int m = 0; m < 4; ++m) { bf16_t* rowp = HB + (size_t)(row0 + ai * HALF + m * 16) * ldh + col0;
#pragma unroll
                    for (int bj = 0; bj < 2; ++bj) { const f32x4 v0 = acc[ai][bj][m][0], v1 = acc[ai][bj][m][1];
                        u32x4 w; w.x = cvt_pk_bf16(v0[0], v0[1]); w.y = cvt_pk_bf16(v0[2], v0[3]); w.z = cvt_pk_bf16(v1[0], v1[1]); w.w = cvt_pk_bf16(v1[2], v1[3]);
                        *(u32x4*)(rowp + bj * HALF) = w; } }
        } else if (u.pn == 56) {
            if (wc == 0) {
#pragma unroll
                for (int ai = 0; ai < 2; ++ai)
#pragma unroll
                    for (int m = 0; m < 4; ++m) { float* rowp = GA + (size_t)(row0 + ai * HALF + m * 16) * 32 + 8 * fq;
                        *(f32x4*)rowp = acc[ai][0][m][0]; *(f32x4*)(rowp + 4) = acc[ai][0][m][1]; }
            }
        } else {
            const int col0 = (u.pn - 57) * BM + wc * 32 + 8 * fq;
#pragma unroll
            for (int ai = 0; ai < 2; ++ai)
#pragma unroll
                for (int m = 0; m < 4; ++m) { bf16_t* rowp = GATES + (size_t)(row0 + ai * HALF + m * 16) * 12288 + col0;
                    asm volatile("" ::: "memory");
#pragma unroll
                    for (int bj = 0; bj < 2; ++bj) { const f32x4 v0 = acc[ai][bj][m][0] + *(const f32x4*)(bgate + col0 + bj * HALF), v1 = acc[ai][bj][m][1] + *(const f32x4*)(bgate + col0 + bj * HALF + 4);
                        u32x4 w; w.x = cvt_pk_bf16(sigmoidf_fast(v0[0]), sigmoidf_fast(v0[1])); w.y = cvt_pk_bf16(sigmoidf_fast(v0[2]), sigmoidf_fast(v0[3]));
                        w.z = cvt_pk_bf16(sigmoidf_fast(v1[0]), sigmoidf_fast(v1[1])); w.w = cvt_pk_bf16(sigmoidf_fast(v1[2]), sigmoidf_fast(v1[3]));
                        *(u32x4*)(rowp + bj * HALF) = w; } }
        }
    }
};
template <int I> struct EpiBranch {
    static constexpr bool PERM = true, AFTER_DRAIN = false;
    bf16_t* MIXED; const bf16_t* GATES;
    __device__ __forceinline__ void operator()(const f32x4 (&acc)[2][2][4][2], const Unit& u, int wr, int wc, int fr, int fq) const {
        asm volatile("" : "+v"(fr), "+v"(fq));
        const int row0 = u.pm * BM + wr * 64 + fr, col0 = u.pn * BM + wc * 32 + 8 * fq;
#pragma unroll
        for (int ai = 0; ai < 2; ++ai)
#pragma unroll
            for (int m = 0; m < 4; ++m) { const size_t r = (size_t)(row0 + ai * HALF + m * 16);
                asm volatile("" ::: "memory");
#pragma unroll
                for (int bj = 0; bj < 2; ++bj) {
                    const u32x4 g = *(const u32x4*)(GATES + r * 12288 + I * 4096 + col0 + bj * HALF);
                    bf16_t* mp = MIXED + r * 4096 + col0 + bj * HALF;
                    u32x4 p = (u32x4){0u, 0u, 0u, 0u}; if (I) p = *(const u32x4*)mp;
                    const f32x4 a0 = acc[ai][bj][m][0], a1 = acc[ai][bj][m][1];
                    u32x4 w;
                    w.x = cvt_pk_bf16(bf_lo(p.x) + bf_lo(g.x) * a0[0], bf_hi(p.x) + bf_hi(g.x) * a0[1]);
                    w.y = cvt_pk_bf16(bf_lo(p.y) + bf_lo(g.y) * a0[2], bf_hi(p.y) + bf_hi(g.y) * a0[3]);
                    w.z = cvt_pk_bf16(bf_lo(p.z) + bf_lo(g.z) * a1[0], bf_hi(p.z) + bf_hi(g.z) * a1[1]);
                    w.w = cvt_pk_bf16(bf_lo(p.w) + bf_lo(g.w) * a1[2], bf_hi(p.w) + bf_hi(g.w) * a1[3]);
                    *(u32x4*)mp = w; } }
    }
};
struct EpiResid {
    static constexpr bool PERM = false, AFTER_DRAIN = false;
    float* V; const float* xres; int ldc; float alpha;
    __device__ __forceinline__ void operator()(const f32x4 (&acc)[2][2][4][2], const Unit& u, int wr, int wc, int fr, int fq) const {
        asm volatile("" : "+v"(fr), "+v"(fq));
        const int row0 = u.pm * BM + wr * 64 + fr, col0 = u.pn * BM + wc * 32 + 4 * fq;
#pragma unroll
        for (int ai = 0; ai < 2; ++ai)
#pragma unroll
            for (int m = 0; m < 4; ++m) { const size_t off = (size_t)(row0 + ai * HALF + m * 16) * ldc + col0;
                asm volatile("" ::: "memory");
#pragma unroll
                for (int bj = 0; bj < 2; ++bj)
#pragma unroll
                    for (int n = 0; n < 2; ++n) { const f32x4 xr = *(const f32x4*)(xres + off + bj * HALF + n * 16);
                        *(f32x4*)(V + off + bj * HALF + n * 16) = xr * alpha + acc[ai][bj][m][n]; } }
    }
};

template <class Epi, class Sched, bool ALIGN_EPI = false, bool SP2 = false>
__device__ __forceinline__ void gemm_phase(PG8_LAS unsigned char* lds, const Gemm g, const Sched& S, const Epi& E, const int wv  ) {
    int tid_ = wv * 64 + (int)__builtin_amdgcn_mbcnt_hi(~0u, __builtin_amdgcn_mbcnt_lo(~0u, 0u)); asm volatile("" : "+v"(tid_));
    const int tid = tid_, wid = __builtin_amdgcn_readfirstlane(tid >> 6), lane = tid & 63, wr = wid >> 2, wc = wid & 3, fr = lane & 15, fq = lane >> 4;
    const int K = g.K, nt = K / BK;
    unsigned voffA[2], voffB[2];
#pragma unroll
    for (int i = 0; i < 2; ++i) { int R, C; stage_rc(tid * 16 + i * 8192, R, C); const int Rb = Epi::PERM ? ((R & ~31) + perm32(R & 31)) : R;
        voffA[i] = (unsigned)(R * K + C) * 2u; voffB[i] = (unsigned)(Rb * K + C) * 2u; }
    const size_t kstep = (size_t)(BK * 2);
    const size_t hstep = (size_t)HALF * K * 2;
    const size_t tstep = 2 * hstep;
    const unsigned ldsw = (unsigned)wid * 1024u;
    const int aoff = lds_byte(wr * 64 + fr, fq * 8), boff = lds_byte(wc * 32 + fr, fq * 8);
#define PG8_SA(b, h) (((b) * 2 + (h)) * HTB)
#define PG8_SB(b, h) ((4 + (b) * 2 + (h)) * HTB)
#define PG8_STAGE(bufoff, gbase, voff) do { _Pragma("unroll") for (int _i = 0; _i < 2; ++_i) \
        __builtin_amdgcn_global_load_lds((const unsigned*)((const char*)(gbase) + (voff)[_i]), (PG8_LAS unsigned*)(lds + (bufoff) + ldsw + _i * 8192), 16, 0, 0); } while (0)
#define PG8_LDA(dst, b, h) do { _Pragma("unroll") for (int m = 0; m < 4; ++m) _Pragma("unroll") for (int k = 0; k < 2; ++k) dst[m][k] = *(const PG8_LAS bf16x8*)(lds + PG8_SA(b, h) + aoff + m * 2048 + k * 1024); } while (0)
#define PG8_LDB(dst, b, h) do { _Pragma("unroll") for (int n = 0; n < 2; ++n) _Pragma("unroll") for (int k = 0; k < 2; ++k) dst[n][k] = *(const PG8_LAS bf16x8*)(lds + PG8_SB(b, h) + boff + n * 2048 + k * 1024); } while (0)
#define PG8_MMA(ai, bj, At, Bt) do { __builtin_amdgcn_s_setprio(1); _Pragma("unroll") for (int m = 0; m < 4; ++m) _Pragma("unroll") for (int n = 0; n < 2; ++n) _Pragma("unroll") for (int k = 0; k < 2; ++k) \
        acc[ai][bj][m][n] = __builtin_amdgcn_mfma_f32_16x16x32_bf16(Bt[n][k], At[m][k], acc[ai][bj][m][n], 0, 0, 0); __builtin_amdgcn_s_setprio(0); } while (0)
#define PG8_WAIT_V(n) asm volatile("s_waitcnt vmcnt(" #n ")" ::: "memory")
#define PG8_WAIT_L(n) asm volatile("s_waitcnt lgkmcnt(" #n ")" ::: "memory")
#define PG8_BAR __builtin_amdgcn_s_barrier()
#define PG8_SCHED __builtin_amdgcn_sched_barrier(0)
    Unit cur, nxt; int ui = 0;
    if (!S.next(0, cur)) return;
    f32x4 acc[2][2][4][2];
#pragma unroll
    for (int a = 0; a < 2; ++a)
#pragma unroll
        for (int b = 0; b < 2; ++b)
#pragma unroll
            for (int m = 0; m < 4; ++m)
#pragma unroll
                for (int n = 0; n < 2; ++n) acc[a][b][m][n] = (f32x4){0.f, 0.f, 0.f, 0.f};
    bf16x8 At[4][2], B0[2][2], B1[2][2];
    const char* cA = (const char*)g.A + (size_t)cur.pm * tstep; const char* cB = (const char*)g.Bt + (size_t)cur.pn * tstep;
    S.a_ready(cur);
    if constexpr (SP2) {
        PG8_STAGE(PG8_SB(0, 0), cB, voffB); PG8_STAGE(PG8_SB(0, 1), cB + hstep, voffB); PG8_STAGE(PG8_SA(0, 0), cA, voffA); PG8_STAGE(PG8_SA(0, 1), cA + hstep, voffA);
        if (wr == 1) PG8_BAR;
        PG8_WAIT_V(2); PG8_BAR;
        PG8_STAGE(PG8_SB(1, 0), cB + kstep, voffB); PG8_STAGE(PG8_SA(1, 0), cA + kstep, voffA); PG8_STAGE(PG8_SB(1, 1), cB + hstep + kstep, voffB);
        PG8_WAIT_V(6); PG8_BAR;
    } else {
        PG8_STAGE(PG8_SB(0, 0), cB, voffB); PG8_STAGE(PG8_SA(0, 0), cA, voffA); PG8_STAGE(PG8_SB(0, 1), cB + hstep, voffB); PG8_STAGE(PG8_SA(0, 1), cA + hstep, voffA);
        if (wr == 1) PG8_BAR;
        PG8_WAIT_V(4); PG8_BAR;
        PG8_STAGE(PG8_SB(1, 0), cB + kstep, voffB); PG8_STAGE(PG8_SA(1, 0), cA + kstep, voffA); PG8_STAGE(PG8_SB(1, 1), cB + hstep + kstep, voffB);
        PG8_WAIT_V(6); PG8_BAR;
    }
    for (;;) {
        const bool has_next = S.next(ui + 1, nxt);
        const char* nA = has_next ? (const char*)g.A + (size_t)nxt.pm * tstep : cA; const char* nB = has_next ? (const char*)g.Bt + (size_t)nxt.pn * tstep : cB;
        for (int t = 0; t < nt; t += 2) {
            const bool last = (t == nt - 2);
            const char* a1 = cA + (size_t)(t + 1) * kstep;
            const char* a2 = last ? nA : cA + (size_t)(t + 2) * kstep; const char* b2 = last ? nB : cB + (size_t)(t + 2) * kstep;
            const char* a3 = a2 + kstep; const char* b3 = b2 + kstep;
            if (last && has_next) S.a_ready(nxt);
            if constexpr (SP2) {
            PG8_LDB(B0, 0, 0); PG8_LDB(B1, 0, 1); PG8_SCHED; PG8_LDA(At, 0, 0); PG8_STAGE(PG8_SA(1, 1), a1 + hstep, voffA);
            PG8_WAIT_V(8); PG8_WAIT_L(0); PG8_BAR; PG8_MMA(0, 0, At, B0); PG8_MMA(0, 1, At, B1); PG8_BAR; PG8_SCHED;
            PG8_LDA(At, 0, 1); PG8_STAGE(PG8_SB(0, 0), b2, voffB); PG8_STAGE(PG8_SB(0, 1), b2 + hstep, voffB); PG8_STAGE(PG8_SA(0, 0), a2, voffA);
            PG8_WAIT_V(8); PG8_WAIT_L(0); PG8_BAR; PG8_MMA(1, 0, At, B0); PG8_MMA(1, 1, At, B1); PG8_BAR; PG8_SCHED;
            PG8_LDB(B0, 1, 0); PG8_LDB(B1, 1, 1); PG8_SCHED; PG8_LDA(At, 1, 0); PG8_STAGE(PG8_SA(0, 1), a2 + hstep, voffA);
            PG8_WAIT_V(8); PG8_WAIT_L(0); PG8_BAR; PG8_MMA(0, 0, At, B0); PG8_MMA(0, 1, At, B1); PG8_BAR; PG8_SCHED;
            PG8_LDA(At, 1, 1); PG8_STAGE(PG8_SB(1, 0), b3, voffB); PG8_STAGE(PG8_SB(1, 1), b3 + hstep, voffB); PG8_STAGE(PG8_SA(1, 0), a3, voffA);
            PG8_WAIT_V(8); PG8_WAIT_L(0); PG8_BAR; PG8_MMA(1, 0, At, B0); PG8_MMA(1, 1, At, B1); PG8_BAR; PG8_SCHED;
            } else {
            PG8_LDB(B0, 0, 0); PG8_SCHED; PG8_LDA(At, 0, 0); PG8_STAGE(PG8_SA(1, 1), a1 + hstep, voffA);
            PG8_WAIT_L(8); PG8_BAR; PG8_WAIT_L(0); PG8_MMA(0, 0, At, B0); PG8_BAR; PG8_SCHED;
            PG8_LDB(B1, 0, 1); PG8_STAGE(PG8_SB(0, 0), b2, voffB);
            PG8_BAR; PG8_WAIT_L(0); PG8_MMA(0, 1, At, B1); PG8_BAR;
            PG8_LDA(At, 0, 1); PG8_STAGE(PG8_SA(0, 0), a2, voffA);
            PG8_BAR; PG8_WAIT_L(0); PG8_MMA(1, 0, At, B0); PG8_BAR; PG8_SCHED;
            PG8_STAGE(PG8_SB(0, 1), b2 + hstep, voffB);
            PG8_WAIT_V(6); PG8_BAR; PG8_MMA(1, 1, At, B1); PG8_BAR;
            PG8_LDB(B0, 1, 0); PG8_SCHED; PG8_LDA(At, 1, 0); PG8_STAGE(PG8_SA(0, 1), a2 + hstep, voffA);
            PG8_WAIT_L(8); PG8_BAR; PG8_WAIT_L(0); PG8_MMA(0, 0, At, B0); PG8_BAR; PG8_SCHED;
            PG8_LDB(B1, 1, 1); PG8_STAGE(PG8_SB(1, 0), b3, voffB);
            PG8_BAR; PG8_WAIT_L(0); PG8_MMA(0, 1, At, B1); PG8_BAR;
            PG8_LDA(At, 1, 1); PG8_STAGE(PG8_SA(1, 0), a3, voffA);
            PG8_BAR; PG8_WAIT_L(0); PG8_MMA(1, 0, At, B0); PG8_BAR; PG8_SCHED;
            PG8_STAGE(PG8_SB(1, 1), b3 + hstep, voffB);
            PG8_WAIT_V(6); PG8_BAR; PG8_MMA(1, 1, At, B1); PG8_BAR;
            }
        }
        if constexpr (ALIGN_EPI) { if (wr == 0) PG8_BAR; }
        if constexpr (!Epi::AFTER_DRAIN) { E(acc, cur, wr, wc, fr, fq); S.done(cur); }
        if (!has_next) break;
#pragma unroll
        for (int a = 0; a < 2; ++a)
#pragma unroll
            for (int b = 0; b < 2; ++b)
#pragma unroll
                for (int m = 0; m < 4; ++m)
#pragma unroll
                    for (int n = 0; n < 2; ++n) acc[a][b][m][n] = (f32x4){0.f, 0.f, 0.f, 0.f};
        cur = nxt; cA = nA; cB = nB; ++ui;
        if constexpr (ALIGN_EPI) { if (wr == 1) PG8_BAR; }
    }
    PG8_WAIT_V(0);
    if constexpr (!ALIGN_EPI) { if (wr == 0) PG8_BAR; }
    PG8_BAR;
    if constexpr (Epi::AFTER_DRAIN) { E.fused(acc, cur, wr, wc, fr, fq, lds, wid, lane); S.done(cur); }
#undef PG8_SA
#undef PG8_SB
#undef PG8_STAGE
#undef PG8_LDA
#undef PG8_LDB
#undef PG8_MMA
#undef PG8_WAIT_V
#undef PG8_WAIT_L
#undef PG8_BAR
#undef PG8_SCHED
}
}

constexpr int NWAVES = 8;
constexpr int NB = 4, SEQ = 4096, M = NB * SEQ, D = 4096, BW = 2048, FF = 11008, DEPTH = 2;
constexpr int IN_WIDTH = 30752;
constexpr int NIN_MAIN = 26880, NIN_PAD = 30976;
constexpr int LDH = 14336;
constexpr int H_CB = 0, H_CC = 2048, H_CH = 4096, H_NQ = 6144, H_NK = 8192, H_GQ = 10240, H_GK = 11264, H_GR = 12288;
constexpr float LN_EPS = 1e-5f, RMS_EPS = 1e-6f, ALPHA = 1.41421356237f;
#ifndef MK_MULTI
#define MK_MULTI 0
#endif
constexpr int N_PHASES = 1 + 11 * DEPTH;

constexpr size_t MiB = 1u << 20;
constexpr size_t alm(size_t x) { return (x + MiB - 1) / MiB * MiB; }
constexpr size_t WS_CTL = 0, CTL_ZERO_BYTES = 1 * MiB;
constexpr size_t SZ_WIN = alm((size_t)NIN_PAD * D * 2), SZ_WBR = alm((size_t)3 * D * BW * 2), SZ_WO = alm((size_t)D * D * 2), SZ_WFI = alm((size_t)2 * FF * D * 2), SZ_WFO = alm((size_t)D * FF * 2);
constexpr size_t OFF_WIN = 0, OFF_WBR = OFF_WIN + SZ_WIN, OFF_WO = OFF_WBR + SZ_WBR, OFF_WFI = OFF_WO + SZ_WO, OFF_WFO = OFF_WFI + SZ_WFI, SZ_WL = OFF_WFO + SZ_WFO;
constexpr size_t WS_W = 1 * MiB;
constexpr size_t WS_XB = WS_W + DEPTH * SZ_WL;
constexpr size_t WS_XR = WS_XB + alm((size_t)M * D * 2);
constexpr size_t WS_U = WS_XR + alm((size_t)M * D * 4);
constexpr size_t WS_HB = WS_U;
constexpr size_t WS_GA = WS_HB + alm((size_t)M * LDH * 2);
constexpr size_t WS_GATES = WS_GA + alm((size_t)M * 32 * 4);
constexpr size_t WS_VT = WS_GATES + alm((size_t)M * 12288 * 2);
constexpr size_t WS_YC = WS_VT + alm((size_t)4096 * M * 2);
constexpr size_t WS_YN = WS_YC + alm((size_t)M * BW * 2);
constexpr size_t WS_YG = WS_YN + alm((size_t)M * BW * 2);
constexpr size_t WS_QIN = WS_YG + alm((size_t)M * BW * 2);
constexpr size_t WS_KOT = WS_QIN + alm((size_t)2 * M * 1024 * 2);
constexpr size_t WS_ATT = WS_KOT + alm((size_t)2 * 1024 * M * 2);
constexpr size_t WS_DEC = WS_ATT + alm((size_t)2 * 4 * 4 * 64 * 64 * 64 * 2);
constexpr size_t WS_O = WS_DEC + alm((size_t)2 * 4 * 64 * 1024 * 4);
constexpr size_t WS_MIXED = WS_O + alm((size_t)2 * M * 2048 * 4);
constexpr size_t WS_END = WS_MIXED + alm((size_t)M * D * 2);
constexpr size_t WS_AU = WS_U;
constexpr size_t WS_G = WS_AU + alm((size_t)M * 2 * FF * 2);
static_assert(WS_G + alm((size_t)M * FF * 2) <= WS_MIXED, "the FFN overlay must stay below MIXED");
static_assert(WS_END <= (size_t)3844 * MiB, "d_ws budget: 4 x the largest input tensor");
constexpr int CW_BAR = 4096;

constexpr int RING_BYTES = 131072;
constexpr int LDS_BYTES = 147456;
constexpr int MISC_OFF = LDS_BYTES - 512;

#define GAS __attribute__((address_space(1)))
#define LAS __attribute__((address_space(3)))
typedef unsigned short bf16;
typedef unsigned v4u __attribute__((ext_vector_type(4)));
typedef unsigned v2u __attribute__((ext_vector_type(2)));
typedef float f32x4 __attribute__((ext_vector_type(4)));
typedef short bf16x8 __attribute__((ext_vector_type(8)));
typedef GAS unsigned gu32;
#define LDS_WAIT() asm volatile("s_waitcnt lgkmcnt(0)" ::: "memory")
#define VM_WAIT() asm volatile("s_waitcnt vmcnt(0)" ::: "memory")
__device__ __forceinline__ unsigned pk2(float lo, float hi) { return pg8::cvt_pk_bf16(lo, hi); }
__device__ __forceinline__ float bflo(unsigned w) { return __uint_as_float(w << 16); }
__device__ __forceinline__ float bfhi(unsigned w) { return __uint_as_float(w & 0xffff0000u); }
__device__ __forceinline__ float bf1(bf16 b) { return __uint_as_float(((unsigned)b) << 16); }
__device__ __forceinline__ void unpack8(const v4u w, float (&f)[8]) { f[0] = bflo(w.x); f[1] = bfhi(w.x); f[2] = bflo(w.y); f[3] = bfhi(w.y); f[4] = bflo(w.z); f[5] = bfhi(w.z); f[6] = bflo(w.w); f[7] = bfhi(w.w); }
__device__ __forceinline__ v4u pack8(const float (&f)[8]) { v4u w; w.x = pk2(f[0], f[1]); w.y = pk2(f[2], f[3]); w.z = pk2(f[4], f[5]); w.w = pk2(f[6], f[7]); return w; }
__device__ __forceinline__ float wave_sum(float v) {
#pragma unroll
    for (int o = 1; o < 64; o <<= 1) v += __shfl_xor(v, o);
    return v;
}
__device__ __forceinline__ f32x4 mfma16(bf16x8 a, bf16x8 b, f32x4 c) { return __builtin_amdgcn_mfma_f32_16x16x32_bf16(a, b, c, 0, 0, 0); }

#define XB_TMO      128
#define XB_XCNT(j)  (256  + 64 * (j))
#define XB_XSUB(j)  (1280 + 64 * (j))
#define XB_XGEN(j)  (2304 + 64 * (j))
#define XB_TOP      3328
#define XB_TOPGEN   3392
#define XCD_BAR_WORDS 3456
#define XB_SPIN_CAP (1u << 18)

__device__ __forceinline__ unsigned xb_ld(unsigned* p)              { return __hip_atomic_load(p, __ATOMIC_RELAXED, __HIP_MEMORY_SCOPE_AGENT); }
__device__ __forceinline__ unsigned xb_add(unsigned* p, unsigned v) { return __hip_atomic_fetch_add(p, v, __ATOMIC_RELAXED, __HIP_MEMORY_SCOPE_AGENT); }
__device__ __forceinline__ unsigned xb_xcc_id() { return (unsigned)__builtin_amdgcn_s_getreg((3 << 11) | 20) & 0xFu; }
#define XB_SPIN(cond, bar) do { unsigned _sp = 0; while (cond) { __builtin_amdgcn_s_sleep(1); \
    if ((++_sp & 255u) == 0u) { if (xb_ld(&(bar)[XB_TMO])) break; if (_sp > XB_SPIN_CAP) { atomicAdd(&(bar)[XB_TMO], 1u); break; } } } } while (0)

__device__ __forceinline__ unsigned xb_lane_id() { return __builtin_amdgcn_mbcnt_hi(~0u, __builtin_amdgcn_mbcnt_lo(~0u, 0u)); }
struct XcdBarrier {
    unsigned wv;
    unsigned* bar; unsigned x;
    volatile LAS unsigned* st;
};

__device__ __forceinline__ XcdBarrier xcd_barrier_post(unsigned* bar, volatile LAS unsigned* st) {
    XcdBarrier b; b.wv = 0u; b.bar = bar; b.x = xb_xcc_id(); b.st = st;
    if (threadIdx.x == 0) (void)xb_add(&bar[XB_XCNT(b.x)], 1u);
    return b;
}
__device__ __forceinline__ void xcd_barrier_complete(unsigned* bar, unsigned x, unsigned& nloc, unsigned& nx) {
    const unsigned G = gridDim.x * gridDim.y * gridDim.z;
    unsigned sum, cnt, mine, sp = 0u;
    for (;;) {
        sum = 0u; cnt = 0u; mine = 0u;
#pragma unroll
        for (unsigned j = 0; j < 16; ++j) { const unsigned c = xb_ld(&bar[XB_XCNT(j)]); sum += c; cnt += (c > 0u) ? 1u : 0u; mine = (j == x) ? c : mine; }
        if (sum == G) break;
        __builtin_amdgcn_s_sleep(1);
        if ((++sp & 255u) == 0u) { if (xb_ld(&bar[XB_TMO])) break; if (sp > XB_SPIN_CAP) { atomicAdd(&bar[XB_TMO], 1u); break; } }
    }
    nloc = mine > 0u ? mine : 1u; nx = cnt > 0u ? cnt : 1u;
}

__device__ __forceinline__ void xcd_barrier(const XcdBarrier& b) {
    asm volatile("s_waitcnt vmcnt(0)" ::: "memory");
    __syncthreads();
    if (b.wv == 0u && xb_lane_id() == 0u) {
        unsigned* bar = b.bar;
        __builtin_amdgcn_s_waitcnt(0);
        unsigned nloc = b.st[0], nx = b.st[1];
        if (nloc == 0u) { xcd_barrier_complete(bar, b.x, nloc, nx); b.st[0] = nloc; b.st[1] = nx; }
        const unsigned old = xb_add(&bar[XB_XSUB(b.x)], 1u);
        const unsigned gen = old / nloc;
        if (old + 1u == (gen + 1u) * nloc) {
            __builtin_amdgcn_fence(__ATOMIC_RELEASE, "agent");
            asm volatile("s_waitcnt vmcnt(0)" ::: "memory");
            const unsigned og = xb_add(&bar[XB_TOP], 1u);
            const unsigned tg = og / nx;
            if (og + 1u == (tg + 1u) * nx) xb_add(&bar[XB_TOPGEN], 1u);
            else XB_SPIN(xb_ld(&bar[XB_TOPGEN]) == tg, bar);
            __builtin_amdgcn_fence(__ATOMIC_ACQUIRE, "agent");
            xb_add(&bar[XB_XGEN(b.x)], 1u);
            asm volatile("s_waitcnt vmcnt(0)" ::: "memory");
        } else {
            XB_SPIN(xb_ld(&bar[XB_XGEN(b.x)]) == gen, bar);
            __builtin_amdgcn_fence(__ATOMIC_ACQUIRE, "agent");
            asm volatile("s_waitcnt vmcnt(0)" ::: "memory");
        }
    }
    __syncthreads();
}

struct Args { GAS const float* in[18]; GAS float* out; GAS unsigned char* ws; int ph_lo, ph_hi; };
typedef __attribute__((address_space(4))) const Args CArgs;
__device__ __forceinline__ CArgs* kargs() { CArgs* p = (CArgs*)__builtin_amdgcn_kernarg_segment_ptr(); asm volatile("" : "+s"(p)); return p; }
#define INP(i) ((const float*)kargs()->in[i])
#define OUTP ((float*)kargs()->out)
struct Frame { LAS unsigned char* lds; int wv; };
struct Ids { int tid, lane, wave, G, gw, NGW; };
__device__ __forceinline__ Ids phase_ids(const int wv) { Ids I; int t = wv * 64 + (int)__builtin_amdgcn_mbcnt_hi(~0u, __builtin_amdgcn_mbcnt_lo(~0u, 0u)); asm volatile("" : "+v"(t)); I.tid = t; I.lane = t & 63; I.wave = __builtin_amdgcn_readfirstlane(t >> 6);
    int g = gridDim.x; asm volatile("" : "+s"(g)); I.G = g; I.gw = blockIdx.x * NWAVES + I.wave; I.NGW = g * NWAVES; return I; }
#define WSP(T, off) ((T*)(GAS T*)(kargs()->ws + (off)))


__device__ __forceinline__ int win_src(int r) {
    if (r < 10240) return r;
    if (r < 12288) return 12288 + (r - 10240);
    if (r < 14336) return 16384 + (r - 12288);
    if (r < 14592) return r == 14336 ? 18432 : -1;
    if (r < 26880) return 18464 + (r - 14592);
    if (r < 28928) return 10240 + (r - 26880);
    return 14336 + (r - 28928);
}
__device__ __forceinline__ void tr_item(const float* W, size_t ldw, int K, int k0, int srcA, int srcB, bf16* WT, int n0, LAS float* scr, int lane) {
    const int src = lane < 32 ? srcA : srcB; const int cl = lane & 31;
    if (src >= 0) { const float* p = W + (size_t)k0 * ldw + src + cl;
#pragma unroll 16
        for (int kk = 0; kk < 64; ++kk) scr[kk * 65 + lane] = p[(size_t)kk * ldw];
    } else {
#pragma unroll 16
        for (int kk = 0; kk < 64; ++kk) scr[kk * 65 + lane] = 0.f;
    }
    LDS_WAIT(); asm volatile("" ::: "memory");
    const int c = lane & 7;
#pragma unroll
    for (int j = 0; j < 8; ++j) { const int n = (lane >> 3) + 8 * j; const LAS float* s = scr + (8 * c) * 65 + n;
        v4u o; o.x = pk2(s[0 * 65], s[1 * 65]); o.y = pk2(s[2 * 65], s[3 * 65]); o.z = pk2(s[4 * 65], s[5 * 65]); o.w = pk2(s[6 * 65], s[7 * 65]);
        *(v4u*)(WT + (size_t)(n0 + n) * K + k0 + 8 * c) = o; }
    LDS_WAIT(); asm volatile("" ::: "memory");
}
__device__ __forceinline__ void tr_matrix(const Ids& I, const float* W, int K, int N, bf16* WT, LAS float* scr) {
    const int nnb = N / 64, items = (K / 64) * nnb;
    for (int it = I.gw; it < items; it += I.NGW) { const int kb = it / nnb, nb = it % nnb; tr_item(W, (size_t)N, K, kb * 64, nb * 64, nb * 64 + 32, WT, nb * 64, scr, I.lane); }
}
__device__ __forceinline__ void p0_prologue(Frame& F) {
    const Ids I = phase_ids(F.wv);
    LAS float* scr = (LAS float*)(F.lds + I.wave * 16640);
    for (int l = 0; l < DEPTH; ++l) {
        unsigned char* wl = (unsigned char*)(kargs()->ws + WS_W + (size_t)l * SZ_WL);
        { const float* W = INP(1) + (size_t)l * D * IN_WIDTH; bf16* WT = (bf16*)(wl + OFF_WIN);
            const int nnb = NIN_PAD / 64, items = (D / 64) * nnb;
            for (int it = I.gw; it < items; it += I.NGW) { const int kb = it / nnb, nb = it % nnb; tr_item(W, (size_t)IN_WIDTH, D, kb * 64, win_src(nb * 64), win_src(nb * 64 + 32), WT, nb * 64, scr, I.lane); } }
        for (int i = 0; i < 3; ++i) tr_matrix(I, INP(8) + ((size_t)l * 3 + i) * BW * D, BW, D, (bf16*)(wl + OFF_WBR) + (size_t)i * D * BW, scr);
        tr_matrix(I, INP(9) + (size_t)l * D * D, D, D, (bf16*)(wl + OFF_WO), scr);
        tr_matrix(I, INP(12) + (size_t)l * D * 2 * FF, D, 2 * FF, (bf16*)(wl + OFF_WFI), scr);
        tr_matrix(I, INP(15) + (size_t)l * FF * D, FF, D, (bf16*)(wl + OFF_WFO), scr);
    }
    { const f32x4* x4 = (const f32x4*)INP(0); v4u* o = WSP(v4u, WS_XB); const size_t n8 = (size_t)M * D / 8, stride = (size_t)I.G * 512;
      for (size_t i = (size_t)blockIdx.x * 512 + I.tid; i < n8; i += stride) { const f32x4 a = x4[2 * i], b = x4[2 * i + 1]; v4u w; w.x = pk2(a[0], a[1]); w.y = pk2(a[2], a[3]); w.z = pk2(b[0], b[1]); w.w = pk2(b[2], b[3]); o[i] = w; } }
}

__device__ __forceinline__ void conv_mixer_phase(Frame& F, int layer) {
    const Ids I = phase_ids(F.wv);
    const bf16* HB = WSP(const bf16, WS_HB); bf16* YC = WSP(bf16, WS_YC); const float* wc = INP(3) + (size_t)layer * 3 * BW;
    const int c8 = (I.tid & 255) * 8, half = I.tid >> 8;
    float w[3][8];
#pragma unroll
    for (int i = 0; i < 3; ++i) { const f32x4 a = *(const f32x4*)(wc + i * BW + c8), b = *(const f32x4*)(wc + i * BW + c8 + 4);
        w[i][0] = a[0]; w[i][1] = a[1]; w[i][2] = a[2]; w[i][3] = a[3]; w[i][4] = b[0]; w[i][5] = b[1]; w[i][6] = b[2]; w[i][7] = b[3]; }
    for (int it = blockIdx.x; it < M / 2; it += I.G) {
        const int m = 2 * it + half, s = m & (SEQ - 1);
        const bf16* row = HB + (size_t)m * LDH + c8;
        float acc[8], cb[8], x[8], y[8];
        unpack8(*(const v4u*)(row + H_CC), x); unpack8(*(const v4u*)(row + H_CH), y);
#pragma unroll
        for (int e = 0; e < 8; ++e) acc[e] = w[1][e] * (x[e] * y[e]);
        if (s > 0) { unpack8(*(const v4u*)(row - LDH + H_CC), x); unpack8(*(const v4u*)(row - LDH + H_CH), y);
#pragma unroll
            for (int e = 0; e < 8; ++e) acc[e] += w[0][e] * (x[e] * y[e]); }
        if (s < SEQ - 1) { unpack8(*(const v4u*)(row + LDH + H_CC), x); unpack8(*(const v4u*)(row + LDH + H_CH), y);
#pragma unroll
            for (int e = 0; e < 8; ++e) acc[e] += w[2][e] * (x[e] * y[e]); }
        unpack8(*(const v4u*)(row + H_CB), cb);
#pragma unroll
        for (int e = 0; e < 8; ++e) acc[e] *= cb[e];
        *(v4u*)(YC + (size_t)m * BW + c8) = pack8(acc);
    }
}
__device__ __forceinline__ void ln_phase(Frame& F, const float* V, const float* g, const float* b, float* XF, bf16* XBo) {
    const Ids I = phase_ids(F.wv);
    for (int m = I.gw; m < M; m += I.NGW) {
        const f32x4* vr = (const f32x4*)(V + (size_t)m * D) + I.lane;
        f32x4 v[16]; float s = 0.f;
#pragma unroll
        for (int j = 0; j < 16; ++j) { v[j] = vr[64 * j]; s += (v[j][0] + v[j][1]) + (v[j][2] + v[j][3]); }
        const float mean = wave_sum(s) * (1.f / D); float s2 = 0.f;
#pragma unroll
        for (int j = 0; j < 16; ++j) { v[j] = v[j] - mean; s2 += (v[j][0] * v[j][0] + v[j][1] * v[j][1]) + (v[j][2] * v[j][2] + v[j][3] * v[j][3]); }
        const float rstd = 1.f / sqrtf(wave_sum(s2) * (1.f / D) + LN_EPS);
        f32x4* xo = (f32x4*)(XF + (size_t)m * D) + I.lane; v2u* bo = (v2u*)(XBo + (size_t)m * D) + I.lane;
#pragma unroll
        for (int j = 0; j < 16; ++j) { const f32x4 gg = ((const f32x4*)g)[I.lane + 64 * j], bb = ((const f32x4*)b)[I.lane + 64 * j];
            const f32x4 o = v[j] * rstd * gg + bb; xo[64 * j] = o; v2u w; w.x = pk2(o[0], o[1]); w.y = pk2(o[2], o[3]); bo[64 * j] = w; }
    }
}
__device__ __forceinline__ void convglu_phase(Frame& F, int layer) {
    const Ids I = phase_ids(F.wv);
    const bf16* AU = WSP(const bf16, WS_AU); bf16* G = WSP(bf16, WS_G);
    const float* wc = INP(13) + (size_t)layer * 3 * FF; const float* bc = INP(14) + (size_t)layer * FF;
    constexpr int J = FF / 8; const size_t total = (size_t)M * J, stride = (size_t)I.G * 512;
    for (size_t idx = (size_t)blockIdx.x * 512 + I.tid; idx < total; idx += stride) {
        const int m = (int)(idx / J), c8 = (int)(idx % J) * 8, s = m & (SEQ - 1);
        const bf16* row = AU + (size_t)m * (2 * FF) + c8;
        float a[8], acc[8], wv[8];
        { const f32x4 x = *(const f32x4*)(bc + c8), y = *(const f32x4*)(bc + c8 + 4); acc[0] = x[0]; acc[1] = x[1]; acc[2] = x[2]; acc[3] = x[3]; acc[4] = y[0]; acc[5] = y[1]; acc[6] = y[2]; acc[7] = y[3]; }
#define CG_TAP(i, ptr) { unpack8(*(const v4u*)(ptr), a); const f32x4 x = *(const f32x4*)(wc + (i) * FF + c8), y = *(const f32x4*)(wc + (i) * FF + c8 + 4); \
            wv[0] = x[0]; wv[1] = x[1]; wv[2] = x[2]; wv[3] = x[3]; wv[4] = y[0]; wv[5] = y[1]; wv[6] = y[2]; wv[7] = y[3]; _Pragma("unroll") for (int e = 0; e < 8; ++e) acc[e] += wv[e] * a[e]; }
        CG_TAP(1, row)
        if (s > 0) CG_TAP(0, row - 2 * FF)
        if (s < SEQ - 1) CG_TAP(2, row + 2 * FF)
#undef CG_TAP
        float u[8]; unpack8(*(const v4u*)(row + FF), u);
#pragma unroll
        for (int e = 0; e < 8; e += 2) { const pg8::f32x2 gl = pg8::gelu_pk((pg8::f32x2){acc[e], acc[e + 1]}); acc[e] = gl.x * u[e]; acc[e + 1] = gl.y * u[e + 1]; }
        *(v4u*)(G + (size_t)m * FF + c8) = pack8(acc);
    }
}
__device__ __forceinline__ void gla_combine_phase(Frame& F, int layer) {
    const Ids I = phase_ids(F.wv);
    const float* O0 = WSP(const float, WS_O); const float* O1 = O0 + (size_t)M * 2048; const bf16* HB = WSP(const bf16, WS_HB); bf16* YG = WSP(bf16, WS_YG);
    const float* ng = INP(7) + (size_t)layer * 2048;
    for (int idx = I.gw; idx < M * 4; idx += I.NGW) {
        const int m = idx >> 2, h = idx & 3; const size_t off = (size_t)m * 2048 + h * 512 + 8 * I.lane;
        const f32x4 a0 = *(const f32x4*)(O0 + off), a1 = *(const f32x4*)(O0 + off + 4), b0 = *(const f32x4*)(O1 + off), b1 = *(const f32x4*)(O1 + off + 4);
        float o[8] = {a0[0] + b0[0], a0[1] + b0[1], a0[2] + b0[2], a0[3] + b0[3], a1[0] + b1[0], a1[1] + b1[1], a1[2] + b1[2], a1[3] + b1[3]};
        float ss = 0.f;
#pragma unroll
        for (int e = 0; e < 8; ++e) ss += o[e] * o[e];
        const float rs = 1.f / sqrtf(wave_sum(ss) * (1.f / 512.f) + RMS_EPS);
        float r[8]; unpack8(*(const v4u*)(HB + (size_t)m * LDH + H_GR + h * 512 + 8 * I.lane), r);
        const f32x4 g0 = *(const f32x4*)(ng + h * 512 + 8 * I.lane), g1 = *(const f32x4*)(ng + h * 512 + 8 * I.lane + 4);
        const float gg[8] = {g0[0], g0[1], g0[2], g0[3], g1[0], g1[1], g1[2], g1[3]};
#pragma unroll
        for (int e = 0; e < 8; ++e) o[e] = o[e] * rs * gg[e] * (r[e] / (1.f + __expf(-r[e])));
        *(v4u*)(YG + off) = pack8(o);
    }
}

__device__ __forceinline__ void na_phase(Frame& F, int layer) {
    const Ids I = phase_ids(F.wv);
    const bf16* HB = WSP(const bf16, WS_HB); const bf16* VT = WSP(const bf16, WS_VT); bf16* YN = WSP(bf16, WS_YN);
    const float* rpb = INP(4) + (size_t)layer * 16 * 465;
    LAS float* rpbs = (LAS float*)F.lds;
    const int fr = I.lane & 15, q4 = I.lane >> 4;
    for (int it = blockIdx.x; it < 2048; it += I.G) {
        const int rblk = it & 7, cblk = (it >> 3) & 3, h = (it >> 5) & 15, b = it >> 9;
        __syncthreads();
        for (int i = I.tid; i < 465; i += 512) rpbs[i] = rpb[h * 465 + i];
        __syncthreads();
        const int r = rblk * 8 + I.wave, c0 = cblk * 16;
        const int rs = min(max(r - 4, 0), 56), cs = min(max(c0 - 8, 0), 32);
        const int mq = b * SEQ + r * 64 + c0 + fr;
        const bf16* qp = HB + (size_t)mq * LDH + H_NQ + h * 128 + 8 * q4;
        bf16x8 qf[4];
#pragma unroll
        for (int s = 0; s < 4; ++s) qf[s] = *(const bf16x8*)(qp + 32 * s);
        const int cq = c0 + fr, ws = min(max(cq - 8, 0), 48);
        f32x4 sc[8][2];
        float mx = -1e30f;
#pragma unroll
        for (int sp = 0; sp < 8; ++sp)
#pragma unroll
            for (int u = 0; u < 2; ++u) {
                const int coloff = 8 * (fr >> 2) + 4 * u + (fr & 3);
                const int mk = b * SEQ + (rs + sp) * 64 + cs + coloff;
                const bf16* kp = HB + (size_t)mk * LDH + H_NK + h * 128 + 8 * q4;
                f32x4 d = (f32x4){0.f, 0.f, 0.f, 0.f};
#pragma unroll
                for (int s = 0; s < 4; ++s) d = mfma16(*(const bf16x8*)(kp + 32 * s), qf[s], d);
                const int brow = (rs + sp - r + 7) * 31;
#pragma unroll
                for (int j = 0; j < 4; ++j) { const int kc = cs + 8 * q4 + 4 * u + j; const bool valid = (kc >= ws) && (kc < ws + 16);
                    const int bi = min(max(kc - cq + 15, 0), 30);
                    const float v = valid ? d[j] * 0.08838834764831845f + rpbs[brow + bi] : -1e30f;
                    sc[sp][u][j] = v; mx = fmaxf(mx, v); }
            }
        mx = fmaxf(mx, __shfl_xor(mx, 16)); mx = fmaxf(mx, __shfl_xor(mx, 32));
        float sum = 0.f;
        bf16x8 pf[8];
#pragma unroll
        for (int sp = 0; sp < 8; ++sp) { float p[8];
#pragma unroll
            for (int u = 0; u < 2; ++u)
#pragma unroll
                for (int j = 0; j < 4; ++j) { const float e = __builtin_amdgcn_exp2f((sc[sp][u][j] - mx) * 1.44269504f); p[4 * u + j] = e; sum += e; }
            const v4u w = pack8(p); pf[sp] = __builtin_bit_cast(bf16x8, w); }
        sum += __shfl_xor(sum, 16); sum += __shfl_xor(sum, 32);
        const float inv = 1.f / sum;
        const bf16* vp = VT + (size_t)(h * 128 + fr) * M + b * SEQ + rs * 64 + cs + 8 * q4;
#pragma unroll
        for (int dt = 0; dt < 8; ++dt) { f32x4 o = (f32x4){0.f, 0.f, 0.f, 0.f};
#pragma unroll
            for (int sp = 0; sp < 8; ++sp) o = mfma16(*(const bf16x8*)(vp + (size_t)(16 * dt) * M + sp * 64), pf[sp], o);
            v2u w; w.x = pk2(o[0] * inv, o[1] * inv); w.y = pk2(o[2] * inv, o[3] * inv);
            *(v2u*)(YN + (size_t)mq * BW + h * 128 + 16 * dt + 4 * q4) = w; }
    }
}

__device__ __forceinline__ float logsigmoidf_(float z) { return fminf(z, 0.f) - log1pf(__expf(-fabsf(z))); }
__device__ __forceinline__ void gla_prep_phase(Frame& F, int layer) {
    const Ids I = phase_ids(F.wv);
    constexpr int RS = 264;
    LAS bf16* qs = (LAS bf16*)F.lds; LAS bf16* ks = qs + 2 * 64 * RS; LAS float* gas = (LAS float*)(ks + 2 * 64 * RS);
    const bf16* HB = WSP(const bf16, WS_HB); const float* GA = WSP(const float, WS_GA);
    bf16* QIN = WSP(bf16, WS_QIN); bf16* KOT = WSP(bf16, WS_KOT); bf16* ATT = WSP(bf16, WS_ATT); float* DEC = WSP(float, WS_DEC);
    const float* wdec = INP(5) + (size_t)layer * 2 * 16 * 1024; const float* bdec = INP(6) + (size_t)layer * 2 * 1024;
    const int dir = I.tid >> 8, c = I.tid & 255, fr = I.lane & 15, q4 = I.lane >> 4;
    for (int it = blockIdx.x; it < 1024; it += I.G) {
        const int h = it & 3, chunk = (it >> 2) & 63, b = it >> 8, m0 = b * SEQ + chunk * 64, ch = h * 256 + c;
        __syncthreads();
        ((LAS f32x4*)gas)[I.tid] = ((const f32x4*)(GA + (size_t)m0 * 32))[I.tid];
        float w[16];
#pragma unroll
        for (int r = 0; r < 16; ++r) w[r] = wdec[(dir * 16 + r) * 1024 + ch];
        const float bd = bdec[dir * 1024 + ch];
        __syncthreads();
        const LAS float* ga = gas + dir * 16;
        float tot = 0.f;
#pragma unroll 4
        for (int t = 0; t < 64; ++t) { float z = bd;
#pragma unroll
            for (int r = 0; r < 16; ++r) z += ga[t * 32 + r] * w[r];
            tot += logsigmoidf_(z) * 0.0625f; }
        float run = 0.f; unsigned ko[32];
        const bf16* qg = HB + (size_t)m0 * LDH + H_GQ + ch; const bf16* kg = HB + (size_t)m0 * LDH + H_GK + ch;
        bf16* qo = QIN + ((size_t)dir * M + m0) * 1024 + ch;
#pragma unroll
        for (int tt = 0; tt < 32; ++tt) { float kov[2];
#pragma unroll
            for (int e = 0; e < 2; ++e) { const int t = 2 * tt + e; float z = bd;
#pragma unroll
                for (int r = 0; r < 16; ++r) z += ga[t * 32 + r] * w[r];
                const float la = logsigmoidf_(z) * 0.0625f; float cum;
                if (dir == 0) { run += la; cum = run; } else { cum = tot - run; run += la; }
                const float qv = bf1(qg[(size_t)t * LDH]), kv = bf1(kg[(size_t)t * LDH]);
                const float q_in = qv * 0.0625f * __expf(cum), k_in = kv * __expf(-cum); kov[e] = kv * __expf(tot - cum);
                const unsigned qb = pk2(q_in, 0.f) & 0xffffu, kb = pk2(k_in, 0.f) & 0xffffu;
                qs[(dir * 64 + t) * RS + c] = (bf16)qb; ks[(dir * 64 + t) * RS + c] = (bf16)kb; qo[(size_t)t * 1024] = (bf16)qb; }
            ko[tt] = pk2(kov[0], kov[1]); }
        { v4u* kd = (v4u*)(KOT + ((size_t)dir * 1024 + ch) * M + m0);
#pragma unroll
            for (int i = 0; i < 8; ++i) { v4u w4; w4.x = ko[4 * i]; w4.y = ko[4 * i + 1]; w4.z = ko[4 * i + 2]; w4.w = ko[4 * i + 3]; kd[i] = w4; } }
        DEC[(((size_t)dir * 4 + b) * 64 + chunk) * 1024 + ch] = __expf(tot);
        __syncthreads();
        { const int adir = I.wave >> 2, mt = I.wave & 3, i = 16 * mt + fr;
          const LAS bf16* qrow = qs + (adir * 64 + i) * RS + 8 * q4;
          bf16* arow = ATT + (((((size_t)adir * 4 + b) * 4 + h) * 64 + chunk) * 64 + i) * 64;
#pragma unroll
          for (int nt = 0; nt < 4; ++nt) { const LAS bf16* krow = ks + (adir * 64 + 16 * nt + fr) * RS + 8 * q4;
              f32x4 d = (f32x4){0.f, 0.f, 0.f, 0.f};
#pragma unroll
              for (int s = 0; s < 8; ++s) d = mfma16(*(const LAS bf16x8*)(krow + 32 * s), *(const LAS bf16x8*)(qrow + 32 * s), d);
              const int j0 = 16 * nt + 4 * q4; float v[4];
#pragma unroll
              for (int jj = 0; jj < 4; ++jj) { const bool keep = adir == 0 ? (j0 + jj <= i) : (j0 + jj >= i); v[jj] = keep ? d[jj] : 0.f; }
              v2u w2; w2.x = pk2(v[0], v[1]); w2.y = pk2(v[2], v[3]); *(v2u*)(arow + j0) = w2; } }
    }
}
__device__ __forceinline__ void gla_scan_phase(Frame& F) {
    const Ids I = phase_ids(F.wv);
    const bf16* VT = WSP(const bf16, WS_VT); const bf16* QIN = WSP(const bf16, WS_QIN); const bf16* KOT = WSP(const bf16, WS_KOT); const bf16* ATT = WSP(const bf16, WS_ATT);
    const float* DEC = WSP(const float, WS_DEC); float* O = WSP(float, WS_O);
    const int fr = I.lane & 15, q4 = I.lane >> 4;
    if (I.wave < 4)
    for (int task = blockIdx.x * 4 + I.wave; task < 1024; task += I.G * 4) {
        const int es = task & 31, dir = (task >> 5) & 1, h = (task >> 6) & 3, b = task >> 8;
        f32x4 st[16];
#pragma unroll
        for (int t = 0; t < 16; ++t) st[t] = (f32x4){0.f, 0.f, 0.f, 0.f};
        const bf16* vrow = VT + (size_t)(2048 + h * 512 + es * 16 + fr) * M + 8 * q4;
        for (int step = 0; step < 64; ++step) {
            const int c = dir ? 63 - step : step, m0 = b * SEQ + c * 64;
            bf16x8 sb[8];
#pragma unroll
            for (int s = 0; s < 8; ++s) { v4u w; w.x = pk2(st[2 * s][0], st[2 * s][1]); w.y = pk2(st[2 * s][2], st[2 * s][3]); w.z = pk2(st[2 * s + 1][0], st[2 * s + 1][1]); w.w = pk2(st[2 * s + 1][2], st[2 * s + 1][3]); sb[s] = __builtin_bit_cast(bf16x8, w); }
            bf16x8 vf[2];
#pragma unroll
            for (int sp = 0; sp < 2; ++sp) vf[sp] = *(const bf16x8*)(vrow + m0 + 32 * sp);
#pragma unroll
            for (int mt = 0; mt < 4; ++mt) { f32x4 o = (f32x4){0.f, 0.f, 0.f, 0.f};
                const bf16* qp = QIN + ((size_t)dir * M + m0 + 16 * mt + fr) * 1024 + h * 256 + 8 * q4;
#pragma unroll
                for (int s = 0; s < 8; ++s) o = mfma16(sb[s], *(const bf16x8*)(qp + 32 * s), o);
                const bf16* ap = ATT + (((((size_t)dir * 4 + b) * 4 + h) * 64 + c) * 64 + 16 * mt + fr) * 64 + 8 * q4;
#pragma unroll
                for (int sp = 0; sp < 2; ++sp) o = mfma16(vf[sp], *(const bf16x8*)(ap + 32 * sp), o);
                *(f32x4*)(O + ((size_t)dir * M + m0 + 16 * mt + fr) * 2048 + h * 512 + es * 16 + 4 * q4) = o; }
            const float* dp = DEC + (((size_t)dir * 4 + b) * 64 + c) * 1024 + h * 256 + 8 * q4;
#pragma unroll
            for (int s = 0; s < 8; ++s)
#pragma unroll
                for (int u = 0; u < 2; ++u) { const int t = 2 * s + u, dkrow = 32 * s + 8 * (fr >> 2) + 4 * u + (fr & 3);
                    const bf16* kp = KOT + ((size_t)dir * 1024 + h * 256 + dkrow) * M + m0 + 8 * q4;
                    const f32x4 dc = *(const f32x4*)(dp + 32 * s + 4 * u);
                    f32x4 a = st[t] * dc;
#pragma unroll
                    for (int sp = 0; sp < 2; ++sp) a = mfma16(*(const bf16x8*)(kp + 32 * sp), vf[sp], a);
                    st[t] = a; }
        }
    }
}


#ifndef PHM
#define PHM 0xffff
#endif
__global__ void __launch_bounds__(NWAVES * 64, 2) enc_fwd(Args args) {
    extern __shared__ __attribute__((aligned(16))) unsigned char lds[];
    Frame F;
    F.lds = (LAS unsigned char*)lds; F.wv = __builtin_amdgcn_readfirstlane(threadIdx.x >> 6);
    volatile LAS unsigned* MISC = (volatile LAS unsigned*)(F.lds + MISC_OFF);
    if (threadIdx.x < 128) MISC[threadIdx.x] = 0u;
    __syncthreads();
    (void)xcd_barrier_post((unsigned*)(GAS unsigned*)(args.ws + WS_CTL) + CW_BAR, MISC + 8);
#if MK_MULTI
#define IN(k) (kargs()->ph_lo <= (k) && (k) < kargs()->ph_hi)
#else
#define IN(k) true
#endif
#define SEAM(k) do { if (IN((k) + 1)) { XcdBarrier bb; bb.wv = (unsigned)F.wv; bb.bar = (unsigned*)(GAS unsigned*)(kargs()->ws + WS_CTL) + CW_BAR; bb.x = (unsigned)__builtin_amdgcn_readfirstlane((int)xb_xcc_id()); bb.st = (volatile LAS unsigned*)(F.lds + MISC_OFF) + 8; xcd_barrier(bb); } } while (0)
    LAS unsigned char* ring = F.lds;

    if (IN(0)) { if (PHM & 1) p0_prologue(F); SEAM(0); }

    for (int layer = 0; layer < DEPTH; ++layer) {
        const int pb = 1 + 11 * layer;
#define WL ((unsigned char*)(kargs()->ws + WS_W + (size_t)layer * SZ_WL))

        const pg8::bf16_t* XB = WSP(const pg8::bf16_t, WS_XB);
        if (IN(pb + 0)) { if (PHM & 2) {
            { pg8::Gemm g{XB, (const pg8::bf16_t*)(WL + OFF_WIN), M, NIN_MAIN, D}; pg8::StaticOrder S; S.init(M, NIN_MAIN, (int)gridDim.x, (int)blockIdx.x);
              pg8::EpiIn E{WSP(pg8::bf16_t, WS_HB), LDH, WSP(float, WS_GA), WSP(pg8::bf16_t, WS_GATES), INP(2) + (size_t)layer * 3 * D};
              pg8::gemm_phase<pg8::EpiIn, pg8::StaticOrder, true, true>(ring, g, S, E, F.wv); }
            { pg8::Gemm g{(const pg8::bf16_t*)(WL + OFF_WIN) + (size_t)NIN_MAIN * D, XB, 4096, M, D}; pg8::StaticOrder S; S.init(4096, M, (int)gridDim.x, (int)blockIdx.x);
              pg8::EpiBf16 E{WSP(pg8::bf16_t, WS_VT), M};
              pg8::gemm_phase<pg8::EpiBf16, pg8::StaticOrder, true, true>(ring, g, S, E, F.wv); } }
            SEAM(pb + 0);
        }
        if (IN(pb + 1)) { if (PHM & 4) conv_mixer_phase(F, layer); if (PHM & 8) gla_prep_phase(F, layer); if (PHM & 16) na_phase(F, layer); SEAM(pb + 1); }
        if (IN(pb + 2)) { if (PHM & 32) gla_scan_phase(F); SEAM(pb + 2); }
        if (IN(pb + 3)) { if (PHM & 64) gla_combine_phase(F, layer); SEAM(pb + 3); }
        if (IN(pb + 4)) { if (PHM & 128) {
            pg8::StaticOrder S; S.init(M, D, (int)gridDim.x, (int)blockIdx.x);
            { pg8::Gemm g{WSP(const pg8::bf16_t, WS_YC), (const pg8::bf16_t*)(WL + OFF_WBR), M, D, BW};
              pg8::EpiBranch<0> E{WSP(pg8::bf16_t, WS_MIXED), WSP(const pg8::bf16_t, WS_GATES)}; pg8::gemm_phase<pg8::EpiBranch<0>, pg8::StaticOrder, true, true>(ring, g, S, E, F.wv); }
            { pg8::Gemm g{WSP(const pg8::bf16_t, WS_YN), (const pg8::bf16_t*)(WL + OFF_WBR) + (size_t)D * BW, M, D, BW};
              pg8::EpiBranch<1> E{WSP(pg8::bf16_t, WS_MIXED), WSP(const pg8::bf16_t, WS_GATES)}; pg8::gemm_phase<pg8::EpiBranch<1>, pg8::StaticOrder, true, true>(ring, g, S, E, F.wv); }
            { pg8::Gemm g{WSP(const pg8::bf16_t, WS_YG), (const pg8::bf16_t*)(WL + OFF_WBR) + (size_t)2 * D * BW, M, D, BW};
              pg8::EpiBranch<2> E{WSP(pg8::bf16_t, WS_MIXED), WSP(const pg8::bf16_t, WS_GATES)}; pg8::gemm_phase<pg8::EpiBranch<2>, pg8::StaticOrder, true, true>(ring, g, S, E, F.wv); } }
            SEAM(pb + 4);
        }
        const float* xres = layer == 0 ? INP(0) : WSP(const float, WS_XR);
        if (IN(pb + 5)) { if (PHM & 256) {
            pg8::Gemm g{WSP(const pg8::bf16_t, WS_MIXED), (const pg8::bf16_t*)(WL + OFF_WO), M, D, D}; pg8::StaticOrder S; S.init(M, D, (int)gridDim.x, (int)blockIdx.x);
            pg8::EpiResid E{WSP(float, WS_XR), xres, D, ALPHA}; pg8::gemm_phase<pg8::EpiResid, pg8::StaticOrder, true, true>(ring, g, S, E, F.wv); }
            SEAM(pb + 5);
        }
        if (IN(pb + 6)) { if (PHM & 512) ln_phase(F, WSP(const float, WS_XR), INP(10) + (size_t)layer * D, INP(11) + (size_t)layer * D, WSP(float, WS_XR), WSP(bf16, WS_XB)); SEAM(pb + 6); }
        if (IN(pb + 7)) { if (PHM & 1024) {
            pg8::Gemm g{XB, (const pg8::bf16_t*)(WL + OFF_WFI), M, 2 * FF, D}; pg8::StaticOrder S; S.init(M, 2 * FF, (int)gridDim.x, (int)blockIdx.x);
            pg8::EpiBf16 E{WSP(pg8::bf16_t, WS_AU), 2 * FF}; pg8::gemm_phase<pg8::EpiBf16, pg8::StaticOrder, true, true>(ring, g, S, E, F.wv); }
            SEAM(pb + 7);
        }
        if (IN(pb + 8)) { if (PHM & 2048) convglu_phase(F, layer); SEAM(pb + 8); }
        if (IN(pb + 9)) { if (PHM & 4096) {
            pg8::Gemm g{WSP(const pg8::bf16_t, WS_G), (const pg8::bf16_t*)(WL + OFF_WFO), M, D, FF}; pg8::StaticOrder S; S.init(M, D, (int)gridDim.x, (int)blockIdx.x);
            pg8::EpiResid E{WSP(float, WS_XR), WSP(const float, WS_XR), D, ALPHA}; pg8::gemm_phase<pg8::EpiResid, pg8::StaticOrder, true, true>(ring, g, S, E, F.wv); }
            SEAM(pb + 9);
        }
        if (IN(pb + 10)) { if (PHM & 8192) ln_phase(F, WSP(const float, WS_XR), INP(16) + (size_t)layer * D, INP(17) + (size_t)layer * D, layer == DEPTH - 1 ? OUTP : WSP(float, WS_XR), WSP(bf16, WS_XB)); SEAM(pb + 10); }
    }
#undef IN
#undef SEAM
}

extern "C" void kernel_launch(void* const* d_in, const int* in_sizes, int n_in, void* d_out, int out_size, void* d_ws, size_t ws_size, hipStream_t stream) {
    static int grid = 0;
    if (grid == 0) {
        if (n_in != 18 || in_sizes[0] != M * D || out_size != M * D || ws_size < WS_END) { fprintf(stderr, "kernel_launch: unexpected sizes: n_in %d in0 %d out %d ws %zu (need %zu); nothing launched\n", n_in, n_in > 0 ? in_sizes[0] : -1, out_size, ws_size, (size_t)WS_END); grid = -1; return; }
        int dev = 0, cus = 0, per_cu = 0;
        if (hipGetDevice(&dev) != hipSuccess || hipDeviceGetAttribute(&cus, hipDeviceAttributeMultiprocessorCount, dev) != hipSuccess) { grid = -1; return; }
        if (hipFuncSetAttribute((const void*)enc_fwd, hipFuncAttributeMaxDynamicSharedMemorySize, LDS_BYTES) != hipSuccess) { fprintf(stderr, "kernel_launch: hipFuncSetAttribute failed\n"); grid = -1; return; }
        if (hipOccupancyMaxActiveBlocksPerMultiprocessor(&per_cu, (const void*)enc_fwd, NWAVES * 64, LDS_BYTES) != hipSuccess || per_cu < 1) { fprintf(stderr, "kernel_launch: occupancy query reports %d workgroups per CU\n", per_cu); grid = -1; (void)hipGetLastError(); return; }
        (void)hipGetLastError();
        grid = cus;
    }
    if (grid < 0) return;
    if (hipMemsetAsync((char*)d_ws + WS_CTL, 0, CTL_ZERO_BYTES, stream) != hipSuccess) return;
    Args a{};
    for (int i = 0; i < 18; ++i) a.in[i] = (GAS const float*)d_in[i];
    a.out = (GAS float*)d_out; a.ws = (GAS unsigned char*)d_ws;
#if MK_MULTI
    for (int p = 0; p < N_PHASES; ++p) { a.ph_lo = p; a.ph_hi = p + 1; hipLaunchKernelGGL(enc_fwd, dim3(grid), dim3(NWAVES * 64), LDS_BYTES, stream, a); }
#else
    a.ph_lo = 0; a.ph_hi = N_PHASES;
    hipLaunchKernelGGL(enc_fwd, dim3(grid), dim3(NWAVES * 64), LDS_BYTES, stream, a);
#endif
}
```

```cpp
#include <hip/hip_runtime.h>
#include <cstdio>
#include <cstdint>
namespace pg8 {
#define PG8_LAS __attribute__((address_space(3)))
typedef unsigned short bf16_t;
typedef short bf16x8 __attribute__((ext_vector_type(8)));
typedef float f32x4 __attribute__((ext_vector_type(4)));
typedef unsigned u32x4 __attribute__((ext_vector_type(4)));
constexpr int BM = 256, BK = 64, HALF = 128, HTB = HALF * BK * 2  , STAGE_BYTES = 8 * HTB, NXCD = 8, WGM = 8;

__host__ __device__ __forceinline__ int lds_byte(int r, int c) { const int st = (r >> 4) * 2 + (c >> 5), rr = r & 15, cc = c & 31, ob = rr * 64 + cc * 2; return st * 1024 + (ob ^ (((ob >> 9) & 1) << 5)); }
__host__ __device__ __forceinline__ void stage_rc(int b, int& R, int& C) { const int st = b / 1024, sb = b % 1024, swz = sb ^ (((sb >> 9) & 1) << 5); R = (st >> 1) * 16 + swz / 64; C = (st & 1) * 32 + (swz % 64) / 2; }
__host__ __device__ __forceinline__ int perm32(int rho) { const int n = rho >> 4, i = rho & 15; return 8 * (i >> 2) + 4 * n + (i & 3); }

struct Unit { int pm, pn; };
struct Gemm { const bf16_t* A; const bf16_t* Bt; int M, N, K; };

struct StaticOrder {
    int nM, nN, nwg, G, c;
    __host__ __device__ void init(int M, int N, int G_, int c_) { nM = M / BM; nN = N / BM; nwg = nM * nN; G = G_; c = c_; }
    __host__ __device__ bool next(int i, Unit& u) const {
        const long L = (long)i * G + c; if (L >= nwg) return false;
        int wgid = (int)L; { const int q = nwg / NXCD, r = nwg % NXCD, xcd = wgid % NXCD, off = wgid / NXCD; wgid = (xcd < r ? xcd * (q + 1) : r * (q + 1) + (xcd - r) * q) + off; }
        const int nig = WGM * nN, gid = wgid / nig, fm = gid * WGM, gsz = (nM - fm) < WGM ? (nM - fm) : WGM;
        u.pm = fm + ((wgid % nig) % gsz); u.pn = (wgid % nig) / gsz; return true;
    }
    __device__ __forceinline__ void a_ready(const Unit&) const {}
    __device__ __forceinline__ void done(const Unit&) const {}
};

__device__ __forceinline__ unsigned cvt_pk_bf16(float lo, float hi) { unsigned r; asm volatile("v_cvt_pk_bf16_f32 %0, %1, %2" : "=v"(r) : "v"(lo), "v"(hi)); return r; }
typedef float f32x2 __attribute__((ext_vector_type(2)));
__device__ __forceinline__ f32x2 gelu_pk(f32x2 v) {
    const f32x2 av = __builtin_elementwise_abs(v), d = av * 0.2316418882f + 1.0f;
    f32x2 t; t.x = __builtin_amdgcn_rcpf(d.x); t.y = __builtin_amdgcn_rcpf(d.y);
    f32x2 q = t * 0.5307027145f + (-0.7265760135f); q = q * t + 0.7107068705f; q = q * t + (-0.142248368f); q = q * t + 0.127414796f; q = q * t;
    const f32x2 s = (v * v) * (-0.72134752044f);
    f32x2 e; e.x = __builtin_amdgcn_exp2f(s.x); e.y = __builtin_amdgcn_exp2f(s.y);
    const f32x2 m = v * (q * e), r = v - m;
    f32x2 o; o.x = v.x < 0.f ? m.x : r.x; o.y = v.y < 0.f ? m.y : r.y; return o;
}

__device__ __forceinline__ float bf_lo(unsigned w) { return __uint_as_float(w << 16); }
__device__ __forceinline__ float bf_hi(unsigned w) { return __uint_as_float(w & 0xffff0000u); }
__device__ __forceinline__ float sigmoidf_fast(float v) { return __builtin_amdgcn_rcpf(1.0f + __builtin_amdgcn_exp2f(-1.44269504f * v)); }

struct EpiBf16 {
    static constexpr bool PERM = true, AFTER_DRAIN = false;
    bf16_t* O; int ldc;
    __device__ __forceinline__ void operator()(const f32x4 (&acc)[2][2][4][2], const Unit& u, int wr, int wc, int fr, int fq) const {
        asm volatile("" : "+v"(fr), "+v"(fq));
        const int row0 = u.pm * BM + wr * 64 + fr, col0 = u.pn * BM + wc * 32 + 8 * fq;
#pragma unroll
        for (int ai = 0; ai < 2; ++ai)
#pragma unroll
            for (int m = 0; m < 4; ++m) { bf16_t* rowp = O + (size_t)(row0 + ai * HALF + m * 16) * ldc + col0;
#pragma unroll
                for (int bj = 0; bj < 2; ++bj) { const f32x4 v0 = acc[ai][bj][m][0], v1 = acc[ai][bj][m][1];
                    u32x4 w; w.x = cvt_pk_bf16(v0[0], v0[1]); w.y = cvt_pk_bf16(v0[2], v0[3]); w.z = cvt_pk_bf16(v1[0], v1[1]); w.w = cvt_pk_bf16(v1[2], v1[3]);
                    *(u32x4*)(rowp + bj * HALF) = w; } }
    }
};
struct EpiIn {
    static constexpr bool PERM = true, AFTER_DRAIN = false;
    bf16_t* HB; int ldh; float* GA; bf16_t* GATES; const float* bgate;
    __device__ __forceinline__ void operator()(const f32x4 (&acc)[2][2][4][2], const Unit& u, int wr, int wc, int fr, int fq) const {
        asm volatile("" : "+v"(fr), "+v"(fq));
        const int row0 = u.pm * BM + wr * 64 + fr;
        if (u.pn < 56) {
            const int col0 = u.pn * BM + wc * 32 + 8 * fq;
#pragma unroll
            for (int ai = 0; ai < 2; ++ai)
#pragma unroll
                for (int m = 0; m < 4; ++m) { bf16_t* rowp = HB + (size_t)(row0 + ai * HALF + m * 16) * ldh + col0;
#pragma unroll
                    for (int bj = 0; bj < 2; ++bj) { const f32x4 v0 = acc[ai][bj][m][0], v1 = acc[ai][bj][m][1];
                        u32x4 w; w.x = cvt_pk_bf16(v0[0], v0[1]); w.y = cvt_pk_bf16(v0[2], v0[3]); w.z = cvt_pk_bf16(v1[0], v1[1]); w.w = cvt_pk_bf16(v1[2], v1[3]);
                        *(u32x4*)(rowp + bj * HALF) = w; } }
        } else if (u.pn == 56) {
            if (wc == 0) {
#pragma unroll
                for (int ai = 0; ai < 2; ++ai)
#pragma unroll
                    for (int m = 0; m < 4; ++m) { float* rowp = GA + (size_t)(row0 + ai * HALF + m * 16) * 32 + 8 * fq;
                        *(f32x4*)rowp = acc[ai][0][m][0]; *(f32x4*)(rowp + 4) = acc[ai][0][m][1]; }
            }
        } else {
            const int col0 = (u.pn - 57) * BM + wc * 32 + 8 * fq;
#pragma unroll
            for (int ai = 0; ai < 2; ++ai)
#pragma unroll
                for (int m = 0; m < 4; ++m) { bf16_t* rowp = GATES + (size_t)(row0 + ai * HALF + m * 16) * 12288 + col0;
                    asm volatile("" ::: "memory");
#pragma unroll
                    for (int bj = 0; bj < 2; ++bj) { const f32x4 v0 = acc[ai][bj][m][0] + *(const f32x4*)(bgate + col0 + bj * HALF), v1 = acc[ai][bj][m][1] + *(const f32x4*)(bgate + col0 + bj * HALF + 4);
                        u32x4 w; w.x = cvt_pk_bf16(sigmoidf_fast(v0[0]), sigmoidf_fast(v0[1])); w.y = cvt_pk_bf16(sigmoidf_fast(v0[2]), sigmoidf_fast(v0[3]));
                        w.z = cvt_pk_bf16(sigmoidf_fast(v1[0]), sigmoidf_fast(v1[1])); w.w = cvt_pk_bf16(sigmoidf_fast(v1[2]), sigmoidf_fast(v1[3]));
                        *(u32x4*)(rowp + bj * HALF) = w; } }
        }
    }
};
template <int I> struct EpiBranch {
    static constexpr bool PERM = true, AFTER_DRAIN = false;
    bf16_t* MIXED; const bf16_t* GATES;
    __device__ __forceinline__ void operator()(const f32x4 (&acc)[2][2][4][2], const Unit& u, int wr, int wc, int fr, int fq) const {
        asm volatile("" : "+v"(fr), "+v"(fq));
        const int row0 = u.pm * BM + wr * 64 + fr, col0 = u.pn * BM + wc * 32 + 8 * fq;
#pragma unroll
        for (int ai = 0; ai < 2; ++ai)
#pragma unroll
            for (int m = 0; m < 4; ++m) { const size_t r = (size_t)(row0 + ai * HALF + m * 16);
                asm volatile("" ::: "memory");
#pragma unroll
                for (int bj = 0; bj < 2; ++bj) {
                    const u32x4 g = *(const u32x4*)(GATES + r * 12288 + I * 4096 + col0 + bj * HALF);
                    bf16_t* mp = MIXED + r * 4096 + col0 + bj * HALF;
                    u32x4 p = (u32x4){0u, 0u, 0u, 0u}; if (I) p = *(const u32x4*)mp;
                    const f32x4 a0 = acc[ai][bj][m][0], a1 = acc[ai][bj][m][1];
                    u32x4 w;
                    w.x = cvt_pk_bf16(bf_lo(p.x) + bf_lo(g.x) * a0[0], bf_hi(p.x) + bf_hi(g.x) * a0[1]);
                    w.y = cvt_pk_bf16(bf_lo(p.y) + bf_lo(g.y) * a0[2], bf_hi(p.y) + bf_hi(g.y) * a0[3]);
                    w.z = cvt_pk_bf16(bf_lo(p.z) + bf_lo(g.z) * a1[0], bf_hi(p.z) + bf_hi(g.z) * a1[1]);
                    w.w = cvt_pk_bf16(bf_lo(p.w) + bf_lo(g.w) * a1[2], bf_hi(p.w) + bf_hi(g.w) * a1[3]);
                    *(u32x4*)mp = w; } }
    }
};
struct EpiResid {
    static constexpr bool PERM = false, AFTER_DRAIN = false;
    float* V; const float* xres; int ldc; float alpha;
    __device__ __forceinline__ void operator()(const f32x4 (&acc)[2][2][4][2], const Unit& u, int wr, int wc, int fr, int fq) const {
        asm volatile("" : "+v"(fr), "+v"(fq));
        const int row0 = u.pm * BM + wr * 64 + fr, col0 = u.pn * BM + wc * 32 + 4 * fq;
#pragma unroll
        for (int ai = 0; ai < 2; ++ai)
#pragma unroll
            for (int m = 0; m < 4; ++m) { const size_t off = (size_t)(row0 + ai * HALF + m * 16) * ldc + col0;
                asm volatile("" ::: "memory");
#pragma unroll
                for (int bj = 0; bj < 2; ++bj)
#pragma unroll
                    for (int n = 0; n < 2; ++n) { const f32x4 xr = *(const f32x4*)(xres + off + bj * HALF + n * 16);
                        *(f32x4*)(V + off + bj * HALF + n * 16) = xr * alpha + acc[ai][bj][m][n]; } }
    }
};

template <class Epi, class Sched, bool ALIGN_EPI = false, bool SP2 = false>
__device__ __forceinline__ void gemm_phase(PG8_LAS unsigned char* lds, const Gemm g, const Sched& S, const Epi& E, const int wv  ) {
    int tid_ = wv * 64 + (int)__builtin_amdgcn_mbcnt_hi(~0u, __builtin_amdgcn_mbcnt_lo(~0u, 0u)); asm volatile("" : "+v"(tid_));
    const int tid = tid_, wid = __builtin_amdgcn_readfirstlane(tid >> 6), lane = tid & 63, wr = wid >> 2, wc = wid & 3, fr = lane & 15, fq = lane >> 4;
    const int K = g.K, nt = K / BK;
    unsigned voffA[2], voffB[2];
#pragma unroll
    for (int i = 0; i < 2; ++i) { int R, C; stage_rc(tid * 16 + i * 8192, R, C); const int Rb = Epi::PERM ? ((R & ~31) + perm32(R & 31)) : R;
        voffA[i] = (unsigned)(R * K + C) * 2u; voffB[i] = (unsigned)(Rb * K + C) * 2u; }
    const size_t kstep = (size_t)(BK * 2);
    const size_t hstep = (size_t)HALF * K * 2;
    const size_t tstep = 2 * hstep;
    const unsigned ldsw = (unsigned)wid * 1024u;
    const int aoff = lds_byte(wr * 64 + fr, fq * 8), boff = lds_byte(wc * 32 + fr, fq * 8);
#define PG8_SA(b, h) (((b) * 2 + (h)) * HTB)
#define PG8_SB(b, h) ((4 + (b) * 2 + (h)) * HTB)
#define PG8_STAGE(bufoff, gbase, voff) do { _Pragma("unroll") for (int _i = 0; _i < 2; ++_i) \
        __builtin_amdgcn_global_load_lds((const unsigned*)((const char*)(gbase) + (voff)[_i]), (PG8_LAS unsigned*)(lds + (bufoff) + ldsw + _i * 8192), 16, 0, 0); } while (0)
#define PG8_LDA(dst, b, h) do { _Pragma("unroll") for (int m = 0; m < 4; ++m) _Pragma("unroll") for (int k = 0; k < 2; ++k) dst[m][k] = *(const PG8_LAS bf16x8*)(lds + PG8_SA(b, h) + aoff + m * 2048 + k * 1024); } while (0)
#define PG8_LDB(dst, b, h) do { _Pragma("unroll") for (int n = 0; n < 2; ++n) _Pragma("unroll") for (int k = 0; k < 2; ++k) dst[n][k] = *(const PG8_LAS bf16x8*)(lds + PG8_SB(b, h) + boff + n * 2048 + k * 1024); } while (0)
#define PG8_MMA(ai, bj, At, Bt) do { __builtin_amdgcn_s_setprio(1); _Pragma("unroll") for (int m = 0; m < 4; ++m) _Pragma("unroll") for (int n = 0; n < 2; ++n) _Pragma("unroll") for (int k = 0; k < 2; ++k) \
        acc[ai][bj][m][n] = __builtin_amdgcn_mfma_f32_16x16x32_bf16(Bt[n][k], At[m][k], acc[ai][bj][m][n], 0, 0, 0); __builtin_amdgcn_s_setprio(0); } while (0)
#define PG8_WAIT_V(n) asm volatile("s_waitcnt vmcnt(" #n ")" ::: "memory")
#define PG8_WAIT_L(n) asm volatile("s_waitcnt lgkmcnt(" #n ")" ::: "memory")
#define PG8_BAR __builtin_amdgcn_s_barrier()
#define PG8_SCHED __builtin_amdgcn_sched_barrier(0)
    Unit cur, nxt; int ui = 0;
    if (!S.next(0, cur)) return;
    f32x4 acc[2][2][4][2];
#pragma unroll
    for (int a = 0; a < 2; ++a)
#pragma unroll
        for (int b = 0; b < 2; ++b)
#pragma unroll
            for (int m = 0; m < 4; ++m)
#pragma unroll
                for (int n = 0; n < 2; ++n) acc[a][b][m][n] = (f32x4){0.f, 0.f, 0.f, 0.f};
    bf16x8 At[4][2], B0[2][2], B1[2][2];
    const char* cA = (const char*)g.A + (size_t)cur.pm * tstep; const char* cB = (const char*)g.Bt + (size_t)cur.pn * tstep;
    S.a_ready(cur);
    if constexpr (SP2) {
        PG8_STAGE(PG8_SB(0, 0), cB, voffB); PG8_STAGE(PG8_SB(0, 1), cB + hstep, voffB); PG8_STAGE(PG8_SA(0, 0), cA, voffA); PG8_STAGE(PG8_SA(0, 1), cA + hstep, voffA);
        if (wr == 1) PG8_BAR;
        PG8_WAIT_V(2); PG8_BAR;
        PG8_STAGE(PG8_SB(1, 0), cB + kstep, voffB); PG8_STAGE(PG8_SA(1, 0), cA + kstep, voffA); PG8_STAGE(PG8_SB(1, 1), cB + hstep + kstep, voffB);
        PG8_WAIT_V(6); PG8_BAR;
    } else {
        PG8_STAGE(PG8_SB(0, 0), cB, voffB); PG8_STAGE(PG8_SA(0, 0), cA, voffA); PG8_STAGE(PG8_SB(0, 1), cB + hstep, voffB); PG8_STAGE(PG8_SA(0, 1), cA + hstep, voffA);
        if (wr == 1) PG8_BAR;
        PG8_WAIT_V(4); PG8_BAR;
        PG8_STAGE(PG8_SB(1, 0), cB + kstep, voffB); PG8_STAGE(PG8_SA(1, 0), cA + kstep, voffA); PG8_STAGE(PG8_SB(1, 1), cB + hstep + kstep, voffB);
        PG8_WAIT_V(6); PG8_BAR;
    }
    for (;;) {
        const bool has_next = S.next(ui + 1, nxt);
        const char* nA = has_next ? (const char*)g.A + (size_t)nxt.pm * tstep : cA; const char* nB = has_next ? (const char*)g.Bt + (size_t)nxt.pn * tstep : cB;
        for (int t = 0; t < nt; t += 2) {
            const bool last = (t == nt - 2);
            const char* a1 = cA + (size_t)(t + 1) * kstep;
            const char* a2 = last ? nA : cA + (size_t)(t + 2) * kstep; const char* b2 = last ? nB : cB + (size_t)(t + 2) * kstep;
            const char* a3 = a2 + kstep; const char* b3 = b2 + kstep;
            if (last && has_next) S.a_ready(nxt);
            if constexpr (SP2) {
            PG8_LDB(B0, 0, 0); PG8_LDB(B1, 0, 1); PG8_SCHED; PG8_LDA(At, 0, 0); PG8_STAGE(PG8_SA(1, 1), a1 + hstep, voffA);
            PG8_WAIT_V(8); PG8_WAIT_L(0); PG8_BAR; PG8_MMA(0, 0, At, B0); PG8_MMA(0, 1, At, B1); PG8_BAR; PG8_SCHED;
            PG8_LDA(At, 0, 1); PG8_STAGE(PG8_SB(0, 0), b2, voffB); PG8_STAGE(PG8_SB(0, 1), b2 + hstep, voffB); PG8_STAGE(PG8_SA(0, 0), a2, voffA);
            PG8_WAIT_V(8); PG8_WAIT_L(0); PG8_BAR; PG8_MMA(1, 0, At, B0); PG8_MMA(1, 1, At, B1); PG8_BAR; PG8_SCHED;
            PG8_LDB(B0, 1, 0); PG8_LDB(B1, 1, 1); PG8_SCHED; PG8_LDA(At, 1, 0); PG8_STAGE(PG8_SA(0, 1), a2 + hstep, voffA);
            PG8_WAIT_V(8); PG8_WAIT_L(0); PG8_BAR; PG8_MMA(0, 0, At, B0); PG8_MMA(0, 1, At, B1); PG8_BAR; PG8_SCHED;
            PG8_LDA(At, 1, 1); PG8_STAGE(PG8_SB(1, 0), b3, voffB); PG8_STAGE(PG8_SB(1, 1), b3 + hstep, voffB); PG8_STAGE(PG8_SA(1, 0), a3, voffA);
            PG8_WAIT_V(8); PG8_WAIT_L(0); PG8_BAR; PG8_MMA(1, 0, At, B0); PG8_MMA(1, 1, At, B1); PG8_BAR; PG8_SCHED;
            } else {
            PG8_LDB(B0, 0, 0); PG8_SCHED; PG8_LDA(At, 0, 0); PG8_STAGE(PG8_SA(1, 1), a1 + hstep, voffA);
            PG8_WAIT_L(8); PG8_BAR; PG8_WAIT_L(0); PG8_MMA(0, 0, At, B0); PG8_BAR; PG8_SCHED;
            PG8_LDB(B1, 0, 1); PG8_STAGE(PG8_SB(0, 0), b2, voffB);
            PG8_BAR; PG8_WAIT_L(0); PG8_MMA(0, 1, At, B1); PG8_BAR;
            PG8_LDA(At, 0, 1); PG8_STAGE(PG8_SA(0, 0), a2, voffA);
            PG8_BAR; PG8_WAIT_L(0); PG8_MMA(1, 0, At, B0); PG8_BAR; PG8_SCHED;
            PG8_STAGE(PG8_SB(0, 1), b2 + hstep, voffB);
            PG8_WAIT_V(6); PG8_BAR; PG8_MMA(1, 1, At, B1); PG8_BAR;
            PG8_LDB(B0, 1, 0); PG8_SCHED; PG8_LDA(At, 1, 0); PG8_STAGE(PG8_SA(0, 1), a2 + hstep, voffA);
            PG8_WAIT_L(8); PG8_BAR; PG8_WAIT_L(0); PG8_MMA(0, 0, At, B0); PG8_BAR; PG8_SCHED;
            PG8_LDB(B1, 1, 1); PG8_STAGE(PG8_SB(1, 0), b3, voffB);
            PG8_BAR; PG8_WAIT_L(0); PG8_MMA(0, 1, At, B1); PG8_BAR;
            PG8_LDA(At, 1, 1); PG8_STAGE(PG8_SA(1, 0), a3, voffA);
            PG8_BAR; PG8_WAIT_L(0); PG8_MMA(1, 0, At, B0); PG8_BAR; PG8_SCHED;
            PG8_STAGE(PG8_SB(1, 1), b3 + hstep, voffB);
            PG8_WAIT_V(6); PG8_BAR; PG8_MMA(1, 1, At, B1); PG8_BAR;
            }
        }
        if constexpr (ALIGN_EPI) { if (wr == 0) PG8_BAR; }
        if constexpr (!Epi::AFTER_DRAIN) { E(acc, cur, wr, wc, fr, fq); S.done(cur); }
        if (!has_next) break;
#pragma unroll
        for (int a = 0; a < 2; ++a)
#pragma unroll
            for (int b = 0; b < 2; ++b)
#pragma unroll
                for (int m = 0; m < 4; ++m)
#pragma unroll
                    for (int n = 0; n < 2; ++n) acc[a][b][m][n] = (f32x4){0.f, 0.f, 0.f, 0.f};
        cur = nxt; cA = nA; cB = nB; ++ui;
        if constexpr (ALIGN_EPI) { if (wr == 1) PG8_BAR; }
    }
    PG8_WAIT_V(0);
    if constexpr (!ALIGN_EPI) { if (wr == 0) PG8_BAR; }
    PG8_BAR;
    if constexpr (Epi::AFTER_DRAIN) { E.fused(acc, cur, wr, wc, fr, fq, lds, wid, lane); S.done(cur); }
#undef PG8_SA
#undef PG8_SB
#undef PG8_STAGE
#undef PG8_LDA
#undef PG8_LDB
#undef PG8_MMA
#undef PG8_WAIT_V
#undef PG8_WAIT_L
#undef PG8_BAR
#undef PG8_SCHED
}
}

constexpr int NWAVES = 8;
constexpr int NB = 4, SEQ = 4096, M = NB * SEQ, D = 4096, BW = 2048, FF = 11008, DEPTH = 2;
constexpr int IN_WIDTH = 30752;
constexpr int NIN_MAIN = 26880, NIN_PAD = 30976;
constexpr int LDH = 14336;
constexpr int H_CB = 0, H_CC = 2048, H_CH = 4096, H_NQ = 6144, H_NK = 8192, H_GQ = 10240, H_GK = 11264, H_GR = 12288;
constexpr float LN_EPS = 1e-5f, RMS_EPS = 1e-6f, ALPHA = 1.41421356237f;
#ifndef MK_MULTI
#define MK_MULTI 0
#endif
constexpr int N_PHASES = 1 + 11 * DEPTH;

constexpr size_t MiB = 1u << 20;
constexpr size_t alm(size_t x) { return (x + MiB - 1) / MiB * MiB; }
constexpr size_t WS_CTL = 0, CTL_ZERO_BYTES = 1 * MiB;
constexpr size_t SZ_WIN = alm((size_t)NIN_PAD * D * 2), SZ_WBR = alm((size_t)3 * D * BW * 2), SZ_WO = alm((size_t)D * D * 2), SZ_WFI = alm((size_t)2 * FF * D * 2), SZ_WFO = alm((size_t)D * FF * 2);
constexpr size_t OFF_WIN = 0, OFF_WBR = OFF_WIN + SZ_WIN, OFF_WO = OFF_WBR + SZ_WBR, OFF_WFI = OFF_WO + SZ_WO, OFF_WFO = OFF_WFI + SZ_WFI, SZ_WL = OFF_WFO + SZ_WFO;
constexpr size_t WS_W = 1 * MiB;
constexpr size_t WS_XB = WS_W + DEPTH * SZ_WL;
constexpr size_t WS_XR = WS_XB + alm((size_t)M * D * 2);
constexpr size_t WS_U = WS_XR + alm((size_t)M * D * 4);
constexpr size_t WS_HB = WS_U;
constexpr size_t WS_GA = WS_HB + alm((size_t)M * LDH * 2);
constexpr size_t WS_GATES = WS_GA + alm((size_t)M * 32 * 4);
constexpr size_t WS_VT = WS_GATES + alm((size_t)M * 12288 * 2);
constexpr size_t WS_YC = WS_VT + alm((size_t)4096 * M * 2);
constexpr size_t WS_YN = WS_YC + alm((size_t)M * BW * 2);
constexpr size_t WS_YG = WS_YN + alm((size_t)M * BW * 2);
constexpr size_t WS_QIN = WS_YG + alm((size_t)M * BW * 2);
constexpr size_t WS_KOT = WS_QIN + alm((size_t)2 * M * 1024 * 2);
constexpr size_t WS_ATT = WS_KOT + alm((size_t)2 * 1024 * M * 2);
constexpr size_t WS_DEC = WS_ATT + alm((size_t)2 * 4 * 4 * 64 * 64 * 64 * 2);
constexpr size_t WS_O = WS_DEC + alm((size_t)2 * 4 * 64 * 1024 * 4);
constexpr size_t WS_MIXED = WS_O + alm((size_t)2 * M * 2048 * 4);
constexpr size_t WS_END = WS_MIXED + alm((size_t)M * D * 2);
constexpr size_t WS_AU = WS_U;
constexpr size_t WS_G = WS_AU + alm((size_t)M * 2 * FF * 2);
static_assert(WS_G + alm((size_t)M * FF * 2) <= WS_MIXED, "the FFN overlay must stay below MIXED");
static_assert(WS_END <= (size_t)3844 * MiB, "d_ws budget: 4 x the largest input tensor");
constexpr int CW_BAR = 4096;

constexpr int RING_BYTES = 131072;
constexpr int LDS_BYTES = 159744;
constexpr int MISC_OFF = LDS_BYTES - 512;

#define GAS __attribute__((address_space(1)))
#define LAS __attribute__((address_space(3)))
typedef unsigned short bf16;
typedef unsigned v4u __attribute__((ext_vector_type(4)));
typedef unsigned v2u __attribute__((ext_vector_type(2)));
typedef float f32x4 __attribute__((ext_vector_type(4)));
typedef short bf16x8 __attribute__((ext_vector_type(8)));
typedef GAS unsigned gu32;
#define LDS_WAIT() asm volatile("s_waitcnt lgkmcnt(0)" ::: "memory")
#define VM_WAIT() asm volatile("s_waitcnt vmcnt(0)" ::: "memory")
__device__ __forceinline__ unsigned pk2(float lo, float hi) { return pg8::cvt_pk_bf16(lo, hi); }
__device__ __forceinline__ float bflo(unsigned w) { return __uint_as_float(w << 16); }
__device__ __forceinline__ float bfhi(unsigned w) { return __uint_as_float(w & 0xffff0000u); }
__device__ __forceinline__ float bf1(bf16 b) { return __uint_as_float(((unsigned)b) << 16); }
__device__ __forceinline__ void unpack8(const v4u w, float (&f)[8]) { f[0] = bflo(w.x); f[1] = bfhi(w.x); f[2] = bflo(w.y); f[3] = bfhi(w.y); f[4] = bflo(w.z); f[5] = bfhi(w.z); f[6] = bflo(w.w); f[7] = bfhi(w.w); }
__device__ __forceinline__ v4u pack8(const float (&f)[8]) { v4u w; w.x = pk2(f[0], f[1]); w.y = pk2(f[2], f[3]); w.z = pk2(f[4], f[5]); w.w = pk2(f[6], f[7]); return w; }
__device__ __forceinline__ float wave_sum(float v) {
#pragma unroll
    for (int o = 1; o < 64; o <<= 1) v += __shfl_xor(v, o);
    return v;
}
__device__ __forceinline__ f32x4 mfma16(bf16x8 a, bf16x8 b, f32x4 c) { return __builtin_amdgcn_mfma_f32_16x16x32_bf16(a, b, c, 0, 0, 0); }

#define XB_TMO      128
#define XB_XCNT(j)  (256  + 64 * (j))
#define XB_XSUB(j)  (1280 + 64 * (j))
#define XB_XGEN(j)  (2304 + 64 * (j))
#define XB_TOP      3328
#define XB_TOPGEN   3392
#define XCD_BAR_WORDS 3456
#define XB_SPIN_CAP (1u << 18)

__device__ __forceinline__ unsigned xb_ld(unsigned* p)              { return __hip_atomic_load(p, __ATOMIC_RELAXED, __HIP_MEMORY_SCOPE_AGENT); }
__device__ __forceinline__ unsigned xb_add(unsigned* p, unsigned v) { return __hip_atomic_fetch_add(p, v, __ATOMIC_RELAXED, __HIP_MEMORY_SCOPE_AGENT); }
__device__ __forceinline__ unsigned xb_xcc_id() { return (unsigned)__builtin_amdgcn_s_getreg((3 << 11) | 20) & 0xFu; }
#define XB_SPIN(cond, bar) do { unsigned _sp = 0; while (cond) { __builtin_amdgcn_s_sleep(1); \
    if ((++_sp & 255u) == 0u) { if (xb_ld(&(bar)[XB_TMO])) break; if (_sp > XB_SPIN_CAP) { atomicAdd(&(bar)[XB_TMO], 1u); break; } } } } while (0)

__device__ __forceinline__ unsigned xb_lane_id() { return __builtin_amdgcn_mbcnt_hi(~0u, __builtin_amdgcn_mbcnt_lo(~0u, 0u)); }
struct XcdBarrier {
    unsigned wv;
    unsigned* bar; unsigned x;
    volatile LAS unsigned* st;
};

__device__ __forceinline__ XcdBarrier xcd_barrier_post(unsigned* bar, volatile LAS unsigned* st) {
    XcdBarrier b; b.wv = 0u; b.bar = bar; b.x = xb_xcc_id(); b.st = st;
    if (threadIdx.x == 0) (void)xb_add(&bar[XB_XCNT(b.x)], 1u);
    return b;
}
__device__ __forceinline__ void xcd_barrier_complete(unsigned* bar, unsigned x, unsigned& nloc, unsigned& nx) {
    const unsigned G = gridDim.x * gridDim.y * gridDim.z;
    unsigned sum, cnt, mine, sp = 0u;
    for (;;) {
        sum = 0u; cnt = 0u; mine = 0u;
#pragma unroll
        for (unsigned j = 0; j < 16; ++j) { const unsigned c = xb_ld(&bar[XB_XCNT(j)]); sum += c; cnt += (c > 0u) ? 1u : 0u; mine = (j == x) ? c : mine; }
        if (sum == G) break;
        __builtin_amdgcn_s_sleep(1);
        if ((++sp & 255u) == 0u) { if (xb_ld(&bar[XB_TMO])) break; if (sp > XB_SPIN_CAP) { atomicAdd(&bar[XB_TMO], 1u); break; } }
    }
    nloc = mine > 0u ? mine : 1u; nx = cnt > 0u ? cnt : 1u;
}

__device__ __forceinline__ void xcd_barrier(const XcdBarrier& b) {
    asm volatile("s_waitcnt vmcnt(0)" ::: "memory");
    __syncthreads();
    if (b.wv == 0u && xb_lane_id() == 0u) {
        unsigned* bar = b.bar;
        __builtin_amdgcn_s_waitcnt(0);
        unsigned nloc = b.st[0], nx = b.st[1];
        if (nloc == 0u) { xcd_barrier_complete(bar, b.x, nloc, nx); b.st[0] = nloc; b.st[1] = nx; }
        const unsigned old = xb_add(&bar[XB_XSUB(b.x)], 1u);
        const unsigned gen = old / nloc;
        if (old + 1u == (gen + 1u) * nloc) {
            __builtin_amdgcn_fence(__ATOMIC_RELEASE, "agent");
            asm volatile("s_waitcnt vmcnt(0)" ::: "memory");
            const unsigned og = xb_add(&bar[XB_TOP], 1u);
            const unsigned tg = og / nx;
            if (og + 1u == (tg + 1u) * nx) xb_add(&bar[XB_TOPGEN], 1u);
            else XB_SPIN(xb_ld(&bar[XB_TOPGEN]) == tg, bar);
            __builtin_amdgcn_fence(__ATOMIC_ACQUIRE, "agent");
            xb_add(&bar[XB_XGEN(b.x)], 1u);
            asm volatile("s_waitcnt vmcnt(0)" ::: "memory");
        } else {
            XB_SPIN(xb_ld(&bar[XB_XGEN(b.x)]) == gen, bar);
            __builtin_amdgcn_fence(__ATOMIC_ACQUIRE, "agent");
            asm volatile("s_waitcnt vmcnt(0)" ::: "memory");
        }
    }
    __syncthreads();
}

struct Args { GAS const float* in[18]; GAS float* out; GAS unsigned char* ws; int ph_lo, ph_hi; };
typedef __attribute__((address_space(4))) const Args CArgs;
__device__ __forceinline__ CArgs* kargs() { CArgs* p = (CArgs*)__builtin_amdgcn_kernarg_segment_ptr(); asm volatile("" : "+s"(p)); return p; }
#define INP(i) ((const float*)kargs()->in[i])
#define OUTP ((float*)kargs()->out)
struct Frame { LAS unsigned char* lds; int wv; };
struct Ids { int tid, lane, wave, G, gw, NGW; };
__device__ __forceinline__ Ids phase_ids(const int wv) { Ids I; int t = wv * 64 + (int)__builtin_amdgcn_mbcnt_hi(~0u, __builtin_amdgcn_mbcnt_lo(~0u, 0u)); asm volatile("" : "+v"(t)); I.tid = t; I.lane = t & 63; I.wave = __builtin_amdgcn_readfirstlane(t >> 6);
    int g = gridDim.x; asm volatile("" : "+s"(g)); I.G = g; I.gw = blockIdx.x * NWAVES + I.wave; I.NGW = g * NWAVES; return I; }
#define WSP(T, off) ((T*)(GAS T*)(kargs()->ws + (off)))


__device__ __forceinline__ int win_src(int r) {
    if (r < 10240) return r;
    if (r < 12288) return 12288 + (r - 10240);
    if (r < 14336) return 16384 + (r - 12288);
    if (r < 14592) return r == 14336 ? 18432 : -1;
    if (r < 26880) return 18464 + (r - 14592);
    if (r < 28928) return 10240 + (r - 26880);
    return 14336 + (r - 28928);
}
__device__ __forceinline__ void tr_item(const float* W, size_t ldw, int K, int k0, int srcA, int srcB, bf16* WT, int n0, LAS float* scr, int lane) {
    const int src = lane < 32 ? srcA : srcB; const int cl = lane & 31;
    if (src >= 0) { const float* p = W + (size_t)k0 * ldw + src + cl;
#pragma unroll 16
        for (int kk = 0; kk < 64; ++kk) scr[kk * 65 + lane] = p[(size_t)kk * ldw];
    } else {
#pragma unroll 16
        for (int kk = 0; kk < 64; ++kk) scr[kk * 65 + lane] = 0.f;
    }
    LDS_WAIT(); asm volatile("" ::: "memory");
    const int c = lane & 7;
#pragma unroll
    for (int j = 0; j < 8; ++j) { const int n = (lane >> 3) + 8 * j; const LAS float* s = scr + (8 * c) * 65 + n;
        v4u o; o.x = pk2(s[0 * 65], s[1 * 65]); o.y = pk2(s[2 * 65], s[3 * 65]); o.z = pk2(s[4 * 65], s[5 * 65]); o.w = pk2(s[6 * 65], s[7 * 65]);
        *(v4u*)(WT + (size_t)(n0 + n) * K + k0 + 8 * c) = o; }
    LDS_WAIT(); asm volatile("" ::: "memory");
}
__device__ __forceinline__ void tr_matrix(const Ids& I, const float* W, int K, int N, bf16* WT, LAS float* scr) {
    const int nnb = N / 64, items = (K / 64) * nnb;
    for (int it = I.gw; it < items; it += I.NGW) { const int kb = it / nnb, nb = it % nnb; tr_item(W, (size_t)N, K, kb * 64, nb * 64, nb * 64 + 32, WT, nb * 64, scr, I.lane); }
}
__device__ __forceinline__ void p0_prologue(Frame& F) {
    const Ids I = phase_ids(F.wv);
    LAS float* scr = (LAS float*)(F.lds + I.wave * 16640);
    for (int l = 0; l < DEPTH; ++l) {
        unsigned char* wl = (unsigned char*)(kargs()->ws + WS_W + (size_t)l * SZ_WL);
        { const float* W = INP(1) + (size_t)l * D * IN_WIDTH; bf16* WT = (bf16*)(wl + OFF_WIN);
            const int nnb = NIN_PAD / 64, items = (D / 64) * nnb;
            for (int it = I.gw; it < items; it += I.NGW) { const int kb = it / nnb, nb = it % nnb; tr_item(W, (size_t)IN_WIDTH, D, kb * 64, win_src(nb * 64), win_src(nb * 64 + 32), WT, nb * 64, scr, I.lane); } }
        for (int i = 0; i < 3; ++i) tr_matrix(I, INP(8) + ((size_t)l * 3 + i) * BW * D, BW, D, (bf16*)(wl + OFF_WBR) + (size_t)i * D * BW, scr);
        tr_matrix(I, INP(9) + (size_t)l * D * D, D, D, (bf16*)(wl + OFF_WO), scr);
        tr_matrix(I, INP(12) + (size_t)l * D * 2 * FF, D, 2 * FF, (bf16*)(wl + OFF_WFI), scr);
        tr_matrix(I, INP(15) + (size_t)l * FF * D, FF, D, (bf16*)(wl + OFF_WFO), scr);
    }
    { const f32x4* x4 = (const f32x4*)INP(0); v4u* o = WSP(v4u, WS_XB); const size_t n8 = (size_t)M * D / 8, stride = (size_t)I.G * 512;
      for (size_t i = (size_t)blockIdx.x * 512 + I.tid; i < n8; i += stride) { const f32x4 a = x4[2 * i], b = x4[2 * i + 1]; v4u w; w.x = pk2(a[0], a[1]); w.y = pk2(a[2], a[3]); w.z = pk2(b[0], b[1]); w.w = pk2(b[2], b[3]); o[i] = w; } }
}

__device__ __forceinline__ void conv_mixer_phase(Frame& F, int layer) {
    const Ids I = phase_ids(F.wv);
    const bf16* HB = WSP(const bf16, WS_HB); bf16* YC = WSP(bf16, WS_YC); const float* wc = INP(3) + (size_t)layer * 3 * BW;
    const int c8 = (I.tid & 255) * 8, half = I.tid >> 8;
    float w[3][8];
#pragma unroll
    for (int i = 0; i < 3; ++i) { const f32x4 a = *(const f32x4*)(wc + i * BW + c8), b = *(const f32x4*)(wc + i * BW + c8 + 4);
        w[i][0] = a[0]; w[i][1] = a[1]; w[i][2] = a[2]; w[i][3] = a[3]; w[i][4] = b[0]; w[i][5] = b[1]; w[i][6] = b[2]; w[i][7] = b[3]; }
    for (int it = blockIdx.x; it < M / 2; it += I.G) {
        const int m = 2 * it + half, s = m & (SEQ - 1);
        const bf16* row = HB + (size_t)m * LDH + c8;
        float acc[8], cb[8], x[8], y[8];
        unpack8(*(const v4u*)(row + H_CC), x); unpack8(*(const v4u*)(row + H_CH), y);
#pragma unroll
        for (int e = 0; e < 8; ++e) acc[e] = w[1][e] * (x[e] * y[e]);
        if (s > 0) { unpack8(*(const v4u*)(row - LDH + H_CC), x); unpack8(*(const v4u*)(row - LDH + H_CH), y);
#pragma unroll
            for (int e = 0; e < 8; ++e) acc[e] += w[0][e] * (x[e] * y[e]); }
        if (s < SEQ - 1) { unpack8(*(const v4u*)(row + LDH + H_CC), x); unpack8(*(const v4u*)(row + LDH + H_CH), y);
#pragma unroll
            for (int e = 0; e < 8; ++e) acc[e] += w[2][e] * (x[e] * y[e]); }
        unpack8(*(const v4u*)(row + H_CB), cb);
#pragma unroll
        for (int e = 0; e < 8; ++e) acc[e] *= cb[e];
        *(v4u*)(YC + (size_t)m * BW + c8) = pack8(acc);
    }
}
__device__ __forceinline__ void ln_phase(Frame& F, const float* V, const float* g, const float* b, float* XF, bf16* XBo) {
    const Ids I = phase_ids(F.wv);
    for (int m = I.gw; m < M; m += I.NGW) {
        const f32x4* vr = (const f32x4*)(V + (size_t)m * D) + I.lane;
        f32x4 v[16]; float s = 0.f;
#pragma unroll
        for (int j = 0; j < 16; ++j) { v[j] = vr[64 * j]; s += (v[j][0] + v[j][1]) + (v[j][2] + v[j][3]); }
        const float mean = wave_sum(s) * (1.f / D); float s2 = 0.f;
#pragma unroll
        for (int j = 0; j < 16; ++j) { v[j] = v[j] - mean; s2 += (v[j][0] * v[j][0] + v[j][1] * v[j][1]) + (v[j][2] * v[j][2] + v[j][3] * v[j][3]); }
        const float rstd = 1.f / sqrtf(wave_sum(s2) * (1.f / D) + LN_EPS);
        f32x4* xo = (f32x4*)(XF + (size_t)m * D) + I.lane; v2u* bo = (v2u*)(XBo + (size_t)m * D) + I.lane;
#pragma unroll
        for (int j = 0; j < 16; ++j) { const f32x4 gg = ((const f32x4*)g)[I.lane + 64 * j], bb = ((const f32x4*)b)[I.lane + 64 * j];
            const f32x4 o = v[j] * rstd * gg + bb; xo[64 * j] = o; v2u w; w.x = pk2(o[0], o[1]); w.y = pk2(o[2], o[3]); bo[64 * j] = w; }
    }
}
__device__ __forceinline__ void convglu_phase(Frame& F, int layer) {
    const Ids I = phase_ids(F.wv);
    const bf16* AU = WSP(const bf16, WS_AU); bf16* G = WSP(bf16, WS_G);
    const float* wc = INP(13) + (size_t)layer * 3 * FF; const float* bc = INP(14) + (size_t)layer * FF;
    constexpr int J = FF / 8; const size_t total = (size_t)M * J, stride = (size_t)I.G * 512;
    for (size_t idx = (size_t)blockIdx.x * 512 + I.tid; idx < total; idx += stride) {
        const int m = (int)(idx / J), c8 = (int)(idx % J) * 8, s = m & (SEQ - 1);
        const bf16* row = AU + (size_t)m * (2 * FF) + c8;
        float a[8], acc[8], wv[8];
        { const f32x4 x = *(const f32x4*)(bc + c8), y = *(const f32x4*)(bc + c8 + 4); acc[0] = x[0]; acc[1] = x[1]; acc[2] = x[2]; acc[3] = x[3]; acc[4] = y[0]; acc[5] = y[1]; acc[6] = y[2]; acc[7] = y[3]; }
#define CG_TAP(i, ptr) { unpack8(*(const v4u*)(ptr), a); const f32x4 x = *(const f32x4*)(wc + (i) * FF + c8), y = *(const f32x4*)(wc + (i) * FF + c8 + 4); \
            wv[0] = x[0]; wv[1] = x[1]; wv[2] = x[2]; wv[3] = x[3]; wv[4] = y[0]; wv[5] = y[1]; wv[6] = y[2]; wv[7] = y[3]; _Pragma("unroll") for (int e = 0; e < 8; ++e) acc[e] += wv[e] * a[e]; }
        CG_TAP(1, row)
        if (s > 0) CG_TAP(0, row - 2 * FF)
        if (s < SEQ - 1) CG_TAP(2, row + 2 * FF)
#undef CG_TAP
        float u[8]; unpack8(*(const v4u*)(row + FF), u);
#pragma unroll
        for (int e = 0; e < 8; e += 2) { const pg8::f32x2 gl = pg8::gelu_pk((pg8::f32x2){acc[e], acc[e + 1]}); acc[e] = gl.x * u[e]; acc[e + 1] = gl.y * u[e + 1]; }
        *(v4u*)(G + (size_t)m * FF + c8) = pack8(acc);
    }
}
__device__ __forceinline__ void gla_combine_phase(Frame& F, int layer) {
    const Ids I = phase_ids(F.wv);
    const float* O0 = WSP(const float, WS_O); const float* O1 = O0 + (size_t)M * 2048; const bf16* HB = WSP(const bf16, WS_HB); bf16* YG = WSP(bf16, WS_YG);
    const float* ng = INP(7) + (size_t)layer * 2048;
    for (int idx = I.gw; idx < M * 4; idx += I.NGW) {
        const int m = idx >> 2, h = idx & 3; const size_t off = (size_t)m * 2048 + h * 512 + 8 * I.lane;
        const f32x4 a0 = *(const f32x4*)(O0 + off), a1 = *(const f32x4*)(O0 + off + 4), b0 = *(const f32x4*)(O1 + off), b1 = *(const f32x4*)(O1 + off + 4);
        float o[8] = {a0[0] + b0[0], a0[1] + b0[1], a0[2] + b0[2], a0[3] + b0[3], a1[0] + b1[0], a1[1] + b1[1], a1[2] + b1[2], a1[3] + b1[3]};
        float ss = 0.f;
#pragma unroll
        for (int e = 0; e < 8; ++e) ss += o[e] * o[e];
        const float rs = 1.f / sqrtf(wave_sum(ss) * (1.f / 512.f) + RMS_EPS);
        float r[8]; unpack8(*(const v4u*)(HB + (size_t)m * LDH + H_GR + h * 512 + 8 * I.lane), r);
        const f32x4 g0 = *(const f32x4*)(ng + h * 512 + 8 * I.lane), g1 = *(const f32x4*)(ng + h * 512 + 8 * I.lane + 4);
        const float gg[8] = {g0[0], g0[1], g0[2], g0[3], g1[0], g1[1], g1[2], g1[3]};
#pragma unroll
        for (int e = 0; e < 8; ++e) o[e] = o[e] * rs * gg[e] * (r[e] / (1.f + __expf(-r[e])));
        *(v4u*)(YG + off) = pack8(o);
    }
}

__device__ __forceinline__ void na_phase(Frame& F, int layer) {
    const Ids I = phase_ids(F.wv);
    const bf16* HB = WSP(const bf16, WS_HB); const bf16* VT = WSP(const bf16, WS_VT); bf16* YN = WSP(bf16, WS_YN);
    const float* rpb = INP(4) + (size_t)layer * 16 * 465;
    LAS float* rpbs = (LAS float*)F.lds;
    const int fr = I.lane & 15, q4 = I.lane >> 4;
    for (int it = blockIdx.x; it < 2048; it += I.G) {
        const int rblk = it & 7, cblk = (it >> 3) & 3, h = (it >> 5) & 15, b = it >> 9;
        __syncthreads();
        for (int i = I.tid; i < 465; i += 512) rpbs[i] = rpb[h * 465 + i];
        __syncthreads();
        const int r = rblk * 8 + I.wave, c0 = cblk * 16;
        const int rs = min(max(r - 4, 0), 56), cs = min(max(c0 - 8, 0), 32);
        const int mq = b * SEQ + r * 64 + c0 + fr;
        const bf16* qp = HB + (size_t)mq * LDH + H_NQ + h * 128 + 8 * q4;
        bf16x8 qf[4];
#pragma unroll
        for (int s = 0; s < 4; ++s) qf[s] = *(const bf16x8*)(qp + 32 * s);
        const int cq = c0 + fr, ws = min(max(cq - 8, 0), 48);
        f32x4 sc[8][2];
        float mx = -1e30f;
#pragma unroll
        for (int sp = 0; sp < 8; ++sp)
#pragma unroll
            for (int u = 0; u < 2; ++u) {
                const int coloff = 8 * (fr >> 2) + 4 * u + (fr & 3);
                const int mk = b * SEQ + (rs + sp) * 64 + cs + coloff;
                const bf16* kp = HB + (size_t)mk * LDH + H_NK + h * 128 + 8 * q4;
                f32x4 d = (f32x4){0.f, 0.f, 0.f, 0.f};
#pragma unroll
                for (int s = 0; s < 4; ++s) d = mfma16(*(const bf16x8*)(kp + 32 * s), qf[s], d);
                const int brow = (rs + sp - r + 7) * 31;
#pragma unroll
                for (int j = 0; j < 4; ++j) { const int kc = cs + 8 * q4 + 4 * u + j; const bool valid = (kc >= ws) && (kc < ws + 16);
                    const int bi = min(max(kc - cq + 15, 0), 30);
                    const float v = valid ? d[j] * 0.08838834764831845f + rpbs[brow + bi] : -1e30f;
                    sc[sp][u][j] = v; mx = fmaxf(mx, v); }
            }
        mx = fmaxf(mx, __shfl_xor(mx, 16)); mx = fmaxf(mx, __shfl_xor(mx, 32));
        float sum = 0.f;
        bf16x8 pf[8];
#pragma unroll
        for (int sp = 0; sp < 8; ++sp) { float p[8];
#pragma unroll
            for (int u = 0; u < 2; ++u)
#pragma unroll
                for (int j = 0; j < 4; ++j) { const float e = __builtin_amdgcn_exp2f((sc[sp][u][j] - mx) * 1.44269504f); p[4 * u + j] = e; sum += e; }
            const v4u w = pack8(p); pf[sp] = __builtin_bit_cast(bf16x8, w); }
        sum += __shfl_xor(sum, 16); sum += __shfl_xor(sum, 32);
        const float inv = 1.f / sum;
        const bf16* vp = VT + (size_t)(h * 128 + fr) * M + b * SEQ + rs * 64 + cs + 8 * q4;
#pragma unroll
        for (int dt = 0; dt < 8; ++dt) { f32x4 o = (f32x4){0.f, 0.f, 0.f, 0.f};
#pragma unroll
            for (int sp = 0; sp < 8; ++sp) o = mfma16(*(const bf16x8*)(vp + (size_t)(16 * dt) * M + sp * 64), pf[sp], o);
            v2u w; w.x = pk2(o[0] * inv, o[1] * inv); w.y = pk2(o[2] * inv, o[3] * inv);
            *(v2u*)(YN + (size_t)mq * BW + h * 128 + 16 * dt + 4 * q4) = w; }
    }
}

__device__ __forceinline__ float logsigmoidf_(float z) { return fminf(z, 0.f) - log1pf(__expf(-fabsf(z))); }
__device__ __forceinline__ void gla_prep_phase(Frame& F, int layer) {
    const Ids I = phase_ids(F.wv);
    constexpr int RS = 264;
    LAS bf16* qs = (LAS bf16*)F.lds; LAS bf16* ks = qs + 2 * 64 * RS; LAS float* gas = (LAS float*)(ks + 2 * 64 * RS);
    const bf16* HB = WSP(const bf16, WS_HB); const float* GA = WSP(const float, WS_GA);
    bf16* QIN = WSP(bf16, WS_QIN); bf16* KOT = WSP(bf16, WS_KOT); bf16* ATT = WSP(bf16, WS_ATT); float* DEC = WSP(float, WS_DEC);
    const float* wdec = INP(5) + (size_t)layer * 2 * 16 * 1024; const float* bdec = INP(6) + (size_t)layer * 2 * 1024;
    const int dir = I.tid >> 8, c = I.tid & 255, fr = I.lane & 15, q4 = I.lane >> 4;
    for (int it = blockIdx.x; it < 1024; it += I.G) {
        const int h = it & 3, chunk = (it >> 2) & 63, b = it >> 8, m0 = b * SEQ + chunk * 64, ch = h * 256 + c;
        __syncthreads();
        ((LAS f32x4*)gas)[I.tid] = ((const f32x4*)(GA + (size_t)m0 * 32))[I.tid];
        float w[16];
#pragma unroll
        for (int r = 0; r < 16; ++r) w[r] = wdec[(dir * 16 + r) * 1024 + ch];
        const float bd = bdec[dir * 1024 + ch];
        __syncthreads();
        const LAS float* ga = gas + dir * 16;
        float tot = 0.f;
#pragma unroll 4
        for (int t = 0; t < 64; ++t) { float z = bd;
#pragma unroll
            for (int r = 0; r < 16; ++r) z += ga[t * 32 + r] * w[r];
            tot += logsigmoidf_(z) * 0.0625f; }
        float run = 0.f; unsigned ko[32];
        const bf16* qg = HB + (size_t)m0 * LDH + H_GQ + ch; const bf16* kg = HB + (size_t)m0 * LDH + H_GK + ch;
        bf16* qo = QIN + ((size_t)dir * M + m0) * 1024 + ch;
#pragma unroll
        for (int tt = 0; tt < 32; ++tt) { float kov[2];
#pragma unroll
            for (int e = 0; e < 2; ++e) { const int t = 2 * tt + e; float z = bd;
#pragma unroll
                for (int r = 0; r < 16; ++r) z += ga[t * 32 + r] * w[r];
                const float la = logsigmoidf_(z) * 0.0625f; float cum;
                if (dir == 0) { run += la; cum = run; } else { cum = tot - run; run += la; }
                const float qv = bf1(qg[(size_t)t * LDH]), kv = bf1(kg[(size_t)t * LDH]);
                const float q_in = qv * 0.0625f * __expf(cum), k_in = kv * __expf(-cum); kov[e] = kv * __expf(tot - cum);
                const unsigned qb = pk2(q_in, 0.f) & 0xffffu, kb = pk2(k_in, 0.f) & 0xffffu;
                qs[(dir * 64 + t) * RS + c] = (bf16)qb; ks[(dir * 64 + t) * RS + c] = (bf16)kb; qo[(size_t)t * 1024] = (bf16)qb; }
            ko[tt] = pk2(kov[0], kov[1]); }
        { v4u* kd = (v4u*)(KOT + ((size_t)dir * 1024 + ch) * M + m0);
#pragma unroll
            for (int i = 0; i < 8; ++i) { v4u w4; w4.x = ko[4 * i]; w4.y = ko[4 * i + 1]; w4.z = ko[4 * i + 2]; w4.w = ko[4 * i + 3]; kd[i] = w4; } }
        DEC[(((size_t)dir * 4 + b) * 64 + chunk) * 1024 + ch] = __expf(tot);
        __syncthreads();
        { const int adir = I.wave >> 2, mt = I.wave & 3, i = 16 * mt + fr;
          const LAS bf16* qrow = qs + (adir * 64 + i) * RS + 8 * q4;
          bf16* arow = ATT + (((((size_t)adir * 4 + b) * 4 + h) * 64 + chunk) * 64 + i) * 64;
#pragma unroll
          for (int nt = 0; nt < 4; ++nt) { const LAS bf16* krow = ks + (adir * 64 + 16 * nt + fr) * RS + 8 * q4;
              f32x4 d = (f32x4){0.f, 0.f, 0.f, 0.f};
#pragma unroll
              for (int s = 0; s < 8; ++s) d = mfma16(*(const LAS bf16x8*)(krow + 32 * s), *(const LAS bf16x8*)(qrow + 32 * s), d);
              const int j0 = 16 * nt + 4 * q4; float v[4];
#pragma unroll
              for (int jj = 0; jj < 4; ++jj) { const bool keep = adir == 0 ? (j0 + jj <= i) : (j0 + jj >= i); v[jj] = keep ? d[jj] : 0.f; }
              v2u w2; w2.x = pk2(v[0], v[1]); w2.y = pk2(v[2], v[3]); *(v2u*)(arow + j0) = w2; } }
    }
}
constexpr int SCAN_Q = 0, SCAN_K = 32768, SCAN_A = 65536, SCAN_D = 73728, SCAN_BUF = 74752;
__device__ __forceinline__ void scan_stage(const bf16* QIN, const bf16* KOT, const bf16* ATT, const float* DEC, LAS unsigned char* buf, int lw, int lane, int dir, int b, int h, int c) {
    const int m0 = b * SEQ + c * 64;
    const int sb_ = lane * 16, swz = sb_ ^ (((sb_ >> 9) & 1) << 5), rl = swz >> 6, cl = (swz & 63) >> 1;
#pragma unroll
    for (int i = 0; i < 8; ++i) { const int q = lw * 8 + i, sl = q >> 3, j = q & 7, R = (j >> 1) * 16 + rl, C = (j & 1) * 32 + cl;
        __builtin_amdgcn_global_load_lds((const GAS unsigned*)(QIN + ((size_t)dir * M + m0 + R) * 1024 + h * 256 + sl * 64 + C), (LAS unsigned*)(buf + SCAN_Q + sl * 8192 + j * 1024), 16, 0, 0); }
#pragma unroll
    for (int i = 0; i < 8; ++i) { const int k = lw * 8 + i, hh = k >> 4, j = k & 15, Rg = 128 * hh + (j >> 1) * 16 + rl, C = (j & 1) * 32 + cl, Rb = (Rg & ~31) + pg8::perm32(Rg & 31);
        __builtin_amdgcn_global_load_lds((const GAS unsigned*)(KOT + ((size_t)dir * 1024 + h * 256 + Rb) * M + m0 + C), (LAS unsigned*)(buf + SCAN_K + hh * 16384 + j * 1024), 16, 0, 0); }
    const bf16* ab = ATT + ((((size_t)dir * 4 + b) * 4 + h) * 64 + c) * 4096;
#pragma unroll
    for (int i = 0; i < 2; ++i) { const int j = lw * 2 + i, R = (j >> 1) * 16 + rl, C = (j & 1) * 32 + cl;
        __builtin_amdgcn_global_load_lds((const GAS unsigned*)(ab + R * 64 + C), (LAS unsigned*)(buf + SCAN_A + j * 1024), 16, 0, 0); }
    if (lw == 0) __builtin_amdgcn_global_load_lds((const GAS unsigned*)(DEC + (((size_t)dir * 4 + b) * 64 + c) * 1024 + h * 256 + lane * 4), (LAS unsigned*)(buf + SCAN_D), 16, 0, 0);
}
__device__ __forceinline__ void gla_scan_phase(Frame& F) {
    const Ids I = phase_ids(F.wv);
    const bf16* VT = WSP(const bf16, WS_VT); const bf16* QIN = WSP(const bf16, WS_QIN); const bf16* KOT = WSP(const bf16, WS_KOT); const bf16* ATT = WSP(const bf16, WS_ATT);
    const float* DEC = WSP(const float, WS_DEC); float* O = WSP(float, WS_O);
    const int fr = I.lane & 15, q4 = I.lane >> 4;
    for (int bt = blockIdx.x; bt < 256; bt += I.G) {
        const int x = bt & 7, y = bt >> 3, sc = x * 4 + (y >> 3), eq = y & 7;
        const int dir = sc & 1, h = (sc >> 1) & 3, b = sc >> 3;
        asm volatile("s_waitcnt vmcnt(0) lgkmcnt(0)" ::: "memory"); __builtin_amdgcn_s_barrier(); asm volatile("" ::: "memory");
        if (I.wave >= 4) {
            const int lw = I.wave - 4;
            scan_stage(QIN, KOT, ATT, DEC, F.lds, lw, I.lane, dir, b, h, dir ? 63 : 0);
            asm volatile("s_waitcnt vmcnt(0)" ::: "memory"); __builtin_amdgcn_s_barrier(); asm volatile("" ::: "memory");
            for (int step = 0; step < 64; ++step) {
                if (step + 1 < 64) scan_stage(QIN, KOT, ATT, DEC, F.lds + ((step + 1) & 1) * SCAN_BUF, lw, I.lane, dir, b, h, dir ? 62 - step : step + 1);
                asm volatile("s_waitcnt vmcnt(0)" ::: "memory"); __builtin_amdgcn_s_barrier(); asm volatile("" ::: "memory");
            }
        } else {
            const int es = eq * 4 + I.wave;
            f32x4 st[16];
#pragma unroll
            for (int t = 0; t < 16; ++t) st[t] = (f32x4){0.f, 0.f, 0.f, 0.f};
            const bf16* vrow = VT + (size_t)(2048 + h * 512 + es * 16 + fr) * M + b * SEQ + 8 * q4;
            const int ob = fr * 64 + 16 * q4, lo = ob ^ (((ob >> 9) & 1) << 5);
            bf16x8 vf[2];
            { const int c0 = dir ? 63 : 0;
#pragma unroll
              for (int sp = 0; sp < 2; ++sp) vf[sp] = *(const bf16x8*)(vrow + c0 * 64 + 32 * sp); }
            asm volatile("" ::: "memory"); __builtin_amdgcn_s_barrier(); asm volatile("" ::: "memory");
            for (int step = 0; step < 64; ++step) {
                const int c = dir ? 63 - step : step, m0 = b * SEQ + c * 64;
                const LAS unsigned char* bb = F.lds + (step & 1) * SCAN_BUF + lo;
                bf16x8 vn[2];
                { const int cn = step + 1 < 64 ? (dir ? 62 - step : step + 1) : c;
#pragma unroll
                  for (int sp = 0; sp < 2; ++sp) vn[sp] = *(const bf16x8*)(vrow + cn * 64 + 32 * sp); }
                bf16x8 sb[8];
#pragma unroll
                for (int s = 0; s < 8; ++s) { v4u w; w.x = pk2(st[2 * s][0], st[2 * s][1]); w.y = pk2(st[2 * s][2], st[2 * s][3]); w.z = pk2(st[2 * s + 1][0], st[2 * s + 1][1]); w.w = pk2(st[2 * s + 1][2], st[2 * s + 1][3]); sb[s] = __builtin_bit_cast(bf16x8, w); }
#pragma unroll
                for (int mt = 0; mt < 4; ++mt) { f32x4 o = (f32x4){0.f, 0.f, 0.f, 0.f};
#pragma unroll
                    for (int s = 0; s < 8; ++s) o = mfma16(sb[s], *(const LAS bf16x8*)(bb + SCAN_Q + (s >> 1) * 8192 + (2 * mt + (s & 1)) * 1024), o);
#pragma unroll
                    for (int sp = 0; sp < 2; ++sp) o = mfma16(vf[sp], *(const LAS bf16x8*)(bb + SCAN_A + (2 * mt + sp) * 1024), o);
                    *(f32x4*)(O + ((size_t)dir * M + m0 + 16 * mt + fr) * 2048 + h * 512 + es * 16 + 4 * q4) = o; }
                const LAS unsigned char* dbase = F.lds + (step & 1) * SCAN_BUF + SCAN_D + 32 * q4;
#pragma unroll
                for (int s = 0; s < 8; ++s)
#pragma unroll
                    for (int u = 0; u < 2; ++u) { const int t = 2 * s + u;
                        const f32x4 dc = *(const LAS f32x4*)(dbase + (32 * s + 4 * u) * 4);
                        f32x4 a = st[t] * dc;
#pragma unroll
                        for (int sp = 0; sp < 2; ++sp) a = mfma16(*(const LAS bf16x8*)(bb + SCAN_K + (s >> 2) * 16384 + ((2 * (s & 3) + u) * 2 + sp) * 1024), vf[sp], a);
                        st[t] = a; }
                vf[0] = vn[0]; vf[1] = vn[1];
                asm volatile("s_waitcnt lgkmcnt(0)" ::: "memory"); __builtin_amdgcn_s_barrier(); asm volatile("" ::: "memory");
            }
        }
    }
}


#ifndef PHM
#define PHM 0xffff
#endif
#ifndef REPM
#define REPM 0
#endif
#define RP(bit) for (int rep_ = 0; rep_ < ((REPM & (bit)) ? 2 : 1); ++rep_)
__global__ void __launch_bounds__(NWAVES * 64, 2) enc_fwd(Args args) {
    extern __shared__ __attribute__((aligned(16))) unsigned char lds[];
    Frame F;
    F.lds = (LAS unsigned char*)lds; F.wv = __builtin_amdgcn_readfirstlane(threadIdx.x >> 6);
    volatile LAS unsigned* MISC = (volatile LAS unsigned*)(F.lds + MISC_OFF);
    if (threadIdx.x < 128) MISC[threadIdx.x] = 0u;
    __syncthreads();
    (void)xcd_barrier_post((unsigned*)(GAS unsigned*)(args.ws + WS_CTL) + CW_BAR, MISC + 8);
#if MK_MULTI
#define IN(k) (kargs()->ph_lo <= (k) && (k) < kargs()->ph_hi)
#else
#define IN(k) true
#endif
#define SEAM(k) do { if (IN((k) + 1)) { XcdBarrier bb; bb.wv = (unsigned)F.wv; bb.bar = (unsigned*)(GAS unsigned*)(kargs()->ws + WS_CTL) + CW_BAR; bb.x = (unsigned)__builtin_amdgcn_readfirstlane((int)xb_xcc_id()); bb.st = (volatile LAS unsigned*)(F.lds + MISC_OFF) + 8; xcd_barrier(bb); } } while (0)
    LAS unsigned char* ring = F.lds;

    if (IN(0)) { RP(1) p0_prologue(F); SEAM(0); }

    for (int layer = 0; layer < DEPTH; ++layer) {
        const int pb = 1 + 11 * layer;
#define WL ((unsigned char*)(kargs()->ws + WS_W + (size_t)layer * SZ_WL))

        const pg8::bf16_t* XB = WSP(const pg8::bf16_t, WS_XB);
        if (IN(pb + 0)) { RP(2) {
            { pg8::Gemm g{XB, (const pg8::bf16_t*)(WL + OFF_WIN), M, NIN_MAIN, D}; pg8::StaticOrder S; S.init(M, NIN_MAIN, (int)gridDim.x, (int)blockIdx.x);
              pg8::EpiIn E{WSP(pg8::bf16_t, WS_HB), LDH, WSP(float, WS_GA), WSP(pg8::bf16_t, WS_GATES), INP(2) + (size_t)layer * 3 * D};
              pg8::gemm_phase<pg8::EpiIn, pg8::StaticOrder, true, true>(ring, g, S, E, F.wv); }
            { pg8::Gemm g{(const pg8::bf16_t*)(WL + OFF_WIN) + (size_t)NIN_MAIN * D, XB, 4096, M, D}; pg8::StaticOrder S; S.init(4096, M, (int)gridDim.x, (int)blockIdx.x);
              pg8::EpiBf16 E{WSP(pg8::bf16_t, WS_VT), M};
              pg8::gemm_phase<pg8::EpiBf16, pg8::StaticOrder, true, true>(ring, g, S, E, F.wv); } }
            SEAM(pb + 0);
        }
        if (IN(pb + 1)) { RP(4) conv_mixer_phase(F, layer); RP(8) gla_prep_phase(F, layer); RP(16) na_phase(F, layer); SEAM(pb + 1); }
        if (IN(pb + 2)) { RP(32) gla_scan_phase(F); SEAM(pb + 2); }
        if (IN(pb + 3)) { RP(64) gla_combine_phase(F, layer); SEAM(pb + 3); }
        if (IN(pb + 4)) { RP(128) {
            pg8::StaticOrder S; S.init(M, D, (int)gridDim.x, (int)blockIdx.x);
            { pg8::Gemm g{WSP(const pg8::bf16_t, WS_YC), (const pg8::bf16_t*)(WL + OFF_WBR), M, D, BW};
              pg8::EpiBranch<0> E{WSP(pg8::bf16_t, WS_MIXED), WSP(const pg8::bf16_t, WS_GATES)}; pg8::gemm_phase<pg8::EpiBranch<0>, pg8::StaticOrder, true, true>(ring, g, S, E, F.wv); }
            { pg8::Gemm g{WSP(const pg8::bf16_t, WS_YN), (const pg8::bf16_t*)(WL + OFF_WBR) + (size_t)D * BW, M, D, BW};
              pg8::EpiBranch<1> E{WSP(pg8::bf16_t, WS_MIXED), WSP(const pg8::bf16_t, WS_GATES)}; pg8::gemm_phase<pg8::EpiBranch<1>, pg8::StaticOrder, true, true>(ring, g, S, E, F.wv); }
            { pg8::Gemm g{WSP(const pg8::bf16_t, WS_YG), (const pg8::bf16_t*)(WL + OFF_WBR) + (size_t)2 * D * BW, M, D, BW};
              pg8::EpiBranch<2> E{WSP(pg8::bf16_t, WS_MIXED), WSP(const pg8::bf16_t, WS_GATES)}; pg8::gemm_phase<pg8::EpiBranch<2>, pg8::StaticOrder, true, true>(ring, g, S, E, F.wv); } }
            SEAM(pb + 4);
        }
        const float* xres = layer == 0 ? INP(0) : WSP(const float, WS_XR);
        if (IN(pb + 5)) { {
            pg8::Gemm g{WSP(const pg8::bf16_t, WS_MIXED), (const pg8::bf16_t*)(WL + OFF_WO), M, D, D}; pg8::StaticOrder S; S.init(M, D, (int)gridDim.x, (int)blockIdx.x);
            pg8::EpiResid E{WSP(float, WS_XR), xres, D, ALPHA}; pg8::gemm_phase<pg8::EpiResid, pg8::StaticOrder, true, true>(ring, g, S, E, F.wv); }
            SEAM(pb + 5);
        }
        if (IN(pb + 6)) { ln_phase(F, WSP(const float, WS_XR), INP(10) + (size_t)layer * D, INP(11) + (size_t)layer * D, WSP(float, WS_XR), WSP(bf16, WS_XB)); SEAM(pb + 6); }
        if (IN(pb + 7)) { RP(1024) {
            pg8::Gemm g{XB, (const pg8::bf16_t*)(WL + OFF_WFI), M, 2 * FF, D}; pg8::StaticOrder S; S.init(M, 2 * FF, (int)gridDim.x, (int)blockIdx.x);
            pg8::EpiBf16 E{WSP(pg8::bf16_t, WS_AU), 2 * FF}; pg8::gemm_phase<pg8::EpiBf16, pg8::StaticOrder, true, true>(ring, g, S, E, F.wv); }
            SEAM(pb + 7);
        }
        if (IN(pb + 8)) { RP(2048) convglu_phase(F, layer); SEAM(pb + 8); }
        if (IN(pb + 9)) { {
            pg8::Gemm g{WSP(const pg8::bf16_t, WS_G), (const pg8::bf16_t*)(WL + OFF_WFO), M, D, FF}; pg8::StaticOrder S; S.init(M, D, (int)gridDim.x, (int)blockIdx.x);
            pg8::EpiResid E{WSP(float, WS_XR), WSP(const float, WS_XR), D, ALPHA}; pg8::gemm_phase<pg8::EpiResid, pg8::StaticOrder, true, true>(ring, g, S, E, F.wv); }
            SEAM(pb + 9);
        }
        if (IN(pb + 10)) { ln_phase(F, WSP(const float, WS_XR), INP(16) + (size_t)layer * D, INP(17) + (size_t)layer * D, layer == DEPTH - 1 ? OUTP : WSP(float, WS_XR), WSP(bf16, WS_XB)); SEAM(pb + 10); }
    }
#undef IN
#undef SEAM
}

extern "C" void kernel_launch(void* const* d_in, const int* in_sizes, int n_in, void* d_out, int out_size, void* d_ws, size_t ws_size, hipStream_t stream) {
    static int grid = 0;
    if (grid == 0) {
        if (n_in != 18 || in_sizes[0] != M * D || out_size != M * D || ws_size < WS_END) { fprintf(stderr, "kernel_launch: unexpected sizes: n_in %d in0 %d out %d ws %zu (need %zu); nothing launched\n", n_in, n_in > 0 ? in_sizes[0] : -1, out_size, ws_size, (size_t)WS_END); grid = -1; return; }
        int dev = 0, cus = 0, per_cu = 0;
        if (hipGetDevice(&dev) != hipSuccess || hipDeviceGetAttribute(&cus, hipDeviceAttributeMultiprocessorCount, dev) != hipSuccess) { grid = -1; return; }
        if (hipFuncSetAttribute((const void*)enc_fwd, hipFuncAttributeMaxDynamicSharedMemorySize, LDS_BYTES) != hipSuccess) { fprintf(stderr, "kernel_launch: hipFuncSetAttribute failed\n"); grid = -1; return; }
        if (hipOccupancyMaxActiveBlocksPerMultiprocessor(&per_cu, (const void*)enc_fwd, NWAVES * 64, LDS_BYTES) != hipSuccess || per_cu < 1) { fprintf(stderr, "kernel_launch: occupancy query reports %d workgroups per CU\n", per_cu); grid = -1; (void)hipGetLastError(); return; }
        (void)hipGetLastError();
        grid = cus;
    }
    if (grid < 0) return;
    if (hipMemsetAsync((char*)d_ws + WS_CTL, 0, CTL_ZERO_BYTES, stream) != hipSuccess) return;
    Args a{};
    for (int i = 0; i < 18; ++i) a.in[i] = (GAS const float*)d_in[i];
    a.out = (GAS float*)d_out; a.ws = (GAS unsigned char*)d_ws;
#if MK_MULTI
    for (int p = 0; p < N_PHASES; ++p) { a.ph_lo = p; a.ph_hi = p + 1; hipLaunchKernelGGL(enc_fwd, dim3(grid), dim3(NWAVES * 64), LDS_BYTES, stream, a); }
#else
    a.ph_lo = 0; a.ph_hi = N_PHASES;
    hipLaunchKernelGGL(enc_fwd, dim3(grid), dim3(NWAVES * 64), LDS_BYTES, stream, a);
#endif
}
```

```cpp
#include <hip/hip_runtime.h>
#include <cstdio>
#include <cstdint>
namespace pg8 {
#define PG8_LAS __attribute__((address_space(3)))
typedef unsigned short bf16_t;
typedef short bf16x8 __attribute__((ext_vector_type(8)));
typedef float f32x4 __attribute__((ext_vector_type(4)));
typedef unsigned u32x4 __attribute__((ext_vector_type(4)));
constexpr int BM = 256, BK = 64, HALF = 128, HTB = HALF * BK * 2  , STAGE_BYTES = 8 * HTB, NXCD = 8, WGM = 8;

__host__ __device__ __forceinline__ int lds_byte(int r, int c) { const int st = (r >> 4) * 2 + (c >> 5), rr = r & 15, cc = c & 31, ob = rr * 64 + cc * 2; return st * 1024 + (ob ^ (((ob >> 9) & 1) << 5)); }
__host__ __device__ __forceinline__ void stage_rc(int b, int& R, int& C) { const int st = b / 1024, sb = b % 1024, swz = sb ^ (((sb >> 9) & 1) << 5); R = (st >> 1) * 16 + swz / 64; C = (st & 1) * 32 + (swz % 64) / 2; }
__host__ __device__ __forceinline__ int perm32(int rho) { const int n = rho >> 4, i = rho & 15; return 8 * (i >> 2) + 4 * n + (i & 3); }

struct Unit { int pm, pn; };
struct Gemm { const bf16_t* A; const bf16_t* Bt; int M, N, K; };

struct StaticOrder {
    int nM, nN, nwg, G, c;
    __host__ __device__ void init(int M, int N, int G_, int c_) { nM = M / BM; nN = N / BM; nwg = nM * nN; G = G_; c = c_; }
    __host__ __device__ bool next(int i, Unit& u) const {
        const long L = (long)i * G + c; if (L >= nwg) return false;
        int wgid = (int)L; { const int q = nwg / NXCD, r = nwg % NXCD, xcd = wgid % NXCD, off = wgid / NXCD; wgid = (xcd < r ? xcd * (q + 1) : r * (q + 1) + (xcd - r) * q) + off; }
        const int nig = WGM * nN, gid = wgid / nig, fm = gid * WGM, gsz = (nM - fm) < WGM ? (nM - fm) : WGM;
        u.pm = fm + ((wgid % nig) % gsz); u.pn = (wgid % nig) / gsz; return true;
    }
    __device__ __forceinline__ void a_ready(const Unit&) const {}
    __device__ __forceinline__ void done(const Unit&) const {}
};

__device__ __forceinline__ unsigned cvt_pk_bf16(float lo, float hi) { unsigned r; asm volatile("v_cvt_pk_bf16_f32 %0, %1, %2" : "=v"(r) : "v"(lo), "v"(hi)); return r; }
typedef float f32x2 __attribute__((ext_vector_type(2)));
__device__ __forceinline__ f32x2 gelu_pk(f32x2 v) {
    const f32x2 av = __builtin_elementwise_abs(v), d = av * 0.2316418882f + 1.0f;
    f32x2 t; t.x = __builtin_amdgcn_rcpf(d.x); t.y = __builtin_amdgcn_rcpf(d.y);
    f32x2 q = t * 0.5307027145f + (-0.7265760135f); q = q * t + 0.7107068705f; q = q * t + (-0.142248368f); q = q * t + 0.127414796f; q = q * t;
    const f32x2 s = (v * v) * (-0.72134752044f);
    f32x2 e; e.x = __builtin_amdgcn_exp2f(s.x); e.y = __builtin_amdgcn_exp2f(s.y);
    const f32x2 m = v * (q * e), r = v - m;
    f32x2 o; o.x = v.x < 0.f ? m.x : r.x; o.y = v.y < 0.f ? m.y : r.y; return o;
}

__device__ __forceinline__ float bf_lo(unsigned w) { return __uint_as_float(w << 16); }
__device__ __forceinline__ float bf_hi(unsigned w) { return __uint_as_float(w & 0xffff0000u); }
__device__ __forceinline__ float sigmoidf_fast(float v) { return __builtin_amdgcn_rcpf(1.0f + __builtin_amdgcn_exp2f(-1.44269504f * v)); }

struct EpiBf16 {
    static constexpr bool PERM = true, AFTER_DRAIN = false;
    bf16_t* O; int ldc;
    __device__ __forceinline__ void operator()(const f32x4 (&acc)[2][2][4][2], const Unit& u, int wr, int wc, int fr, int fq) const {
        asm volatile("" : "+v"(fr), "+v"(fq));
        const int row0 = u.pm * BM + wr * 64 + fr, col0 = u.pn * BM + wc * 32 + 8 * fq;
#pragma unroll
        for (int ai = 0; ai < 2; ++ai)
#pragma unroll
            for (int m = 0; m < 4; ++m) { bf16_t* rowp = O + (size_t)(row0 + ai * HALF + m * 16) * ldc + col0;
#pragma unroll
                for (int bj = 0; bj < 2; ++bj) { const f32x4 v0 = acc[ai][bj][m][0], v1 = acc[ai][bj][m][1];
                    u32x4 w; w.x = cvt_pk_bf16(v0[0], v0[1]); w.y = cvt_pk_bf16(v0[2], v0[3]); w.z = cvt_pk_bf16(v1[0], v1[1]); w.w = cvt_pk_bf16(v1[2], v1[3]);
                    *(u32x4*)(rowp + bj * HALF) = w; } }
    }
};
struct EpiIn {
    static constexpr bool PERM = true, AFTER_DRAIN = false;
    bf16_t* HB; int ldh; float* GA; bf16_t* GATES; const float* bgate;
    __device__ __forceinline__ void operator()(const f32x4 (&acc)[2][2][4][2], const Unit& u, int wr, int wc, int fr, int fq) const {
        asm volatile("" : "+v"(fr), "+v"(fq));
        const int row0 = u.pm * BM + wr * 64 + fr;
        if (u.pn < 56) {
            const int col0 = u.pn * BM + wc * 32 + 8 * fq;
#pragma unroll
            for (int ai = 0; ai < 2; ++ai)
#pragma unroll
                for (int m = 0; m < 4; ++m) { bf16_t* rowp = HB + (size_t)(row0 + ai * HALF + m * 16) * ldh + col0;
#pragma unroll
                    for (int bj = 0; bj < 2; ++bj) { const f32x4 v0 = acc[ai][bj][m][0], v1 = acc[ai][bj][m][1];
                        u32x4 w; w.x = cvt_pk_bf16(v0[0], v0[1]); w.y = cvt_pk_bf16(v0[2], v0[3]); w.z = cvt_pk_bf16(v1[0], v1[1]); w.w = cvt_pk_bf16(v1[2], v1[3]);
                        *(u32x4*)(rowp + bj * HALF) = w; } }
        } else if (u.pn == 56) {
            if (wc == 0) {
#pragma unroll
                for (int ai = 0; ai < 2; ++ai)
#pragma unroll
                    for (int m = 0; m < 4; ++m) { float* rowp = GA + (size_t)(row0 + ai * HALF + m * 16) * 32 + 8 * fq;
                        *(f32x4*)rowp = acc[ai][0][m][0]; *(f32x4*)(rowp + 4) = acc[ai][0][m][1]; }
            }
        } else {
            const int col0 = (u.pn - 57) * BM + wc * 32 + 8 * fq;
#pragma unroll
            for (int ai = 0; ai < 2; ++ai)
#pragma unroll
                for (int m = 0; m < 4; ++m) { bf16_t* rowp = GATES + (size_t)(row0 + ai * HALF + m * 16) * 12288 + col0;
                    asm volatile("" ::: "memory");
#pragma unroll
                    for (int bj = 0; bj < 2; ++bj) { const f32x4 v0 = acc[ai][bj][m][0] + *(const f32x4*)(bgate + col0 + bj * HALF), v1 = acc[ai][bj][m][1] + *(const f32x4*)(bgate + col0 + bj * HALF + 4);
                        u32x4 w; w.x = cvt_pk_bf16(sigmoidf_fast(v0[0]), sigmoidf_fast(v0[1])); w.y = cvt_pk_bf16(sigmoidf_fast(v0[2]), sigmoidf_fast(v0[3]));
                        w.z = cvt_pk_bf16(sigmoidf_fast(v1[0]), sigmoidf_fast(v1[1])); w.w = cvt_pk_bf16(sigmoidf_fast(v1[2]), sigmoidf_fast(v1[3]));
                        *(u32x4*)(rowp + bj * HALF) = w; } }
        }
    }
};
template <int I> struct EpiBranch {
    static constexpr bool PERM = true, AFTER_DRAIN = false;
    bf16_t* MIXED; const bf16_t* GATES;
    __device__ __forceinline__ void operator()(const f32x4 (&acc)[2][2][4][2], const Unit& u, int wr, int wc, int fr, int fq) const {
        asm volatile("" : "+v"(fr), "+v"(fq));
        const int row0 = u.pm * BM + wr * 64 + fr, col0 = u.pn * BM + wc * 32 + 8 * fq;
#pragma unroll
        for (int ai = 0; ai < 2; ++ai)
#pragma unroll
            for (int m = 0; m < 4; ++m) { const size_t r = (size_t)(row0 + ai * HALF + m * 16);
                asm volatile("" ::: "memory");
#pragma unroll
                for (int bj = 0; bj < 2; ++bj) {
                    const u32x4 g = *(const u32x4*)(GATES + r * 12288 + I * 4096 + col0 + bj * HALF);
                    bf16_t* mp = MIXED + r * 4096 + col0 + bj * HALF;
                    u32x4 p = (u32x4){0u, 0u, 0u, 0u}; if (I) p = *(const u32x4*)mp;
                    const f32x4 a0 = acc[ai][bj][m][0], a1 = acc[ai][bj][m][1];
                    u32x4 w;
                    w.x = cvt_pk_bf16(bf_lo(p.x) + bf_lo(g.x) * a0[0], bf_hi(p.x) + bf_hi(g.x) * a0[1]);
                    w.y = cvt_pk_bf16(bf_lo(p.y) + bf_lo(g.y) * a0[2], bf_hi(p.y) + bf_hi(g.y) * a0[3]);
                    w.z = cvt_pk_bf16(bf_lo(p.z) + bf_lo(g.z) * a1[0], bf_hi(p.z) + bf_hi(g.z) * a1[1]);
                    w.w = cvt_pk_bf16(bf_lo(p.w) + bf_lo(g.w) * a1[2], bf_hi(p.w) + bf_hi(g.w) * a1[3]);
                    *(u32x4*)mp = w; } }
    }
};
struct EpiResid {
    static constexpr bool PERM = false, AFTER_DRAIN = false;
    float* V; const float* xres; int ldc; float alpha;
    __device__ __forceinline__ void operator()(const f32x4 (&acc)[2][2][4][2], const Unit& u, int wr, int wc, int fr, int fq) const {
        asm volatile("" : "+v"(fr), "+v"(fq));
        const int row0 = u.pm * BM + wr * 64 + fr, col0 = u.pn * BM + wc * 32 + 4 * fq;
#pragma unroll
        for (int ai = 0; ai < 2; ++ai)
#pragma unroll
            for (int m = 0; m < 4; ++m) { const size_t off = (size_t)(row0 + ai * HALF + m * 16) * ldc + col0;
                asm volatile("" ::: "memory");
#pragma unroll
                for (int bj = 0; bj < 2; ++bj)
#pragma unroll
                    for (int n = 0; n < 2; ++n) { const f32x4 xr = *(const f32x4*)(xres + off + bj * HALF + n * 16);
                        *(f32x4*)(V + off + bj * HALF + n * 16) = xr * alpha + acc[ai][bj][m][n]; } }
    }
};

template <class Epi, class Sched, bool ALIGN_EPI = false, bool SP2 = false>
__device__ __forceinline__ void gemm_phase(PG8_LAS unsigned char* lds, const Gemm g, const Sched& S, const Epi& E, const int wv  ) {
    int tid_ = wv * 64 + (int)__builtin_amdgcn_mbcnt_hi(~0u, __builtin_amdgcn_mbcnt_lo(~0u, 0u)); asm volatile("" : "+v"(tid_));
    const int tid = tid_, wid = __builtin_amdgcn_readfirstlane(tid >> 6), lane = tid & 63, wr = wid >> 2, wc = wid & 3, fr = lane & 15, fq = lane >> 4;
    const int K = g.K, nt = K / BK;
    unsigned voffA[2], voffB[2];
#pragma unroll
    for (int i = 0; i < 2; ++i) { int R, C; stage_rc(tid * 16 + i * 8192, R, C); const int Rb = Epi::PERM ? ((R & ~31) + perm32(R & 31)) : R;
        voffA[i] = (unsigned)(R * K + C) * 2u; voffB[i] = (unsigned)(Rb * K + C) * 2u; }
    const size_t kstep = (size_t)(BK * 2);
    const size_t hstep = (size_t)HALF * K * 2;
    const size_t tstep = 2 * hstep;
    const unsigned ldsw = (unsigned)wid * 1024u;
    const int aoff = lds_byte(wr * 64 + fr, fq * 8), boff = lds_byte(wc * 32 + fr, fq * 8);
#define PG8_SA(b, h) (((b) * 2 + (h)) * HTB)
#define PG8_SB(b, h) ((4 + (b) * 2 + (h)) * HTB)
#define PG8_STAGE(bufoff, gbase, voff) do { _Pragma("unroll") for (int _i = 0; _i < 2; ++_i) \
        __builtin_amdgcn_global_load_lds((const unsigned*)((const char*)(gbase) + (voff)[_i]), (PG8_LAS unsigned*)(lds + (bufoff) + ldsw + _i * 8192), 16, 0, 0); } while (0)
#define PG8_LDA(dst, b, h) do { _Pragma("unroll") for (int m = 0; m < 4; ++m) _Pragma("unroll") for (int k = 0; k < 2; ++k) dst[m][k] = *(const PG8_LAS bf16x8*)(lds + PG8_SA(b, h) + aoff + m * 2048 + k * 1024); } while (0)
#define PG8_LDB(dst, b, h) do { _Pragma("unroll") for (int n = 0; n < 2; ++n) _Pragma("unroll") for (int k = 0; k < 2; ++k) dst[n][k] = *(const PG8_LAS bf16x8*)(lds + PG8_SB(b, h) + boff + n * 2048 + k * 1024); } while (0)
#define PG8_MMA(ai, bj, At, Bt) do { __builtin_amdgcn_s_setprio(1); _Pragma("unroll") for (int m = 0; m < 4; ++m) _Pragma("unroll") for (int n = 0; n < 2; ++n) _Pragma("unroll") for (int k = 0; k < 2; ++k) \
        acc[ai][bj][m][n] = __builtin_amdgcn_mfma_f32_16x16x32_bf16(Bt[n][k], At[m][k], acc[ai][bj][m][n], 0, 0, 0); __builtin_amdgcn_s_setprio(0); } while (0)
#define PG8_WAIT_V(n) asm volatile("s_waitcnt vmcnt(" #n ")" ::: "memory")
#define PG8_WAIT_L(n) asm volatile("s_waitcnt lgkmcnt(" #n ")" ::: "memory")
#define PG8_BAR __builtin_amdgcn_s_barrier()
#define PG8_SCHED __builtin_amdgcn_sched_barrier(0)
    Unit cur, nxt; int ui = 0;
    if (!S.next(0, cur)) return;
    f32x4 acc[2][2][4][2];
#pragma unroll
    for (int a = 0; a < 2; ++a)
#pragma unroll
        for (int b = 0; b < 2; ++b)
#pragma unroll
            for (int m = 0; m < 4; ++m)
#pragma unroll
                for (int n = 0; n < 2; ++n) acc[a][b][m][n] = (f32x4){0.f, 0.f, 0.f, 0.f};
    bf16x8 At[4][2], B0[2][2], B1[2][2];
    const char* cA = (const char*)g.A + (size_t)cur.pm * tstep; const char* cB = (const char*)g.Bt + (size_t)cur.pn * tstep;
    S.a_ready(cur);
    if constexpr (SP2) {
        PG8_STAGE(PG8_SB(0, 0), cB, voffB); PG8_STAGE(PG8_SB(0, 1), cB + hstep, voffB); PG8_STAGE(PG8_SA(0, 0), cA, voffA); PG8_STAGE(PG8_SA(0, 1), cA + hstep, voffA);
        if (wr == 1) PG8_BAR;
        PG8_WAIT_V(2); PG8_BAR;
        PG8_STAGE(PG8_SB(1, 0), cB + kstep, voffB); PG8_STAGE(PG8_SA(1, 0), cA + kstep, voffA); PG8_STAGE(PG8_SB(1, 1), cB + hstep + kstep, voffB);
        PG8_WAIT_V(6); PG8_BAR;
    } else {
        PG8_STAGE(PG8_SB(0, 0), cB, voffB); PG8_STAGE(PG8_SA(0, 0), cA, voffA); PG8_STAGE(PG8_SB(0, 1), cB + hstep, voffB); PG8_STAGE(PG8_SA(0, 1), cA + hstep, voffA);
        if (wr == 1) PG8_BAR;
        PG8_WAIT_V(4); PG8_BAR;
        PG8_STAGE(PG8_SB(1, 0), cB + kstep, voffB); PG8_STAGE(PG8_SA(1, 0), cA + kstep, voffA); PG8_STAGE(PG8_SB(1, 1), cB + hstep + kstep, voffB);
        PG8_WAIT_V(6); PG8_BAR;
    }
    for (;;) {
        const bool has_next = S.next(ui + 1, nxt);
        const char* nA = has_next ? (const char*)g.A + (size_t)nxt.pm * tstep : cA; const char* nB = has_next ? (const char*)g.Bt + (size_t)nxt.pn * tstep : cB;
        for (int t = 0; t < nt; t += 2) {
            const bool last = (t == nt - 2);
            const char* a1 = cA + (size_t)(t + 1) * kstep;
            const char* a2 = last ? nA : cA + (size_t)(t + 2) * kstep; const char* b2 = last ? nB : cB + (size_t)(t + 2) * kstep;
            const char* a3 = a2 + kstep; const char* b3 = b2 + kstep;
            if (last && has_next) S.a_ready(nxt);
            if constexpr (SP2) {
            PG8_LDB(B0, 0, 0); PG8_LDB(B1, 0, 1); PG8_SCHED; PG8_LDA(At, 0, 0); PG8_STAGE(PG8_SA(1, 1), a1 + hstep, voffA);
            PG8_WAIT_V(8); PG8_WAIT_L(0); PG8_BAR; PG8_MMA(0, 0, At, B0); PG8_MMA(0, 1, At, B1); PG8_BAR; PG8_SCHED;
            PG8_LDA(At, 0, 1); PG8_STAGE(PG8_SB(0, 0), b2, voffB); PG8_STAGE(PG8_SB(0, 1), b2 + hstep, voffB); PG8_STAGE(PG8_SA(0, 0), a2, voffA);
            PG8_WAIT_V(8); PG8_WAIT_L(0); PG8_BAR; PG8_MMA(1, 0, At, B0); PG8_MMA(1, 1, At, B1); PG8_BAR; PG8_SCHED;
            PG8_LDB(B0, 1, 0); PG8_LDB(B1, 1, 1); PG8_SCHED; PG8_LDA(At, 1, 0); PG8_STAGE(PG8_SA(0, 1), a2 + hstep, voffA);
            PG8_WAIT_V(8); PG8_WAIT_L(0); PG8_BAR; PG8_MMA(0, 0, At, B0); PG8_MMA(0, 1, At, B1); PG8_BAR; PG8_SCHED;
            PG8_LDA(At, 1, 1); PG8_STAGE(PG8_SB(1, 0), b3, voffB); PG8_STAGE(PG8_SB(1, 1), b3 + hstep, voffB); PG8_STAGE(PG8_SA(1, 0), a3, voffA);
            PG8_WAIT_V(8); PG8_WAIT_L(0); PG8_BAR; PG8_MMA(1, 0, At, B0); PG8_MMA(1, 1, At, B1); PG8_BAR; PG8_SCHED;
            } else {
            PG8_LDB(B0, 0, 0); PG8_SCHED; PG8_LDA(At, 0, 0); PG8_STAGE(PG8_SA(1, 1), a1 + hstep, voffA);
            PG8_WAIT_L(8); PG8_BAR; PG8_WAIT_L(0); PG8_MMA(0, 0, At, B0); PG8_BAR; PG8_SCHED;
            PG8_LDB(B1, 0, 1); PG8_STAGE(PG8_SB(0, 0), b2, voffB);
            PG8_BAR; PG8_WAIT_L(0); PG8_MMA(0, 1, At, B1); PG8_BAR;
            PG8_LDA(At, 0, 1); PG8_STAGE(PG8_SA(0, 0), a2, voffA);
            PG8_BAR; PG8_WAIT_L(0); PG8_MMA(1, 0, At, B0); PG8_BAR; PG8_SCHED;
            PG8_STAGE(PG8_SB(0, 1), b2 + hstep, voffB);
            PG8_WAIT_V(6); PG8_BAR; PG8_MMA(1, 1, At, B1); PG8_BAR;
            PG8_LDB(B0, 1, 0); PG8_SCHED; PG8_LDA(At, 1, 0); PG8_STAGE(PG8_SA(0, 1), a2 + hstep, voffA);
            PG8_WAIT_L(8); PG8_BAR; PG8_WAIT_L(0); PG8_MMA(0, 0, At, B0); PG8_BAR; PG8_SCHED;
            PG8_LDB(B1, 1, 1); PG8_STAGE(PG8_SB(1, 0), b3, voffB);
            PG8_BAR; PG8_WAIT_L(0); PG8_MMA(0, 1, At, B1); PG8_BAR;
            PG8_LDA(At, 1, 1); PG8_STAGE(PG8_SA(1, 0), a3, voffA);
            PG8_BAR; PG8_WAIT_L(0); PG8_MMA(1, 0, At, B0); PG8_BAR; PG8_SCHED;
            PG8_STAGE(PG8_SB(1, 1), b3 + hstep, voffB);
            PG8_WAIT_V(6); PG8_BAR; PG8_MMA(1, 1, At, B1); PG8_BAR;
            }
        }
        if constexpr (ALIGN_EPI) { if (wr == 0) PG8_BAR; }
        if constexpr (!Epi::AFTER_DRAIN) { E(acc, cur, wr, wc, fr, fq); S.done(cur); }
        if (!has_next) break;
#pragma unroll
        for (int a = 0; a < 2; ++a)
#pragma unroll
            for (int b = 0; b < 2; ++b)
#pragma unroll
                for (int m = 0; m < 4; ++m)
#pragma unroll
                    for (int n = 0; n < 2; ++n) acc[a][b][m][n] = (f32x4){0.f, 0.f, 0.f, 0.f};
        cur = nxt; cA = nA; cB = nB; ++ui;
        if constexpr (ALIGN_EPI) { if (wr == 1) PG8_BAR; }
    }
    PG8_WAIT_V(0);
    if constexpr (!ALIGN_EPI) { if (wr == 0) PG8_BAR; }
    PG8_BAR;
    if constexpr (Epi::AFTER_DRAIN) { E.fused(acc, cur, wr, wc, fr, fq, lds, wid, lane); S.done(cur); }
#undef PG8_SA
#undef PG8_SB
#undef PG8_STAGE
#undef PG8_LDA
#undef PG8_LDB
#undef PG8_MMA
#undef PG8_WAIT_V
#undef PG8_WAIT_L
#undef PG8_BAR
#undef PG8_SCHED
}
}

constexpr int NWAVES = 8;
constexpr int NB = 4, SEQ = 4096, M = NB * SEQ, D = 4096, BW = 2048, FF = 11008, DEPTH = 2;
constexpr int IN_WIDTH = 30752;
constexpr int NIN_MAIN = 26880, NIN_PAD = 30976;
constexpr int LDH = 14336;
constexpr int H_CB = 0, H_CC = 2048, H_CH = 4096, H_NQ = 6144, H_NK = 8192, H_GQ = 10240, H_GK = 11264, H_GR = 12288;
constexpr float LN_EPS = 1e-5f, RMS_EPS = 1e-6f, ALPHA = 1.41421356237f;
#ifndef MK_MULTI
#define MK_MULTI 0
#endif
constexpr int N_PHASES = 1 + 11 * DEPTH;

constexpr size_t MiB = 1u << 20;
constexpr size_t alm(size_t x) { return (x + MiB - 1) / MiB * MiB; }
constexpr size_t WS_CTL = 0, CTL_ZERO_BYTES = 1 * MiB;
constexpr size_t SZ_WIN = alm((size_t)NIN_PAD * D * 2), SZ_WBR = alm((size_t)3 * D * BW * 2), SZ_WO = alm((size_t)D * D * 2), SZ_WFI = alm((size_t)2 * FF * D * 2), SZ_WFO = alm((size_t)D * FF * 2);
constexpr size_t OFF_WIN = 0, OFF_WBR = OFF_WIN + SZ_WIN, OFF_WO = OFF_WBR + SZ_WBR, OFF_WFI = OFF_WO + SZ_WO, OFF_WFO = OFF_WFI + SZ_WFI, SZ_WL = OFF_WFO + SZ_WFO;
constexpr size_t WS_W = 1 * MiB;
constexpr size_t WS_XB = WS_W + DEPTH * SZ_WL;
constexpr size_t WS_XR = WS_XB + alm((size_t)M * D * 2);
constexpr size_t WS_U = WS_XR + alm((size_t)M * D * 4);
constexpr size_t WS_HB = WS_U;
constexpr size_t WS_GA = WS_HB + alm((size_t)M * LDH * 2);
constexpr size_t WS_GATES = WS_GA + alm((size_t)M * 32 * 4);
constexpr size_t WS_VT = WS_GATES + alm((size_t)M * 12288 * 2);
constexpr size_t WS_YC = WS_VT + alm((size_t)4096 * M * 2);
constexpr size_t WS_YN = WS_YC + alm((size_t)M * BW * 2);
constexpr size_t WS_YG = WS_YN + alm((size_t)M * BW * 2);
constexpr size_t WS_QIN = WS_YG + alm((size_t)M * BW * 2);
constexpr size_t WS_KOT = WS_QIN + alm((size_t)2 * M * 1024 * 2);
constexpr size_t WS_ATT = WS_KOT + alm((size_t)2 * 1024 * M * 2);
constexpr size_t WS_DEC = WS_ATT + alm((size_t)2 * 4 * 4 * 64 * 64 * 64 * 2);
constexpr size_t WS_O = WS_DEC + alm((size_t)2 * 4 * 64 * 1024 * 4);
constexpr size_t WS_MIXED = WS_O + alm((size_t)2 * M * 2048 * 4);
constexpr size_t WS_END = WS_MIXED + alm((size_t)M * D * 2);
constexpr size_t WS_AU = WS_U;
constexpr size_t WS_G = WS_AU + alm((size_t)M * 2 * FF * 2);
static_assert(WS_G + alm((size_t)M * FF * 2) <= WS_MIXED, "the FFN overlay must stay below MIXED");
static_assert(WS_END <= (size_t)3844 * MiB, "d_ws budget: 4 x the largest input tensor");
constexpr int CW_BAR = 4096;

constexpr int RING_BYTES = 131072;
constexpr int LDS_BYTES = 159744;
constexpr int MISC_OFF = LDS_BYTES - 512;

#define GAS __attribute__((address_space(1)))
#define LAS __attribute__((address_space(3)))
typedef unsigned short bf16;
typedef unsigned v4u __attribute__((ext_vector_type(4)));
typedef unsigned v2u __attribute__((ext_vector_type(2)));
typedef float f32x4 __attribute__((ext_vector_type(4)));
typedef short bf16x8 __attribute__((ext_vector_type(8)));
typedef GAS unsigned gu32;
#define LDS_WAIT() asm volatile("s_waitcnt lgkmcnt(0)" ::: "memory")
#define VM_WAIT() asm volatile("s_waitcnt vmcnt(0)" ::: "memory")
__device__ __forceinline__ unsigned pk2(float lo, float hi) { return pg8::cvt_pk_bf16(lo, hi); }
__device__ __forceinline__ float bflo(unsigned w) { return __uint_as_float(w << 16); }
__device__ __forceinline__ float bfhi(unsigned w) { return __uint_as_float(w & 0xffff0000u); }
__device__ __forceinline__ float bf1(bf16 b) { return __uint_as_float(((unsigned)b) << 16); }
__device__ __forceinline__ void unpack8(const v4u w, float (&f)[8]) { f[0] = bflo(w.x); f[1] = bfhi(w.x); f[2] = bflo(w.y); f[3] = bfhi(w.y); f[4] = bflo(w.z); f[5] = bfhi(w.z); f[6] = bflo(w.w); f[7] = bfhi(w.w); }
__device__ __forceinline__ v4u pack8(const float (&f)[8]) { v4u w; w.x = pk2(f[0], f[1]); w.y = pk2(f[2], f[3]); w.z = pk2(f[4], f[5]); w.w = pk2(f[6], f[7]); return w; }
__device__ __forceinline__ float wave_sum(float v) {
#pragma unroll
    for (int o = 1; o < 64; o <<= 1) v += __shfl_xor(v, o);
    return v;
}
__device__ __forceinline__ f32x4 mfma16(bf16x8 a, bf16x8 b, f32x4 c) { return __builtin_amdgcn_mfma_f32_16x16x32_bf16(a, b, c, 0, 0, 0); }

#define XB_TMO      128
#define XB_XCNT(j)  (256  + 64 * (j))
#define XB_XSUB(j)  (1280 + 64 * (j))
#define XB_XGEN(j)  (2304 + 64 * (j))
#define XB_TOP      3328
#define XB_TOPGEN   3392
#define XCD_BAR_WORDS 3456
#define XB_SPIN_CAP (1u << 18)

__device__ __forceinline__ unsigned xb_ld(unsigned* p)              { return __hip_atomic_load(p, __ATOMIC_RELAXED, __HIP_MEMORY_SCOPE_AGENT); }
__device__ __forceinline__ unsigned xb_add(unsigned* p, unsigned v) { return __hip_atomic_fetch_add(p, v, __ATOMIC_RELAXED, __HIP_MEMORY_SCOPE_AGENT); }
__device__ __forceinline__ unsigned xb_xcc_id() { return (unsigned)__builtin_amdgcn_s_getreg((3 << 11) | 20) & 0xFu; }
#define XB_SPIN(cond, bar) do { unsigned _sp = 0; while (cond) { __builtin_amdgcn_s_sleep(1); \
    if ((++_sp & 255u) == 0u) { if (xb_ld(&(bar)[XB_TMO])) break; if (_sp > XB_SPIN_CAP) { atomicAdd(&(bar)[XB_TMO], 1u); break; } } } } while (0)

__device__ __forceinline__ unsigned xb_lane_id() { return __builtin_amdgcn_mbcnt_hi(~0u, __builtin_amdgcn_mbcnt_lo(~0u, 0u)); }
struct XcdBarrier {
    unsigned wv;
    unsigned* bar; unsigned x;
    volatile LAS unsigned* st;
};

__device__ __forceinline__ XcdBarrier xcd_barrier_post(unsigned* bar, volatile LAS unsigned* st) {
    XcdBarrier b; b.wv = 0u; b.bar = bar; b.x = xb_xcc_id(); b.st = st;
    if (threadIdx.x == 0) (void)xb_add(&bar[XB_XCNT(b.x)], 1u);
    return b;
}
__device__ __forceinline__ void xcd_barrier_complete(unsigned* bar, unsigned x, unsigned& nloc, unsigned& nx) {
    const unsigned G = gridDim.x * gridDim.y * gridDim.z;
    unsigned sum, cnt, mine, sp = 0u;
    for (;;) {
        sum = 0u; cnt = 0u; mine = 0u;
#pragma unroll
        for (unsigned j = 0; j < 16; ++j) { const unsigned c = xb_ld(&bar[XB_XCNT(j)]); sum += c; cnt += (c > 0u) ? 1u : 0u; mine = (j == x) ? c : mine; }
        if (sum == G) break;
        __builtin_amdgcn_s_sleep(1);
        if ((++sp & 255u) == 0u) { if (xb_ld(&bar[XB_TMO])) break; if (sp > XB_SPIN_CAP) { atomicAdd(&bar[XB_TMO], 1u); break; } }
    }
    nloc = mine > 0u ? mine : 1u; nx = cnt > 0u ? cnt : 1u;
}

__device__ __forceinline__ void xcd_barrier(const XcdBarrier& b) {
    asm volatile("s_waitcnt vmcnt(0)" ::: "memory");
    __syncthreads();
    if (b.wv == 0u && xb_lane_id() == 0u) {
        unsigned* bar = b.bar;
        __builtin_amdgcn_s_waitcnt(0);
        unsigned nloc = b.st[0], nx = b.st[1];
        if (nloc == 0u) { xcd_barrier_complete(bar, b.x, nloc, nx); b.st[0] = nloc; b.st[1] = nx; }
        const unsigned old = xb_add(&bar[XB_XSUB(b.x)], 1u);
        const unsigned gen = old / nloc;
        if (old + 1u == (gen + 1u) * nloc) {
            __builtin_amdgcn_fence(__ATOMIC_RELEASE, "agent");
            asm volatile("s_waitcnt vmcnt(0)" ::: "memory");
            const unsigned og = xb_add(&bar[XB_TOP], 1u);
            const unsigned tg = og / nx;
            if (og + 1u == (tg + 1u) * nx) xb_add(&bar[XB_TOPGEN], 1u);
            else XB_SPIN(xb_ld(&bar[XB_TOPGEN]) == tg, bar);
            __builtin_amdgcn_fence(__ATOMIC_ACQUIRE, "agent");
            xb_add(&bar[XB_XGEN(b.x)], 1u);
            asm volatile("s_waitcnt vmcnt(0)" ::: "memory");
        } else {
            XB_SPIN(xb_ld(&bar[XB_XGEN(b.x)]) == gen, bar);
            __builtin_amdgcn_fence(__ATOMIC_ACQUIRE, "agent");
            asm volatile("s_waitcnt vmcnt(0)" ::: "memory");
        }
    }
    __syncthreads();
}

struct Args { GAS const float* in[18]; GAS float* out; GAS unsigned char* ws; int ph_lo, ph_hi; };
typedef __attribute__((address_space(4))) const Args CArgs;
__device__ __forceinline__ CArgs* kargs() { CArgs* p = (CArgs*)__builtin_amdgcn_kernarg_segment_ptr(); asm volatile("" : "+s"(p)); return p; }
#define INP(i) ((const float*)kargs()->in[i])
#define OUTP ((float*)kargs()->out)
struct Frame { LAS unsigned char* lds; int wv; };
struct Ids { int tid, lane, wave, G, gw, NGW; };
__device__ __forceinline__ Ids phase_ids(const int wv) { Ids I; int t = wv * 64 + (int)__builtin_amdgcn_mbcnt_hi(~0u, __builtin_amdgcn_mbcnt_lo(~0u, 0u)); asm volatile("" : "+v"(t)); I.tid = t; I.lane = t & 63; I.wave = __builtin_amdgcn_readfirstlane(t >> 6);
    int g = gridDim.x; asm volatile("" : "+s"(g)); I.G = g; I.gw = blockIdx.x * NWAVES + I.wave; I.NGW = g * NWAVES; return I; }
#define WSP(T, off) ((T*)(GAS T*)(kargs()->ws + (off)))


__device__ __forceinline__ int win_src(int r) {
    if (r < 10240) return r;
    if (r < 12288) return 12288 + (r - 10240);
    if (r < 14336) return 16384 + (r - 12288);
    if (r < 14592) return r == 14336 ? 18432 : -1;
    if (r < 26880) return 18464 + (r - 14592);
    if (r < 28928) return 10240 + (r - 26880);
    return 14336 + (r - 28928);
}
__device__ __forceinline__ void tr_item(const float* W, size_t ldw, int K, int k0, int srcA, int srcB, bf16* WT, int n0, LAS float* scr, int lane) {
    const int src = lane < 32 ? srcA : srcB; const int cl = lane & 31;
    if (src >= 0) { const float* p = W + (size_t)k0 * ldw + src + cl;
#pragma unroll 16
        for (int kk = 0; kk < 64; ++kk) scr[kk * 65 + lane] = p[(size_t)kk * ldw];
    } else {
#pragma unroll 16
        for (int kk = 0; kk < 64; ++kk) scr[kk * 65 + lane] = 0.f;
    }
    LDS_WAIT(); asm volatile("" ::: "memory");
    const int c = lane & 7;
#pragma unroll
    for (int j = 0; j < 8; ++j) { const int n = (lane >> 3) + 8 * j; const LAS float* s = scr + (8 * c) * 65 + n;
        v4u o; o.x = pk2(s[0 * 65], s[1 * 65]); o.y = pk2(s[2 * 65], s[3 * 65]); o.z = pk2(s[4 * 65], s[5 * 65]); o.w = pk2(s[6 * 65], s[7 * 65]);
        *(v4u*)(WT + (size_t)(n0 + n) * K + k0 + 8 * c) = o; }
    LDS_WAIT(); asm volatile("" ::: "memory");
}
__device__ __forceinline__ void tr_matrix(const Ids& I, const float* W, int K, int N, bf16* WT, LAS float* scr) {
    const int nnb = N / 64, items = (K / 64) * nnb;
    for (int it = I.gw; it < items; it += I.NGW) { const int kb = it / nnb, nb = it % nnb; tr_item(W, (size_t)N, K, kb * 64, nb * 64, nb * 64 + 32, WT, nb * 64, scr, I.lane); }
}
__device__ __forceinline__ void p0_prologue(Frame& F) {
    const Ids I = phase_ids(F.wv);
    LAS float* scr = (LAS float*)(F.lds + I.wave * 16640);
    for (int l = 0; l < DEPTH; ++l) {
        unsigned char* wl = (unsigned char*)(kargs()->ws + WS_W + (size_t)l * SZ_WL);
        { const float* W = INP(1) + (size_t)l * D * IN_WIDTH; bf16* WT = (bf16*)(wl + OFF_WIN);
            const int nnb = NIN_PAD / 64, items = (D / 64) * nnb;
            for (int it = I.gw; it < items; it += I.NGW) { const int kb = it / nnb, nb = it % nnb; tr_item(W, (size_t)IN_WIDTH, D, kb * 64, win_src(nb * 64), win_src(nb * 64 + 32), WT, nb * 64, scr, I.lane); } }
        for (int i = 0; i < 3; ++i) tr_matrix(I, INP(8) + ((size_t)l * 3 + i) * BW * D, BW, D, (bf16*)(wl + OFF_WBR) + (size_t)i * D * BW, scr);
        tr_matrix(I, INP(9) + (size_t)l * D * D, D, D, (bf16*)(wl + OFF_WO), scr);
        tr_matrix(I, INP(12) + (size_t)l * D * 2 * FF, D, 2 * FF, (bf16*)(wl + OFF_WFI), scr);
        tr_matrix(I, INP(15) + (size_t)l * FF * D, FF, D, (bf16*)(wl + OFF_WFO), scr);
    }
    { const f32x4* x4 = (const f32x4*)INP(0); v4u* o = WSP(v4u, WS_XB); const size_t n8 = (size_t)M * D / 8, stride = (size_t)I.G * 512;
      for (size_t i = (size_t)blockIdx.x * 512 + I.tid; i < n8; i += stride) { const f32x4 a = x4[2 * i], b = x4[2 * i + 1]; v4u w; w.x = pk2(a[0], a[1]); w.y = pk2(a[2], a[3]); w.z = pk2(b[0], b[1]); w.w = pk2(b[2], b[3]); o[i] = w; } }
}

__device__ __forceinline__ void conv_mixer_phase(Frame& F, int layer) {
    const Ids I = phase_ids(F.wv);
    const bf16* HB = WSP(const bf16, WS_HB); bf16* YC = WSP(bf16, WS_YC); const float* wc = INP(3) + (size_t)layer * 3 * BW;
    const int c8 = (I.tid & 255) * 8, half = I.tid >> 8;
    float w[3][8];
#pragma unroll
    for (int i = 0; i < 3; ++i) { const f32x4 a = *(const f32x4*)(wc + i * BW + c8), b = *(const f32x4*)(wc + i * BW + c8 + 4);
        w[i][0] = a[0]; w[i][1] = a[1]; w[i][2] = a[2]; w[i][3] = a[3]; w[i][4] = b[0]; w[i][5] = b[1]; w[i][6] = b[2]; w[i][7] = b[3]; }
    for (int it = blockIdx.x; it < M / 2; it += I.G) {
        const int m = 2 * it + half, s = m & (SEQ - 1);
        const bf16* row = HB + (size_t)m * LDH + c8;
        float acc[8], cb[8], x[8], y[8];
        unpack8(*(const v4u*)(row + H_CC), x); unpack8(*(const v4u*)(row + H_CH), y);
#pragma unroll
        for (int e = 0; e < 8; ++e) acc[e] = w[1][e] * (x[e] * y[e]);
        if (s > 0) { unpack8(*(const v4u*)(row - LDH + H_CC), x); unpack8(*(const v4u*)(row - LDH + H_CH), y);
#pragma unroll
            for (int e = 0; e < 8; ++e) acc[e] += w[0][e] * (x[e] * y[e]); }
        if (s < SEQ - 1) { unpack8(*(const v4u*)(row + LDH + H_CC), x); unpack8(*(const v4u*)(row + LDH + H_CH), y);
#pragma unroll
            for (int e = 0; e < 8; ++e) acc[e] += w[2][e] * (x[e] * y[e]); }
        unpack8(*(const v4u*)(row + H_CB), cb);
#pragma unroll
        for (int e = 0; e < 8; ++e) acc[e] *= cb[e];
        *(v4u*)(YC + (size_t)m * BW + c8) = pack8(acc);
    }
}
__device__ __forceinline__ void ln_phase(Frame& F, const float* V, const float* g, const float* b, float* XF, bf16* XBo) {
    const Ids I = phase_ids(F.wv);
    for (int m = I.gw; m < M; m += I.NGW) {
        const f32x4* vr = (const f32x4*)(V + (size_t)m * D) + I.lane;
        f32x4 v[16]; float s = 0.f;
#pragma unroll
        for (int j = 0; j < 16; ++j) { v[j] = vr[64 * j]; s += (v[j][0] + v[j][1]) + (v[j][2] + v[j][3]); }
        const float mean = wave_sum(s) * (1.f / D); float s2 = 0.f;
#pragma unroll
        for (int j = 0; j < 16; ++j) { v[j] = v[j] - mean; s2 += (v[j][0] * v[j][0] + v[j][1] * v[j][1]) + (v[j][2] * v[j][2] + v[j][3] * v[j][3]); }
        const float rstd = 1.f / sqrtf(wave_sum(s2) * (1.f / D) + LN_EPS);
        f32x4* xo = (f32x4*)(XF + (size_t)m * D) + I.lane; v2u* bo = (v2u*)(XBo + (size_t)m * D) + I.lane;
#pragma unroll
        for (int j = 0; j < 16; ++j) { const f32x4 gg = ((const f32x4*)g)[I.lane + 64 * j], bb = ((const f32x4*)b)[I.lane + 64 * j];
            const f32x4 o = v[j] * rstd * gg + bb; xo[64 * j] = o; v2u w; w.x = pk2(o[0], o[1]); w.y = pk2(o[2], o[3]); bo[64 * j] = w; }
    }
}
__device__ __forceinline__ void convglu_phase(Frame& F, int layer) {
    const Ids I = phase_ids(F.wv);
    const bf16* AU = WSP(const bf16, WS_AU); bf16* G = WSP(bf16, WS_G);
    const float* wc = INP(13) + (size_t)layer * 3 * FF; const float* bc = INP(14) + (size_t)layer * FF;
    constexpr int J = FF / 8; const size_t total = (size_t)M * J, stride = (size_t)I.G * 512;
    for (size_t idx = (size_t)blockIdx.x * 512 + I.tid; idx < total; idx += stride) {
        const int m = (int)(idx / J), c8 = (int)(idx % J) * 8, s = m & (SEQ - 1);
        const bf16* row = AU + (size_t)m * (2 * FF) + c8;
        float a[8], acc[8], wv[8];
        { const f32x4 x = *(const f32x4*)(bc + c8), y = *(const f32x4*)(bc + c8 + 4); acc[0] = x[0]; acc[1] = x[1]; acc[2] = x[2]; acc[3] = x[3]; acc[4] = y[0]; acc[5] = y[1]; acc[6] = y[2]; acc[7] = y[3]; }
#define CG_TAP(i, ptr) { unpack8(*(const v4u*)(ptr), a); const f32x4 x = *(const f32x4*)(wc + (i) * FF + c8), y = *(const f32x4*)(wc + (i) * FF + c8 + 4); \
            wv[0] = x[0]; wv[1] = x[1]; wv[2] = x[2]; wv[3] = x[3]; wv[4] = y[0]; wv[5] = y[1]; wv[6] = y[2]; wv[7] = y[3]; _Pragma("unroll") for (int e = 0; e < 8; ++e) acc[e] += wv[e] * a[e]; }
        CG_TAP(1, row)
        if (s > 0) CG_TAP(0, row - 2 * FF)
        if (s < SEQ - 1) CG_TAP(2, row + 2 * FF)
#undef CG_TAP
        float u[8]; unpack8(*(const v4u*)(row + FF), u);
#pragma unroll
        for (int e = 0; e < 8; e += 2) { const pg8::f32x2 gl = pg8::gelu_pk((pg8::f32x2){acc[e], acc[e + 1]}); acc[e] = gl.x * u[e]; acc[e + 1] = gl.y * u[e + 1]; }
        *(v4u*)(G + (size_t)m * FF + c8) = pack8(acc);
    }
}
__device__ __forceinline__ void gla_combine_phase(Frame& F, int layer) {
    const Ids I = phase_ids(F.wv);
    const float* O0 = WSP(const float, WS_O); const float* O1 = O0 + (size_t)M * 2048; const bf16* HB = WSP(const bf16, WS_HB); bf16* YG = WSP(bf16, WS_YG);
    const float* ng = INP(7) + (size_t)layer * 2048;
    for (int idx = I.gw; idx < M * 4; idx += I.NGW) {
        const int m = idx >> 2, h = idx & 3; const size_t off = (size_t)m * 2048 + h * 512 + 8 * I.lane;
        const f32x4 a0 = *(const f32x4*)(O0 + off), a1 = *(const f32x4*)(O0 + off + 4), b0 = *(const f32x4*)(O1 + off), b1 = *(const f32x4*)(O1 + off + 4);
        float o[8] = {a0[0] + b0[0], a0[1] + b0[1], a0[2] + b0[2], a0[3] + b0[3], a1[0] + b1[0], a1[1] + b1[1], a1[2] + b1[2], a1[3] + b1[3]};
        float ss = 0.f;
#pragma unroll
        for (int e = 0; e < 8; ++e) ss += o[e] * o[e];
        const float rs = 1.f / sqrtf(wave_sum(ss) * (1.f / 512.f) + RMS_EPS);
        float r[8]; unpack8(*(const v4u*)(HB + (size_t)m * LDH + H_GR + h * 512 + 8 * I.lane), r);
        const f32x4 g0 = *(const f32x4*)(ng + h * 512 + 8 * I.lane), g1 = *(const f32x4*)(ng + h * 512 + 8 * I.lane + 4);
        const float gg[8] = {g0[0], g0[1], g0[2], g0[3], g1[0], g1[1], g1[2], g1[3]};
#pragma unroll
        for (int e = 0; e < 8; ++e) o[e] = o[e] * rs * gg[e] * (r[e] / (1.f + __expf(-r[e])));
        *(v4u*)(YG + off) = pack8(o);
    }
}

__device__ __forceinline__ void na_phase(Frame& F, int layer) {
    const Ids I = phase_ids(F.wv);
    const bf16* HB = WSP(const bf16, WS_HB); const bf16* VT = WSP(const bf16, WS_VT); bf16* YN = WSP(bf16, WS_YN);
    const float* rpb = INP(4) + (size_t)layer * 16 * 465;
    LAS float* rpbs = (LAS float*)F.lds;
    const int fr = I.lane & 15, q4 = I.lane >> 4;
    for (int it = blockIdx.x; it < 2048; it += I.G) {
        const int rblk = it & 7, cblk = (it >> 3) & 3, h = (it >> 5) & 15, b = it >> 9;
        __syncthreads();
        for (int i = I.tid; i < 465; i += 512) rpbs[i] = rpb[h * 465 + i];
        __syncthreads();
        const int r = rblk * 8 + I.wave, c0 = cblk * 16;
        const int rs = min(max(r - 4, 0), 56), cs = min(max(c0 - 8, 0), 32);
        const int mq = b * SEQ + r * 64 + c0 + fr;
        const bf16* qp = HB + (size_t)mq * LDH + H_NQ + h * 128 + 8 * q4;
        bf16x8 qf[4];
#pragma unroll
        for (int s = 0; s < 4; ++s) qf[s] = *(const bf16x8*)(qp + 32 * s);
        const int cq = c0 + fr, ws = min(max(cq - 8, 0), 48);
        f32x4 sc[8][2];
        float mx = -1e30f;
#pragma unroll
        for (int sp = 0; sp < 8; ++sp)
#pragma unroll
            for (int u = 0; u < 2; ++u) {
                const int coloff = 8 * (fr >> 2) + 4 * u + (fr & 3);
                const int mk = b * SEQ + (rs + sp) * 64 + cs + coloff;
                const bf16* kp = HB + (size_t)mk * LDH + H_NK + h * 128 + 8 * q4;
                f32x4 d = (f32x4){0.f, 0.f, 0.f, 0.f};
#pragma unroll
                for (int s = 0; s < 4; ++s) d = mfma16(*(const bf16x8*)(kp + 32 * s), qf[s], d);
                const int brow = (rs + sp - r + 7) * 31;
#pragma unroll
                for (int j = 0; j < 4; ++j) { const int kc = cs + 8 * q4 + 4 * u + j; const bool valid = (kc >= ws) && (kc < ws + 16);
                    const int bi = min(max(kc - cq + 15, 0), 30);
                    const float v = valid ? d[j] * 0.08838834764831845f + rpbs[brow + bi] : -1e30f;
                    sc[sp][u][j] = v; mx = fmaxf(mx, v); }
            }
        mx = fmaxf(mx, __shfl_xor(mx, 16)); mx = fmaxf(mx, __shfl_xor(mx, 32));
        float sum = 0.f;
        bf16x8 pf[8];
#pragma unroll
        for (int sp = 0; sp < 8; ++sp) { float p[8];
#pragma unroll
            for (int u = 0; u < 2; ++u)
#pragma unroll
                for (int j = 0; j < 4; ++j) { const float e = __builtin_amdgcn_exp2f((sc[sp][u][j] - mx) * 1.44269504f); p[4 * u + j] = e; sum += e; }
            const v4u w = pack8(p); pf[sp] = __builtin_bit_cast(bf16x8, w); }
        sum += __shfl_xor(sum, 16); sum += __shfl_xor(sum, 32);
        const float inv = 1.f / sum;
        const bf16* vp = VT + (size_t)(h * 128 + fr) * M + b * SEQ + rs * 64 + cs + 8 * q4;
#pragma unroll
        for (int dt = 0; dt < 8; ++dt) { f32x4 o = (f32x4){0.f, 0.f, 0.f, 0.f};
#pragma unroll
            for (int sp = 0; sp < 8; ++sp) o = mfma16(*(const bf16x8*)(vp + (size_t)(16 * dt) * M + sp * 64), pf[sp], o);
            v2u w; w.x = pk2(o[0] * inv, o[1] * inv); w.y = pk2(o[2] * inv, o[3] * inv);
            *(v2u*)(YN + (size_t)mq * BW + h * 128 + 16 * dt + 4 * q4) = w; }
    }
}

__device__ __forceinline__ float logsigmoid16(float z) { const float e = __builtin_amdgcn_exp2f(-1.44269504f * fabsf(z)); return (fminf(z, 0.f) - 0.69314718f * __builtin_amdgcn_logf(1.0f + e)) * 0.0625f; }
__device__ __forceinline__ void gla_prep_phase(Frame& F, int layer) {
    const Ids I = phase_ids(F.wv);
    constexpr int RS = 264;
    LAS bf16* qs = (LAS bf16*)F.lds; LAS bf16* ks = qs + 2 * 64 * RS; LAS float* gas = (LAS float*)(ks + 2 * 64 * RS);
    const bf16* HB = WSP(const bf16, WS_HB); const float* GA = WSP(const float, WS_GA);
    bf16* QIN = WSP(bf16, WS_QIN); bf16* KOT = WSP(bf16, WS_KOT); bf16* ATT = WSP(bf16, WS_ATT); float* DEC = WSP(float, WS_DEC);
    const float* wdec = INP(5) + (size_t)layer * 2 * 16 * 1024; const float* bdec = INP(6) + (size_t)layer * 2 * 1024;
    const int dir = I.tid >> 8, c = I.tid & 255, fr = I.lane & 15, q4 = I.lane >> 4;
    for (int it = blockIdx.x; it < 1024; it += I.G) {
        const int h = it & 3, chunk = (it >> 2) & 63, b = it >> 8, m0 = b * SEQ + chunk * 64, ch = h * 256 + c;
        __syncthreads();
        ((LAS f32x4*)gas)[I.tid] = ((const f32x4*)(GA + (size_t)m0 * 32))[I.tid];
        float w[16];
#pragma unroll
        for (int r = 0; r < 16; ++r) w[r] = wdec[(dir * 16 + r) * 1024 + ch];
        const float bd = bdec[dir * 1024 + ch];
        __syncthreads();
        const LAS float* ga = gas + dir * 16;
        float pre[64]; float run = 0.f;
#pragma unroll
        for (int t = 0; t < 64; ++t) { float z = bd;
#pragma unroll
            for (int r = 0; r < 16; ++r) z += ga[t * 32 + r] * w[r];
            run += logsigmoid16(z); pre[t] = run; }
        const float tot = run, dec = __builtin_amdgcn_exp2f(tot * 1.44269504f);
        unsigned ko[32];
        const bf16* qg = HB + (size_t)m0 * LDH + H_GQ + ch; const bf16* kg = HB + (size_t)m0 * LDH + H_GK + ch;
        bf16* qo = QIN + ((size_t)dir * M + m0) * 1024 + ch;
#pragma unroll
        for (int tt = 0; tt < 32; ++tt) { float kov[2];
#pragma unroll
            for (int e = 0; e < 2; ++e) { const int t = 2 * tt + e;
                const float cum = dir == 0 ? pre[t] : tot - (t > 0 ? pre[t > 0 ? t - 1 : 0] : 0.f);
                const float e1 = __builtin_amdgcn_exp2f(cum * 1.44269504f), einv = __builtin_amdgcn_rcpf(e1);
                const float qv = bf1(qg[(size_t)t * LDH]), kv = bf1(kg[(size_t)t * LDH]);
                const float q_in = qv * 0.0625f * e1, k_in = kv * einv; kov[e] = k_in * dec;
                const unsigned qb = pk2(q_in, 0.f) & 0xffffu, kb = pk2(k_in, 0.f) & 0xffffu;
                qs[(dir * 64 + t) * RS + c] = (bf16)qb; ks[(dir * 64 + t) * RS + c] = (bf16)kb; qo[(size_t)t * 1024] = (bf16)qb; }
            ko[tt] = pk2(kov[0], kov[1]); }
        { v4u* kd = (v4u*)(KOT + ((size_t)dir * 1024 + ch) * M + m0);
#pragma unroll
            for (int i = 0; i < 8; ++i) { v4u w4; w4.x = ko[4 * i]; w4.y = ko[4 * i + 1]; w4.z = ko[4 * i + 2]; w4.w = ko[4 * i + 3]; kd[i] = w4; } }
        DEC[(((size_t)dir * 4 + b) * 64 + chunk) * 1024 + ch] = dec;
        __syncthreads();
        { const int adir = I.wave >> 2, mt = I.wave & 3, i = 16 * mt + fr;
          const LAS bf16* qrow = qs + (adir * 64 + i) * RS + 8 * q4;
          bf16* arow = ATT + (((((size_t)adir * 4 + b) * 4 + h) * 64 + chunk) * 64 + i) * 64;
#pragma unroll
          for (int nt = 0; nt < 4; ++nt) { const LAS bf16* krow = ks + (adir * 64 + 16 * nt + fr) * RS + 8 * q4;
              f32x4 d = (f32x4){0.f, 0.f, 0.f, 0.f};
#pragma unroll
              for (int s = 0; s < 8; ++s) d = mfma16(*(const LAS bf16x8*)(krow + 32 * s), *(const LAS bf16x8*)(qrow + 32 * s), d);
              const int j0 = 16 * nt + 4 * q4; float v[4];
#pragma unroll
              for (int jj = 0; jj < 4; ++jj) { const bool keep = adir == 0 ? (j0 + jj <= i) : (j0 + jj >= i); v[jj] = keep ? d[jj] : 0.f; }
              v2u w2; w2.x = pk2(v[0], v[1]); w2.y = pk2(v[2], v[3]); *(v2u*)(arow + j0) = w2; } }
    }
}
constexpr int SCAN_Q = 0, SCAN_K = 32768, SCAN_A = 65536, SCAN_D = 73728, SCAN_BUF = 74752;
__device__ __forceinline__ void scan_stage(const bf16* QIN, const bf16* KOT, const bf16* ATT, const float* DEC, LAS unsigned char* buf, int lw, int lane, int dir, int b, int h, int c) {
    const int m0 = b * SEQ + c * 64;
    const int sb_ = lane * 16, swz = sb_ ^ (((sb_ >> 9) & 1) << 5), rl = swz >> 6, cl = (swz & 63) >> 1;
#pragma unroll
    for (int i = 0; i < 8; ++i) { const int q = lw * 8 + i, sl = q >> 3, j = q & 7, R = (j >> 1) * 16 + rl, C = (j & 1) * 32 + cl;
        __builtin_amdgcn_global_load_lds((const GAS unsigned*)(QIN + ((size_t)dir * M + m0 + R) * 1024 + h * 256 + sl * 64 + C), (LAS unsigned*)(buf + SCAN_Q + sl * 8192 + j * 1024), 16, 0, 0); }
#pragma unroll
    for (int i = 0; i < 8; ++i) { const int k = lw * 8 + i, hh = k >> 4, j = k & 15, Rg = 128 * hh + (j >> 1) * 16 + rl, C = (j & 1) * 32 + cl, Rb = (Rg & ~31) + pg8::perm32(Rg & 31);
        __builtin_amdgcn_global_load_lds((const GAS unsigned*)(KOT + ((size_t)dir * 1024 + h * 256 + Rb) * M + m0 + C), (LAS unsigned*)(buf + SCAN_K + hh * 16384 + j * 1024), 16, 0, 0); }
    const bf16* ab = ATT + ((((size_t)dir * 4 + b) * 4 + h) * 64 + c) * 4096;
#pragma unroll
    for (int i = 0; i < 2; ++i) { const int j = lw * 2 + i, R = (j >> 1) * 16 + rl, C = (j & 1) * 32 + cl;
        __builtin_amdgcn_global_load_lds((const GAS unsigned*)(ab + R * 64 + C), (LAS unsigned*)(buf + SCAN_A + j * 1024), 16, 0, 0); }
    if (lw == 0) __builtin_amdgcn_global_load_lds((const GAS unsigned*)(DEC + (((size_t)dir * 4 + b) * 64 + c) * 1024 + h * 256 + lane * 4), (LAS unsigned*)(buf + SCAN_D), 16, 0, 0);
}
__device__ __forceinline__ void gla_scan_phase(Frame& F) {
    const Ids I = phase_ids(F.wv);
    const bf16* VT = WSP(const bf16, WS_VT); const bf16* QIN = WSP(const bf16, WS_QIN); const bf16* KOT = WSP(const bf16, WS_KOT); const bf16* ATT = WSP(const bf16, WS_ATT);
    const float* DEC = WSP(const float, WS_DEC); float* O = WSP(float, WS_O);
    const int fr = I.lane & 15, q4 = I.lane >> 4;
    for (int bt = blockIdx.x; bt < 256; bt += I.G) {
        const int x = bt & 7, y = bt >> 3, sc = x * 4 + (y >> 3), eq = y & 7;
        const int dir = sc & 1, h = (sc >> 1) & 3, b = sc >> 3;
        asm volatile("s_waitcnt vmcnt(0) lgkmcnt(0)" ::: "memory"); __builtin_amdgcn_s_barrier(); asm volatile("" ::: "memory");
        if (I.wave >= 4) {
            const int lw = I.wave - 4;
            scan_stage(QIN, KOT, ATT, DEC, F.lds, lw, I.lane, dir, b, h, dir ? 63 : 0);
            asm volatile("s_waitcnt vmcnt(0)" ::: "memory"); __builtin_amdgcn_s_barrier(); asm volatile("" ::: "memory");
            for (int step = 0; step < 64; ++step) {
                if (step + 1 < 64) scan_stage(QIN, KOT, ATT, DEC, F.lds + ((step + 1) & 1) * SCAN_BUF, lw, I.lane, dir, b, h, dir ? 62 - step : step + 1);
                asm volatile("s_waitcnt vmcnt(0)" ::: "memory"); __builtin_amdgcn_s_barrier(); asm volatile("" ::: "memory");
            }
        } else {
            const int es = eq * 4 + I.wave;
            f32x4 st[16];
#pragma unroll
            for (int t = 0; t < 16; ++t) st[t] = (f32x4){0.f, 0.f, 0.f, 0.f};
            const bf16* vrow = VT + (size_t)(2048 + h * 512 + es * 16 + fr) * M + b * SEQ + 8 * q4;
            const int ob = fr * 64 + 16 * q4, lo = ob ^ (((ob >> 9) & 1) << 5);
            bf16x8 vf[2];
            { const int c0 = dir ? 63 : 0;
#pragma unroll
              for (int sp = 0; sp < 2; ++sp) vf[sp] = *(const bf16x8*)(vrow + c0 * 64 + 32 * sp); }
            asm volatile("" ::: "memory"); __builtin_amdgcn_s_barrier(); asm volatile("" ::: "memory");
            for (int step = 0; step < 64; ++step) {
                const int c = dir ? 63 - step : step, m0 = b * SEQ + c * 64;
                const LAS unsigned char* bb = F.lds + (step & 1) * SCAN_BUF + lo;
                bf16x8 vn[2];
                { const int cn = step + 1 < 64 ? (dir ? 62 - step : step + 1) : c;
#pragma unroll
                  for (int sp = 0; sp < 2; ++sp) vn[sp] = *(const bf16x8*)(vrow + cn * 64 + 32 * sp); }
                bf16x8 sb[8];
#pragma unroll
                for (int s = 0; s < 8; ++s) { v4u w; w.x = pk2(st[2 * s][0], st[2 * s][1]); w.y = pk2(st[2 * s][2], st[2 * s][3]); w.z = pk2(st[2 * s + 1][0], st[2 * s + 1][1]); w.w = pk2(st[2 * s + 1][2], st[2 * s + 1][3]); sb[s] = __builtin_bit_cast(bf16x8, w); }
#pragma unroll
                for (int mt = 0; mt < 4; ++mt) { f32x4 o = (f32x4){0.f, 0.f, 0.f, 0.f};
#pragma unroll
                    for (int s = 0; s < 8; ++s) o = mfma16(sb[s], *(const LAS bf16x8*)(bb + SCAN_Q + (s >> 1) * 8192 + (2 * mt + (s & 1)) * 1024), o);
#pragma unroll
                    for (int sp = 0; sp < 2; ++sp) o = mfma16(vf[sp], *(const LAS bf16x8*)(bb + SCAN_A + (2 * mt + sp) * 1024), o);
                    *(f32x4*)(O + ((size_t)dir * M + m0 + 16 * mt + fr) * 2048 + h * 512 + es * 16 + 4 * q4) = o; }
                const LAS unsigned char* dbase = F.lds + (step & 1) * SCAN_BUF + SCAN_D + 32 * q4;
#pragma unroll
                for (int s = 0; s < 8; ++s)
#pragma unroll
                    for (int u = 0; u < 2; ++u) { const int t = 2 * s + u;
                        const f32x4 dc = *(const LAS f32x4*)(dbase + (32 * s + 4 * u) * 4);
                        f32x4 a = st[t] * dc;
#pragma unroll
                        for (int sp = 0; sp < 2; ++sp) a = mfma16(*(const LAS bf16x8*)(bb + SCAN_K + (s >> 2) * 16384 + ((2 * (s & 3) + u) * 2 + sp) * 1024), vf[sp], a);
                        st[t] = a; }
                vf[0] = vn[0]; vf[1] = vn[1];
                asm volatile("s_waitcnt lgkmcnt(0)" ::: "memory"); __builtin_amdgcn_s_barrier(); asm volatile("" ::: "memory");
            }
        }
    }
}


#ifndef PHM
#define PHM 0xffff
#endif
#ifndef REPM
#define REPM 0
#endif
#define RP(bit) for (int rep_ = 0; rep_ < ((REPM & (bit)) ? 2 : 1); ++rep_)
__global__ void __launch_bounds__(NWAVES * 64, 2) enc_fwd(Args args) {
    extern __shared__ __attribute__((aligned(16))) unsigned char lds[];
    Frame F;
    F.lds = (LAS unsigned char*)lds; F.wv = __builtin_amdgcn_readfirstlane(threadIdx.x >> 6);
    volatile LAS unsigned* MISC = (volatile LAS unsigned*)(F.lds + MISC_OFF);
    if (threadIdx.x < 128) MISC[threadIdx.x] = 0u;
    __syncthreads();
    (void)xcd_barrier_post((unsigned*)(GAS unsigned*)(args.ws + WS_CTL) + CW_BAR, MISC + 8);
#if MK_MULTI
#define IN(k) (kargs()->ph_lo <= (k) && (k) < kargs()->ph_hi)
#else
#define IN(k) true
#endif
#define SEAM(k) do { if (IN((k) + 1)) { XcdBarrier bb; bb.wv = (unsigned)F.wv; bb.bar = (unsigned*)(GAS unsigned*)(kargs()->ws + WS_CTL) + CW_BAR; bb.x = (unsigned)__builtin_amdgcn_readfirstlane((int)xb_xcc_id()); bb.st = (volatile LAS unsigned*)(F.lds + MISC_OFF) + 8; xcd_barrier(bb); } } while (0)
    LAS unsigned char* ring = F.lds;

    if (IN(0)) { RP(1) p0_prologue(F); SEAM(0); }

    for (int layer = 0; layer < DEPTH; ++layer) {
        const int pb = 1 + 11 * layer;
#define WL ((unsigned char*)(kargs()->ws + WS_W + (size_t)layer * SZ_WL))

        const pg8::bf16_t* XB = WSP(const pg8::bf16_t, WS_XB);
        if (IN(pb + 0)) { RP(2) {
            { pg8::Gemm g{XB, (const pg8::bf16_t*)(WL + OFF_WIN), M, NIN_MAIN, D}; pg8::StaticOrder S; S.init(M, NIN_MAIN, (int)gridDim.x, (int)blockIdx.x);
              pg8::EpiIn E{WSP(pg8::bf16_t, WS_HB), LDH, WSP(float, WS_GA), WSP(pg8::bf16_t, WS_GATES), INP(2) + (size_t)layer * 3 * D};
              pg8::gemm_phase<pg8::EpiIn, pg8::StaticOrder, true, true>(ring, g, S, E, F.wv); }
            { pg8::Gemm g{(const pg8::bf16_t*)(WL + OFF_WIN) + (size_t)NIN_MAIN * D, XB, 4096, M, D}; pg8::StaticOrder S; S.init(4096, M, (int)gridDim.x, (int)blockIdx.x);
              pg8::EpiBf16 E{WSP(pg8::bf16_t, WS_VT), M};
              pg8::gemm_phase<pg8::EpiBf16, pg8::StaticOrder, true, true>(ring, g, S, E, F.wv); } }
            SEAM(pb + 0);
        }
        if (IN(pb + 1)) { RP(4) conv_mixer_phase(F, layer); RP(8) gla_prep_phase(F, layer); RP(16) na_phase(F, layer); SEAM(pb + 1); }
        if (IN(pb + 2)) { RP(32) gla_scan_phase(F); SEAM(pb + 2); }
        if (IN(pb + 3)) { RP(64) gla_combine_phase(F, layer); SEAM(pb + 3); }
        if (IN(pb + 4)) { RP(128) {
            pg8::StaticOrder S; S.init(M, D, (int)gridDim.x, (int)blockIdx.x);
            { pg8::Gemm g{WSP(const pg8::bf16_t, WS_YC), (const pg8::bf16_t*)(WL + OFF_WBR), M, D, BW};
              pg8::EpiBranch<0> E{WSP(pg8::bf16_t, WS_MIXED), WSP(const pg8::bf16_t, WS_GATES)}; pg8::gemm_phase<pg8::EpiBranch<0>, pg8::StaticOrder, true, true>(ring, g, S, E, F.wv); }
            { pg8::Gemm g{WSP(const pg8::bf16_t, WS_YN), (const pg8::bf16_t*)(WL + OFF_WBR) + (size_t)D * BW, M, D, BW};
              pg8::EpiBranch<1> E{WSP(pg8::bf16_t, WS_MIXED), WSP(const pg8::bf16_t, WS_GATES)}; pg8::gemm_phase<pg8::EpiBranch<1>, pg8::StaticOrder, true, true>(ring, g, S, E, F.wv); }
            { pg8::Gemm g{WSP(const pg8::bf16_t, WS_YG), (const pg8::bf16_t*)(WL + OFF_WBR) + (size_t)2 * D * BW, M, D, BW};
              pg8::EpiBranch<2> E{WSP(pg8::bf16_t, WS_MIXED), WSP(const pg8::bf16_t, WS_GATES)}; pg8::gemm_phase<pg8::EpiBranch<2>, pg8::StaticOrder, true, true>(ring, g, S, E, F.wv); } }
            SEAM(pb + 4);
        }
        const float* xres = layer == 0 ? INP(0) : WSP(const float, WS_XR);
        if (IN(pb + 5)) { {
            pg8::Gemm g{WSP(const pg8::bf16_t, WS_MIXED), (const pg8::bf16_t*)(WL + OFF_WO), M, D, D}; pg8::StaticOrder S; S.init(M, D, (int)gridDim.x, (int)blockIdx.x);
            pg8::EpiResid E{WSP(float, WS_XR), xres, D, ALPHA}; pg8::gemm_phase<pg8::EpiResid, pg8::StaticOrder, true, true>(ring, g, S, E, F.wv); }
            SEAM(pb + 5);
        }
        if (IN(pb + 6)) { ln_phase(F, WSP(const float, WS_XR), INP(10) + (size_t)layer * D, INP(11) + (size_t)layer * D, WSP(float, WS_XR), WSP(bf16, WS_XB)); SEAM(pb + 6); }
        if (IN(pb + 7)) { RP(1024) {
            pg8::Gemm g{XB, (const pg8::bf16_t*)(WL + OFF_WFI), M, 2 * FF, D}; pg8::StaticOrder S; S.init(M, 2 * FF, (int)gridDim.x, (int)blockIdx.x);
            pg8::EpiBf16 E{WSP(pg8::bf16_t, WS_AU), 2 * FF}; pg8::gemm_phase<pg8::EpiBf16, pg8::StaticOrder, true, true>(ring, g, S, E, F.wv); }
            SEAM(pb + 7);
        }
        if (IN(pb + 8)) { RP(2048) convglu_phase(F, layer); SEAM(pb + 8); }
        if (IN(pb + 9)) { {
            pg8::Gemm g{WSP(const pg8::bf16_t, WS_G), (const pg8::bf16_t*)(WL + OFF_WFO), M, D, FF}; pg8::StaticOrder S; S.init(M, D, (int)gridDim.x, (int)blockIdx.x);
            pg8::EpiResid E{WSP(float, WS_XR), WSP(const float, WS_XR), D, ALPHA}; pg8::gemm_phase<pg8::EpiResid, pg8::StaticOrder, true, true>(ring, g, S, E, F.wv); }
            SEAM(pb + 9);
        }
        if (IN(pb + 10)) { ln_phase(F, WSP(const float, WS_XR), INP(16) + (size_t)layer * D, INP(17) + (size_t)layer * D, layer == DEPTH - 1 ? OUTP : WSP(float, WS_XR), WSP(bf16, WS_XB)); SEAM(pb + 10); }
    }
#undef IN
#undef SEAM
}

extern "C" void kernel_launch(void* const* d_in, const int* in_sizes, int n_in, void* d_out, int out_size, void* d_ws, size_t ws_size, hipStream_t stream) {
    static int grid = 0;
    if (grid == 0) {
        if (n_in != 18 || in_sizes[0] != M * D || out_size != M * D || ws_size < WS_END) { fprintf(stderr, "kernel_launch: unexpected sizes: n_in %d in0 %d out %d ws %zu (need %zu); nothing launched\n", n_in, n_in > 0 ? in_sizes[0] : -1, out_size, ws_size, (size_t)WS_END); grid = -1; return; }
        int dev = 0, cus = 0, per_cu = 0;
        if (hipGetDevice(&dev) != hipSuccess || hipDeviceGetAttribute(&cus, hipDeviceAttributeMultiprocessorCount, dev) != hipSuccess) { grid = -1; return; }
        if (hipFuncSetAttribute((const void*)enc_fwd, hipFuncAttributeMaxDynamicSharedMemorySize, LDS_BYTES) != hipSuccess) { fprintf(stderr, "kernel_launch: hipFuncSetAttribute failed\n"); grid = -1; return; }
        if (hipOccupancyMaxActiveBlocksPerMultiprocessor(&per_cu, (const void*)enc_fwd, NWAVES * 64, LDS_BYTES) != hipSuccess || per_cu < 1) { fprintf(stderr, "kernel_launch: occupancy query reports %d workgroups per CU\n", per_cu); grid = -1; (void)hipGetLastError(); return; }
        (void)hipGetLastError();
        grid = cus;
    }
    if (grid < 0) return;
    if (hipMemsetAsync((char*)d_ws + WS_CTL, 0, CTL_ZERO_BYTES, stream) != hipSuccess) return;
    Args a{};
    for (int i = 0; i < 18; ++i) a.in[i] = (GAS const float*)d_in[i];
    a.out = (GAS float*)d_out; a.ws = (GAS unsigned char*)d_ws;
#if MK_MULTI
    for (int p = 0; p < N_PHASES; ++p) { a.ph_lo = p; a.ph_hi = p + 1; hipLaunchKernelGGL(enc_fwd, dim3(grid), dim3(NWAVES * 64), LDS_BYTES, stream, a); }
#else
    a.ph_lo = 0; a.ph_hi = N_PHASES;
    hipLaunchKernelGGL(enc_fwd, dim3(grid), dim3(NWAVES * 64), LDS_BYTES, stream, a);
#endif
}
```

```cpp
#include <hip/hip_runtime.h>
#include <cstdio>
#include <cstdint>
namespace pg8 {
#define PG8_LAS __attribute__((address_space(3)))
typedef unsigned short bf16_t;
typedef short bf16x8 __attribute__((ext_vector_type(8)));
typedef float f32x4 __attribute__((ext_vector_type(4)));
typedef unsigned u32x4 __attribute__((ext_vector_type(4)));
constexpr int BM = 256, BK = 64, HALF = 128, HTB = HALF * BK * 2  , STAGE_BYTES = 8 * HTB, NXCD = 8, WGM = 8;

__host__ __device__ __forceinline__ int lds_byte(int r, int c) { const int st = (r >> 4) * 2 + (c >> 5), rr = r & 15, cc = c & 31, ob = rr * 64 + cc * 2; return st * 1024 + (ob ^ (((ob >> 9) & 1) << 5)); }
__host__ __device__ __forceinline__ void stage_rc(int b, int& R, int& C) { const int st = b / 1024, sb = b % 1024, swz = sb ^ (((sb >> 9) & 1) << 5); R = (st >> 1) * 16 + swz / 64; C = (st & 1) * 32 + (swz % 64) / 2; }
__host__ __device__ __forceinline__ int perm32(int rho) { const int n = rho >> 4, i = rho & 15; return 8 * (i >> 2) + 4 * n + (i & 3); }

struct Unit { int pm, pn; };
struct Gemm { const bf16_t* A; const bf16_t* Bt; int M, N, K; };

struct StaticOrder {
    int nM, nN, nwg, G, c;
    __host__ __device__ void init(int M, int N, int G_, int c_) { nM = M / BM; nN = N / BM; nwg = nM * nN; G = G_; c = c_; }
    __host__ __device__ bool next(int i, Unit& u) const {
        const long L = (long)i * G + c; if (L >= nwg) return false;
        int wgid = (int)L; { const int q = nwg / NXCD, r = nwg % NXCD, xcd = wgid % NXCD, off = wgid / NXCD; wgid = (xcd < r ? xcd * (q + 1) : r * (q + 1) + (xcd - r) * q) + off; }
        const int nig = WGM * nN, gid = wgid / nig, fm = gid * WGM, gsz = (nM - fm) < WGM ? (nM - fm) : WGM;
        u.pm = fm + ((wgid % nig) % gsz); u.pn = (wgid % nig) / gsz; return true;
    }
    __device__ __forceinline__ void a_ready(const Unit&) const {}
    __device__ __forceinline__ void done(const Unit&) const {}
};

__device__ __forceinline__ unsigned cvt_pk_bf16(float lo, float hi) { unsigned r; asm volatile("v_cvt_pk_bf16_f32 %0, %1, %2" : "=v"(r) : "v"(lo), "v"(hi)); return r; }
typedef float f32x2 __attribute__((ext_vector_type(2)));
__device__ __forceinline__ f32x2 gelu_pk(f32x2 v) {
    const f32x2 av = __builtin_elementwise_abs(v), d = av * 0.2316418882f + 1.0f;
    f32x2 t; t.x = __builtin_amdgcn_rcpf(d.x); t.y = __builtin_amdgcn_rcpf(d.y);
    f32x2 q = t * 0.5307027145f + (-0.7265760135f); q = q * t + 0.7107068705f; q = q * t + (-0.142248368f); q = q * t + 0.127414796f; q = q * t;
    const f32x2 s = (v * v) * (-0.72134752044f);
    f32x2 e; e.x = __builtin_amdgcn_exp2f(s.x); e.y = __builtin_amdgcn_exp2f(s.y);
    const f32x2 m = v * (q * e), r = v - m;
    f32x2 o; o.x = v.x < 0.f ? m.x : r.x; o.y = v.y < 0.f ? m.y : r.y; return o;
}

__device__ __forceinline__ float bf_lo(unsigned w) { return __uint_as_float(w << 16); }
__device__ __forceinline__ float bf_hi(unsigned w) { return __uint_as_float(w & 0xffff0000u); }
__device__ __forceinline__ float sigmoidf_fast(float v) { return __builtin_amdgcn_rcpf(1.0f + __builtin_amdgcn_exp2f(-1.44269504f * v)); }

struct EpiBf16 {
    static constexpr bool PERM = true, AFTER_DRAIN = false;
    bf16_t* O; int ldc;
    __device__ __forceinline__ void operator()(const f32x4 (&acc)[2][2][4][2], const Unit& u, int wr, int wc, int fr, int fq) const {
        asm volatile("" : "+v"(fr), "+v"(fq));
        const int row0 = u.pm * BM + wr * 64 + fr, col0 = u.pn * BM + wc * 32 + 8 * fq;
#pragma unroll
        for (int ai = 0; ai < 2; ++ai)
#pragma unroll
            for (int m = 0; m < 4; ++m) { bf16_t* rowp = O + (size_t)(row0 + ai * HALF + m * 16) * ldc + col0;
#pragma unroll
                for (int bj = 0; bj < 2; ++bj) { const f32x4 v0 = acc[ai][bj][m][0], v1 = acc[ai][bj][m][1];
                    u32x4 w; w.x = cvt_pk_bf16(v0[0], v0[1]); w.y = cvt_pk_bf16(v0[2], v0[3]); w.z = cvt_pk_bf16(v1[0], v1[1]); w.w = cvt_pk_bf16(v1[2], v1[3]);
                    *(u32x4*)(rowp + bj * HALF) = w; } }
    }
};
struct EpiIn {
    static constexpr bool PERM = true, AFTER_DRAIN = false;
    bf16_t* HB; int ldh; float* GA; bf16_t* GATES; const float* bgate;
    __device__ __forceinline__ void operator()(const f32x4 (&acc)[2][2][4][2], const Unit& u, int wr, int wc, int fr, int fq) const {
        asm volatile("" : "+v"(fr), "+v"(fq));
        const int row0 = u.pm * BM + wr * 64 + fr;
        if (u.pn < 56) {
            const int col0 = u.pn * BM + wc * 32 + 8 * fq;
#pragma unroll
            for (int ai = 0; ai < 2; ++ai)
#pragma unroll
                for (int m = 0; m < 4; ++m) { bf16_t* rowp = HB + (size_t)(row0 + ai * HALF + m * 16) * ldh + col0;
#pragma unroll
                    for (int bj = 0; bj < 2; ++bj) { const f32x4 v0 = acc[ai][bj][m][0], v1 = acc[ai][bj][m][1];
                        u32x4 w; w.x = cvt_pk_bf16(v0[0], v0[1]); w.y = cvt_pk_bf16(v0[2], v0[3]); w.z = cvt_pk_bf16(v1[0], v1[1]); w.w = cvt_pk_bf16(v1[2], v1[3]);
                        *(u32x4*)(rowp + bj * HALF) = w; } }
        } else if (u.pn == 56) {
            if (wc == 0) {
#pragma unroll
                for (int ai = 0; ai < 2; ++ai)
#pragma unroll
                    for (int m = 0; m < 4; ++m) { float* rowp = GA + (size_t)(row0 + ai * HALF + m * 16) * 32 + 8 * fq;
                        *(f32x4*)rowp = acc[ai][0][m][0]; *(f32x4*)(rowp + 4) = acc[ai][0][m][1]; }
            }
        } else {
            const int col0 = (u.pn - 57) * BM + wc * 32 + 8 * fq;
#pragma unroll
            for (int ai = 0; ai < 2; ++ai)
#pragma unroll
                for (int m = 0; m < 4; ++m) { bf16_t* rowp = GATES + (size_t)(row0 + ai * HALF + m * 16) * 12288 + col0;
                    asm volatile("" ::: "memory");
#pragma unroll
                    for (int bj = 0; bj < 2; ++bj) { const f32x4 v0 = acc[ai][bj][m][0] + *(const f32x4*)(bgate + col0 + bj * HALF), v1 = acc[ai][bj][m][1] + *(const f32x4*)(bgate + col0 + bj * HALF + 4);
                        u32x4 w; w.x = cvt_pk_bf16(sigmoidf_fast(v0[0]), sigmoidf_fast(v0[1])); w.y = cvt_pk_bf16(sigmoidf_fast(v0[2]), sigmoidf_fast(v0[3]));
                        w.z = cvt_pk_bf16(sigmoidf_fast(v1[0]), sigmoidf_fast(v1[1])); w.w = cvt_pk_bf16(sigmoidf_fast(v1[2]), sigmoidf_fast(v1[3]));
                        *(u32x4*)(rowp + bj * HALF) = w; } }
        }
    }
};
template <int I> struct EpiBranch {
    static constexpr bool PERM = true, AFTER_DRAIN = false;
    bf16_t* MIXED; const bf16_t* GATES;
    __device__ __forceinline__ void operator()(const f32x4 (&acc)[2][2][4][2], const Unit& u, int wr, int wc, int fr, int fq) const {
        asm volatile("" : "+v"(fr), "+v"(fq));
        const int row0 = u.pm * BM + wr * 64 + fr, col0 = u.pn * BM + wc * 32 + 8 * fq;
#pragma unroll
        for (int ai = 0; ai < 2; ++ai)
#pragma unroll
            for (int m = 0; m < 4; ++m) { const size_t r = (size_t)(row0 + ai * HALF + m * 16);
                asm volatile("" ::: "memory");
#pragma unroll
                for (int bj = 0; bj < 2; ++bj) {
                    const u32x4 g = *(const u32x4*)(GATES + r * 12288 + I * 4096 + col0 + bj * HALF);
                    bf16_t* mp = MIXED + r * 4096 + col0 + bj * HALF;
                    u32x4 p = (u32x4){0u, 0u, 0u, 0u}; if (I) p = *(const u32x4*)mp;
                    const f32x4 a0 = acc[ai][bj][m][0], a1 = acc[ai][bj][m][1];
                    u32x4 w;
                    w.x = cvt_pk_bf16(bf_lo(p.x) + bf_lo(g.x) * a0[0], bf_hi(p.x) + bf_hi(g.x) * a0[1]);
                    w.y = cvt_pk_bf16(bf_lo(p.y) + bf_lo(g.y) * a0[2], bf_hi(p.y) + bf_hi(g.y) * a0[3]);
                    w.z = cvt_pk_bf16(bf_lo(p.z) + bf_lo(g.z) * a1[0], bf_hi(p.z) + bf_hi(g.z) * a1[1]);
                    w.w = cvt_pk_bf16(bf_lo(p.w) + bf_lo(g.w) * a1[2], bf_hi(p.w) + bf_hi(g.w) * a1[3]);
                    *(u32x4*)mp = w; } }
    }
};
struct EpiResid {
    static constexpr bool PERM = false, AFTER_DRAIN = false;
    float* V; const float* xres; int ldc; float alpha;
    __device__ __forceinline__ void operator()(const f32x4 (&acc)[2][2][4][2], const Unit& u, int wr, int wc, int fr, int fq) const {
        asm volatile("" : "+v"(fr), "+v"(fq));
        const int row0 = u.pm * BM + wr * 64 + fr, col0 = u.pn * BM + wc * 32 + 4 * fq;
#pragma unroll
        for (int ai = 0; ai < 2; ++ai)
#pragma unroll
            for (int m = 0; m < 4; ++m) { const size_t off = (size_t)(row0 + ai * HALF + m * 16) * ldc + col0;
                asm volatile("" ::: "memory");
#pragma unroll
                for (int bj = 0; bj < 2; ++bj)
#pragma unroll
                    for (int n = 0; n < 2; ++n) { const f32x4 xr = *(const f32x4*)(xres + off + bj * HALF + n * 16);
                        *(f32x4*)(V + off + bj * HALF + n * 16) = xr * alpha + acc[ai][bj][m][n]; } }
    }
};

template <class Epi, class Sched, bool ALIGN_EPI = false, bool SP2 = false>
__device__ __forceinline__ void gemm_phase(PG8_LAS unsigned char* lds, const Gemm g, const Sched& S, const Epi& E, const int wv  ) {
    int tid_ = wv * 64 + (int)__builtin_amdgcn_mbcnt_hi(~0u, __builtin_amdgcn_mbcnt_lo(~0u, 0u)); asm volatile("" : "+v"(tid_));
    const int tid = tid_, wid = __builtin_amdgcn_readfirstlane(tid >> 6), lane = tid & 63, wr = wid >> 2, wc = wid & 3, fr = lane & 15, fq = lane >> 4;
    const int K = g.K, nt = K / BK;
    unsigned voffA[2], voffB[2];
#pragma unroll
    for (int i = 0; i < 2; ++i) { int R, C; stage_rc(tid * 16 + i * 8192, R, C); const int Rb = Epi::PERM ? ((R & ~31) + perm32(R & 31)) : R;
        voffA[i] = (unsigned)(R * K + C) * 2u; voffB[i] = (unsigned)(Rb * K + C) * 2u; }
    const size_t kstep = (size_t)(BK * 2);
    const size_t hstep = (size_t)HALF * K * 2;
    const size_t tstep = 2 * hstep;
    const unsigned ldsw = (unsigned)wid * 1024u;
    const int aoff = lds_byte(wr * 64 + fr, fq * 8), boff = lds_byte(wc * 32 + fr, fq * 8);
#define PG8_SA(b, h) (((b) * 2 + (h)) * HTB)
#define PG8_SB(b, h) ((4 + (b) * 2 + (h)) * HTB)
#define PG8_STAGE(bufoff, gbase, voff) do { _Pragma("unroll") for (int _i = 0; _i < 2; ++_i) \
        __builtin_amdgcn_global_load_lds((const unsigned*)((const char*)(gbase) + (voff)[_i]), (PG8_LAS unsigned*)(lds + (bufoff) + ldsw + _i * 8192), 16, 0, 0); } while (0)
#define PG8_LDA(dst, b, h) do { _Pragma("unroll") for (int m = 0; m < 4; ++m) _Pragma("unroll") for (int k = 0; k < 2; ++k) dst[m][k] = *(const PG8_LAS bf16x8*)(lds + PG8_SA(b, h) + aoff + m * 2048 + k * 1024); } while (0)
#define PG8_LDB(dst, b, h) do { _Pragma("unroll") for (int n = 0; n < 2; ++n) _Pragma("unroll") for (int k = 0; k < 2; ++k) dst[n][k] = *(const PG8_LAS bf16x8*)(lds + PG8_SB(b, h) + boff + n * 2048 + k * 1024); } while (0)
#define PG8_MMA(ai, bj, At, Bt) do { __builtin_amdgcn_s_setprio(1); _Pragma("unroll") for (int m = 0; m < 4; ++m) _Pragma("unroll") for (int n = 0; n < 2; ++n) _Pragma("unroll") for (int k = 0; k < 2; ++k) \
        acc[ai][bj][m][n] = __builtin_amdgcn_mfma_f32_16x16x32_bf16(Bt[n][k], At[m][k], acc[ai][bj][m][n], 0, 0, 0); __builtin_amdgcn_s_setprio(0); } while (0)
#define PG8_WAIT_V(n) asm volatile("s_waitcnt vmcnt(" #n ")" ::: "memory")
#define PG8_WAIT_L(n) asm volatile("s_waitcnt lgkmcnt(" #n ")" ::: "memory")
#define PG8_BAR __builtin_amdgcn_s_barrier()
#define PG8_SCHED __builtin_amdgcn_sched_barrier(0)
    Unit cur, nxt; int ui = 0;
    if (!S.next(0, cur)) return;
    f32x4 acc[2][2][4][2];
#pragma unroll
    for (int a = 0; a < 2; ++a)
#pragma unroll
        for (int b = 0; b < 2; ++b)
#pragma unroll
            for (int m = 0; m < 4; ++m)
#pragma unroll
                for (int n = 0; n < 2; ++n) acc[a][b][m][n] = (f32x4){0.f, 0.f, 0.f, 0.f};
    bf16x8 At[4][2], B0[2][2], B1[2][2];
    const char* cA = (const char*)g.A + (size_t)cur.pm * tstep; const char* cB = (const char*)g.Bt + (size_t)cur.pn * tstep;
    S.a_ready(cur);
    if constexpr (SP2) {
        PG8_STAGE(PG8_SB(0, 0), cB, voffB); PG8_STAGE(PG8_SB(0, 1), cB + hstep, voffB); PG8_STAGE(PG8_SA(0, 0), cA, voffA); PG8_STAGE(PG8_SA(0, 1), cA + hstep, voffA);
        if (wr == 1) PG8_BAR;
        PG8_WAIT_V(2); PG8_BAR;
        PG8_STAGE(PG8_SB(1, 0), cB + kstep, voffB); PG8_STAGE(PG8_SA(1, 0), cA + kstep, voffA); PG8_STAGE(PG8_SB(1, 1), cB + hstep + kstep, voffB);
        PG8_WAIT_V(6); PG8_BAR;
    } else {
        PG8_STAGE(PG8_SB(0, 0), cB, voffB); PG8_STAGE(PG8_SA(0, 0), cA, voffA); PG8_STAGE(PG8_SB(0, 1), cB + hstep, voffB); PG8_STAGE(PG8_SA(0, 1), cA + hstep, voffA);
        if (wr == 1) PG8_BAR;
        PG8_WAIT_V(4); PG8_BAR;
        PG8_STAGE(PG8_SB(1, 0), cB + kstep, voffB); PG8_STAGE(PG8_SA(1, 0), cA + kstep, voffA); PG8_STAGE(PG8_SB(1, 1), cB + hstep + kstep, voffB);
        PG8_WAIT_V(6); PG8_BAR;
    }
    for (;;) {
        const bool has_next = S.next(ui + 1, nxt);
        const char* nA = has_next ? (const char*)g.A + (size_t)nxt.pm * tstep : cA; const char* nB = has_next ? (const char*)g.Bt + (size_t)nxt.pn * tstep : cB;
        for (int t = 0; t < nt; t += 2) {
            const bool last = (t == nt - 2);
            const char* a1 = cA + (size_t)(t + 1) * kstep;
            const char* a2 = last ? nA : cA + (size_t)(t + 2) * kstep; const char* b2 = last ? nB : cB + (size_t)(t + 2) * kstep;
            const char* a3 = a2 + kstep; const char* b3 = b2 + kstep;
            if (last && has_next) S.a_ready(nxt);
            if constexpr (SP2) {
            PG8_LDB(B0, 0, 0); PG8_LDB(B1, 0, 1); PG8_SCHED; PG8_LDA(At, 0, 0); PG8_STAGE(PG8_SA(1, 1), a1 + hstep, voffA);
            PG8_WAIT_V(8); PG8_WAIT_L(0); PG8_BAR; PG8_MMA(0, 0, At, B0); PG8_MMA(0, 1, At, B1); PG8_BAR; PG8_SCHED;
            PG8_LDA(At, 0, 1); PG8_STAGE(PG8_SB(0, 0), b2, voffB); PG8_STAGE(PG8_SB(0, 1), b2 + hstep, voffB); PG8_STAGE(PG8_SA(0, 0), a2, voffA);
            PG8_WAIT_V(8); PG8_WAIT_L(0); PG8_BAR; PG8_MMA(1, 0, At, B0); PG8_MMA(1, 1, At, B1); PG8_BAR; PG8_SCHED;
            PG8_LDB(B0, 1, 0); PG8_LDB(B1, 1, 1); PG8_SCHED; PG8_LDA(At, 1, 0); PG8_STAGE(PG8_SA(0, 1), a2 + hstep, voffA);
            PG8_WAIT_V(8); PG8_WAIT_L(0); PG8_BAR; PG8_MMA(0, 0, At, B0); PG8_MMA(0, 1, At, B1); PG8_BAR; PG8_SCHED;
            PG8_LDA(At, 1, 1); PG8_STAGE(PG8_SB(1, 0), b3, voffB); PG8_STAGE(PG8_SB(1, 1), b3 + hstep, voffB); PG8_STAGE(PG8_SA(1, 0), a3, voffA);
            PG8_WAIT_V(8); PG8_WAIT_L(0); PG8_BAR; PG8_MMA(1, 0, At, B0); PG8_MMA(1, 1, At, B1); PG8_BAR; PG8_SCHED;
            } else {
            PG8_LDB(B0, 0, 0); PG8_SCHED; PG8_LDA(At, 0, 0); PG8_STAGE(PG8_SA(1, 1), a1 + hstep, voffA);
            PG8_WAIT_L(8); PG8_BAR; PG8_WAIT_L(0); PG8_MMA(0, 0, At, B0); PG8_BAR; PG8_SCHED;
            PG8_LDB(B1, 0, 1); PG8_STAGE(PG8_SB(0, 0), b2, voffB);
            PG8_BAR; PG8_WAIT_L(0); PG8_MMA(0, 1, At, B1); PG8_BAR;
            PG8_LDA(At, 0, 1); PG8_STAGE(PG8_SA(0, 0), a2, voffA);
            PG8_BAR; PG8_WAIT_L(0); PG8_MMA(1, 0, At, B0); PG8_BAR; PG8_SCHED;
            PG8_STAGE(PG8_SB(0, 1), b2 + hstep, voffB);
            PG8_WAIT_V(6); PG8_BAR; PG8_MMA(1, 1, At, B1); PG8_BAR;
            PG8_LDB(B0, 1, 0); PG8_SCHED; PG8_LDA(At, 1, 0); PG8_STAGE(PG8_SA(0, 1), a2 + hstep, voffA);
            PG8_WAIT_L(8); PG8_BAR; PG8_WAIT_L(0); PG8_MMA(0, 0, At, B0); PG8_BAR; PG8_SCHED;
            PG8_LDB(B1, 1, 1); PG8_STAGE(PG8_SB(1, 0), b3, voffB);
            PG8_BAR; PG8_WAIT_L(0); PG8_MMA(0, 1, At, B1); PG8_BAR;
            PG8_LDA(At, 1, 1); PG8_STAGE(PG8_SA(1, 0), a3, voffA);
            PG8_BAR; PG8_WAIT_L(0); PG8_MMA(1, 0, At, B0); PG8_BAR; PG8_SCHED;
            PG8_STAGE(PG8_SB(1, 1), b3 + hstep, voffB);
            PG8_WAIT_V(6); PG8_BAR; PG8_MMA(1, 1, At, B1); PG8_BAR;
            }
        }
        if constexpr (ALIGN_EPI) { if (wr == 0) PG8_BAR; }
        if constexpr (!Epi::AFTER_DRAIN) { E(acc, cur, wr, wc, fr, fq); S.done(cur); }
        if (!has_next) break;
#pragma unroll
        for (int a = 0; a < 2; ++a)
#pragma unroll
            for (int b = 0; b < 2; ++b)
#pragma unroll
                for (int m = 0; m < 4; ++m)
#pragma unroll
                    for (int n = 0; n < 2; ++n) acc[a][b][m][n] = (f32x4){0.f, 0.f, 0.f, 0.f};
        cur = nxt; cA = nA; cB = nB; ++ui;
        if constexpr (ALIGN_EPI) { if (wr == 1) PG8_BAR; }
    }
    PG8_WAIT_V(0);
    if constexpr (!ALIGN_EPI) { if (wr == 0) PG8_BAR; }
    PG8_BAR;
    if constexpr (Epi::AFTER_DRAIN) { E.fused(acc, cur, wr, wc, fr, fq, lds, wid, lane); S.done(cur); }
#undef PG8_SA
#undef PG8_SB
#undef PG8_STAGE
#undef PG8_LDA
#undef PG8_LDB
#undef PG8_MMA
#undef PG8_WAIT_V
#undef PG8_WAIT_L
#undef PG8_BAR
#undef PG8_SCHED
}
}

constexpr int NWAVES = 8;
constexpr int NB = 4, SEQ = 4096, M = NB * SEQ, D = 4096, BW = 2048, FF = 11008, DEPTH = 2;
constexpr int IN_WIDTH = 30752;
constexpr int NIN_MAIN = 26880, NIN_PAD = 30976;
constexpr int LDH = 14336;
constexpr int H_CB = 0, H_CC = 2048, H_CH = 4096, H_NQ = 6144, H_NK = 8192, H_GQ = 10240, H_GK = 11264, H_GR = 12288;
constexpr float LN_EPS = 1e-5f, RMS_EPS = 1e-6f, ALPHA = 1.41421356237f;
#ifndef MK_MULTI
#define MK_MULTI 0
#endif
constexpr int N_PHASES = 1 + 11 * DEPTH;

constexpr size_t MiB = 1u << 20;
constexpr size_t alm(size_t x) { return (x + MiB - 1) / MiB * MiB; }
constexpr size_t WS_CTL = 0, CTL_ZERO_BYTES = 1 * MiB;
constexpr size_t SZ_WIN = alm((size_t)NIN_PAD * D * 2), SZ_WBR = alm((size_t)3 * D * BW * 2), SZ_WO = alm((size_t)D * D * 2), SZ_WFI = alm((size_t)2 * FF * D * 2), SZ_WFO = alm((size_t)D * FF * 2);
constexpr size_t OFF_WIN = 0, OFF_WBR = OFF_WIN + SZ_WIN, OFF_WO = OFF_WBR + SZ_WBR, OFF_WFI = OFF_WO + SZ_WO, OFF_WFO = OFF_WFI + SZ_WFI, SZ_WL = OFF_WFO + SZ_WFO;
constexpr size_t WS_W = 1 * MiB;
constexpr size_t WS_XB = WS_W + DEPTH * SZ_WL;
constexpr size_t WS_XR = WS_XB + alm((size_t)M * D * 2);
constexpr size_t WS_U = WS_XR + alm((size_t)M * D * 4);
constexpr size_t WS_HB = WS_U;
constexpr size_t WS_GA = WS_HB + alm((size_t)M * LDH * 2);
constexpr size_t WS_GATES = WS_GA + alm((size_t)M * 32 * 4);
constexpr size_t WS_VT = WS_GATES + alm((size_t)M * 12288 * 2);
constexpr size_t WS_YC = WS_VT + alm((size_t)4096 * M * 2);
constexpr size_t WS_YN = WS_YC + alm((size_t)M * BW * 2);
constexpr size_t WS_YG = WS_YN + alm((size_t)M * BW * 2);
constexpr size_t WS_QIN = WS_YG + alm((size_t)M * BW * 2);
constexpr size_t WS_KOT = WS_QIN + alm((size_t)2 * M * 1024 * 2);
constexpr size_t WS_ATT = WS_KOT + alm((size_t)2 * 1024 * M * 2);
constexpr size_t WS_DEC = WS_ATT + alm((size_t)2 * 4 * 4 * 64 * 64 * 64 * 2);
constexpr size_t WS_O = WS_DEC + alm((size_t)2 * 4 * 64 * 1024 * 4);
constexpr size_t WS_MIXED = WS_O + alm((size_t)2 * M * 2048 * 4);
constexpr size_t WS_END = WS_MIXED + alm((size_t)M * D * 2);
constexpr size_t WS_AU = WS_U;
constexpr size_t WS_G = WS_AU + alm((size_t)M * 2 * FF * 2);
static_assert(WS_G + alm((size_t)M * FF * 2) <= WS_MIXED, "the FFN overlay must stay below MIXED");
static_assert(WS_END <= (size_t)3844 * MiB, "d_ws budget: 4 x the largest input tensor");
constexpr int CW_BAR = 4096;

constexpr int RING_BYTES = 131072;
constexpr int LDS_BYTES = 159744;
constexpr int MISC_OFF = LDS_BYTES - 512;

#define GAS __attribute__((address_space(1)))
#define LAS __attribute__((address_space(3)))
typedef unsigned short bf16;
typedef unsigned v4u __attribute__((ext_vector_type(4)));
typedef unsigned v2u __attribute__((ext_vector_type(2)));
typedef float f32x4 __attribute__((ext_vector_type(4)));
typedef short bf16x8 __attribute__((ext_vector_type(8)));
typedef GAS unsigned gu32;
#define LDS_WAIT() asm volatile("s_waitcnt lgkmcnt(0)" ::: "memory")
#define VM_WAIT() asm volatile("s_waitcnt vmcnt(0)" ::: "memory")
__device__ __forceinline__ unsigned pk2(float lo, float hi) { return pg8::cvt_pk_bf16(lo, hi); }
__device__ __forceinline__ float bflo(unsigned w) { return __uint_as_float(w << 16); }
__device__ __forceinline__ float bfhi(unsigned w) { return __uint_as_float(w & 0xffff0000u); }
__device__ __forceinline__ float bf1(bf16 b) { return __uint_as_float(((unsigned)b) << 16); }
__device__ __forceinline__ void unpack8(const v4u w, float (&f)[8]) { f[0] = bflo(w.x); f[1] = bfhi(w.x); f[2] = bflo(w.y); f[3] = bfhi(w.y); f[4] = bflo(w.z); f[5] = bfhi(w.z); f[6] = bflo(w.w); f[7] = bfhi(w.w); }
__device__ __forceinline__ v4u pack8(const float (&f)[8]) { v4u w; w.x = pk2(f[0], f[1]); w.y = pk2(f[2], f[3]); w.z = pk2(f[4], f[5]); w.w = pk2(f[6], f[7]); return w; }
__device__ __forceinline__ float wave_sum(float v) {
#pragma unroll
    for (int o = 1; o < 64; o <<= 1) v += __shfl_xor(v, o);
    return v;
}
__device__ __forceinline__ f32x4 mfma16(bf16x8 a, bf16x8 b, f32x4 c) { return __builtin_amdgcn_mfma_f32_16x16x32_bf16(a, b, c, 0, 0, 0); }

#define XB_TMO      128
#define XB_XCNT(j)  (256  + 64 * (j))
#define XB_XSUB(j)  (1280 + 64 * (j))
#define XB_XGEN(j)  (2304 + 64 * (j))
#define XB_TOP      3328
#define XB_TOPGEN   3392
#define XCD_BAR_WORDS 3456
#define XB_SPIN_CAP (1u << 18)

__device__ __forceinline__ unsigned xb_ld(unsigned* p)              { return __hip_atomic_load(p, __ATOMIC_RELAXED, __HIP_MEMORY_SCOPE_AGENT); }
__device__ __forceinline__ unsigned xb_add(unsigned* p, unsigned v) { return __hip_atomic_fetch_add(p, v, __ATOMIC_RELAXED, __HIP_MEMORY_SCOPE_AGENT); }
__device__ __forceinline__ unsigned xb_xcc_id() { return (unsigned)__builtin_amdgcn_s_getreg((3 << 11) | 20) & 0xFu; }
#define XB_SPIN(cond, bar) do { unsigned _sp = 0; while (cond) { __builtin_amdgcn_s_sleep(1); \
    if ((++_sp & 255u) == 0u) { if (xb_ld(&(bar)[XB_TMO])) break; if (_sp > XB_SPIN_CAP) { atomicAdd(&(bar)[XB_TMO], 1u); break; } } } } while (0)

__device__ __forceinline__ unsigned xb_lane_id() { return __builtin_amdgcn_mbcnt_hi(~0u, __builtin_amdgcn_mbcnt_lo(~0u, 0u)); }
struct XcdBarrier {
    unsigned wv;
    unsigned* bar; unsigned x;
    volatile LAS unsigned* st;
};

__device__ __forceinline__ XcdBarrier xcd_barrier_post(unsigned* bar, volatile LAS unsigned* st) {
    XcdBarrier b; b.wv = 0u; b.bar = bar; b.x = xb_xcc_id(); b.st = st;
    if (threadIdx.x == 0) (void)xb_add(&bar[XB_XCNT(b.x)], 1u);
    return b;
}
__device__ __forceinline__ void xcd_barrier_complete(unsigned* bar, unsigned x, unsigned& nloc, unsigned& nx) {
    const unsigned G = gridDim.x * gridDim.y * gridDim.z;
    unsigned sum, cnt, mine, sp = 0u;
    for (;;) {
        sum = 0u; cnt = 0u; mine = 0u;
#pragma unroll
        for (unsigned j = 0; j < 16; ++j) { const unsigned c = xb_ld(&bar[XB_XCNT(j)]); sum += c; cnt += (c > 0u) ? 1u : 0u; mine = (j == x) ? c : mine; }
        if (sum == G) break;
        __builtin_amdgcn_s_sleep(1);
        if ((++sp & 255u) == 0u) { if (xb_ld(&bar[XB_TMO])) break; if (sp > XB_SPIN_CAP) { atomicAdd(&bar[XB_TMO], 1u); break; } }
    }
    nloc = mine > 0u ? mine : 1u; nx = cnt > 0u ? cnt : 1u;
}

__device__ __forceinline__ void xcd_barrier(const XcdBarrier& b) {
    asm volatile("s_waitcnt vmcnt(0)" ::: "memory");
    __syncthreads();
    if (b.wv == 0u && xb_lane_id() == 0u) {
        unsigned* bar = b.bar;
        __builtin_amdgcn_s_waitcnt(0);
        unsigned nloc = b.st[0], nx = b.st[1];
        if (nloc == 0u) { xcd_barrier_complete(bar, b.x, nloc, nx); b.st[0] = nloc; b.st[1] = nx; }
        const unsigned old = xb_add(&bar[XB_XSUB(b.x)], 1u);
        const unsigned gen = old / nloc;
        if (old + 1u == (gen + 1u) * nloc) {
            __builtin_amdgcn_fence(__ATOMIC_RELEASE, "agent");
            asm volatile("s_waitcnt vmcnt(0)" ::: "memory");
            const unsigned og = xb_add(&bar[XB_TOP], 1u);
            const unsigned tg = og / nx;
            if (og + 1u == (tg + 1u) * nx) xb_add(&bar[XB_TOPGEN], 1u);
            else XB_SPIN(xb_ld(&bar[XB_TOPGEN]) == tg, bar);
            __builtin_amdgcn_fence(__ATOMIC_ACQUIRE, "agent");
            xb_add(&bar[XB_XGEN(b.x)], 1u);
            asm volatile("s_waitcnt vmcnt(0)" ::: "memory");
        } else {
            XB_SPIN(xb_ld(&bar[XB_XGEN(b.x)]) == gen, bar);
            __builtin_amdgcn_fence(__ATOMIC_ACQUIRE, "agent");
            asm volatile("s_waitcnt vmcnt(0)" ::: "memory");
        }
    }
    __syncthreads();
}

struct Args { GAS const float* in[18]; GAS float* out; GAS unsigned char* ws; int ph_lo, ph_hi; };
typedef __attribute__((address_space(4))) const Args CArgs;
__device__ __forceinline__ CArgs* kargs() { CArgs* p = (CArgs*)__builtin_amdgcn_kernarg_segment_ptr(); asm volatile("" : "+s"(p)); return p; }
#define INP(i) ((const float*)kargs()->in[i])
#define OUTP ((float*)kargs()->out)
struct Frame { LAS unsigned char* lds; int wv; };
struct Ids { int tid, lane, wave, G, gw, NGW; };
__device__ __forceinline__ Ids phase_ids(const int wv) { Ids I; int t = wv * 64 + (int)__builtin_amdgcn_mbcnt_hi(~0u, __builtin_amdgcn_mbcnt_lo(~0u, 0u)); asm volatile("" : "+v"(t)); I.tid = t; I.lane = t & 63; I.wave = __builtin_amdgcn_readfirstlane(t >> 6);
    int g = gridDim.x; asm volatile("" : "+s"(g)); I.G = g; I.gw = blockIdx.x * NWAVES + I.wave; I.NGW = g * NWAVES; return I; }
#define WSP(T, off) ((T*)(GAS T*)(kargs()->ws + (off)))


__device__ __forceinline__ int win_src(int r) {
    if (r < 10240) return r;
    if (r < 12288) return 12288 + (r - 10240);
    if (r < 14336) return 16384 + (r - 12288);
    if (r < 14592) return r == 14336 ? 18432 : -1;
    if (r < 26880) return 18464 + (r - 14592);
    if (r < 28928) return 10240 + (r - 26880);
    return 14336 + (r - 28928);
}
__device__ __forceinline__ void tr_item(const float* W, size_t ldw, int K, int k0, int srcA, int srcB, bf16* WT, int n0, LAS float* scr, int lane) {
    const int src = lane < 32 ? srcA : srcB; const int cl = lane & 31;
    if (src >= 0) { const float* p = W + (size_t)k0 * ldw + src + cl;
#pragma unroll 16
        for (int kk = 0; kk < 64; ++kk) scr[kk * 65 + lane] = p[(size_t)kk * ldw];
    } else {
#pragma unroll 16
        for (int kk = 0; kk < 64; ++kk) scr[kk * 65 + lane] = 0.f;
    }
    LDS_WAIT(); asm volatile("" ::: "memory");
    const int c = lane & 7;
#pragma unroll
    for (int j = 0; j < 8; ++j) { const int n = (lane >> 3) + 8 * j; const LAS float* s = scr + (8 * c) * 65 + n;
        v4u o; o.x = pk2(s[0 * 65], s[1 * 65]); o.y = pk2(s[2 * 65], s[3 * 65]); o.z = pk2(s[4 * 65], s[5 * 65]); o.w = pk2(s[6 * 65], s[7 * 65]);
        *(v4u*)(WT + (size_t)(n0 + n) * K + k0 + 8 * c) = o; }
    LDS_WAIT(); asm volatile("" ::: "memory");
}
__device__ __forceinline__ void tr_matrix(const Ids& I, const float* W, int K, int N, bf16* WT, LAS float* scr) {
    const int nnb = N / 64, items = (K / 64) * nnb;
    for (int it = I.gw; it < items; it += I.NGW) { const int kb = it / nnb, nb = it % nnb; tr_item(W, (size_t)N, K, kb * 64, nb * 64, nb * 64 + 32, WT, nb * 64, scr, I.lane); }
}
__device__ __forceinline__ void p0_prologue(Frame& F) {
    const Ids I = phase_ids(F.wv);
    LAS float* scr = (LAS float*)(F.lds + I.wave * 16640);
    for (int l = 0; l < DEPTH; ++l) {
        unsigned char* wl = (unsigned char*)(kargs()->ws + WS_W + (size_t)l * SZ_WL);
        { const float* W = INP(1) + (size_t)l * D * IN_WIDTH; bf16* WT = (bf16*)(wl + OFF_WIN);
            const int nnb = NIN_PAD / 64, items = (D / 64) * nnb;
            for (int it = I.gw; it < items; it += I.NGW) { const int kb = it / nnb, nb = it % nnb; tr_item(W, (size_t)IN_WIDTH, D, kb * 64, win_src(nb * 64), win_src(nb * 64 + 32), WT, nb * 64, scr, I.lane); } }
        for (int i = 0; i < 3; ++i) tr_matrix(I, INP(8) + ((size_t)l * 3 + i) * BW * D, BW, D, (bf16*)(wl + OFF_WBR) + (size_t)i * D * BW, scr);
        tr_matrix(I, INP(9) + (size_t)l * D * D, D, D, (bf16*)(wl + OFF_WO), scr);
        tr_matrix(I, INP(12) + (size_t)l * D * 2 * FF, D, 2 * FF, (bf16*)(wl + OFF_WFI), scr);
        tr_matrix(I, INP(15) + (size_t)l * FF * D, FF, D, (bf16*)(wl + OFF_WFO), scr);
    }
    { const f32x4* x4 = (const f32x4*)INP(0); v4u* o = WSP(v4u, WS_XB); const size_t n8 = (size_t)M * D / 8, stride = (size_t)I.G * 512;
      for (size_t i = (size_t)blockIdx.x * 512 + I.tid; i < n8; i += stride) { const f32x4 a = x4[2 * i], b = x4[2 * i + 1]; v4u w; w.x = pk2(a[0], a[1]); w.y = pk2(a[2], a[3]); w.z = pk2(b[0], b[1]); w.w = pk2(b[2], b[3]); o[i] = w; } }
}

__device__ __forceinline__ void conv_mixer_phase(Frame& F, int layer) {
    const Ids I = phase_ids(F.wv);
    const bf16* HB = WSP(const bf16, WS_HB); bf16* YC = WSP(bf16, WS_YC); const float* wc = INP(3) + (size_t)layer * 3 * BW;
    const int c8 = (I.tid & 255) * 8, half = I.tid >> 8;
    float w[3][8];
#pragma unroll
    for (int i = 0; i < 3; ++i) { const f32x4 a = *(const f32x4*)(wc + i * BW + c8), b = *(const f32x4*)(wc + i * BW + c8 + 4);
        w[i][0] = a[0]; w[i][1] = a[1]; w[i][2] = a[2]; w[i][3] = a[3]; w[i][4] = b[0]; w[i][5] = b[1]; w[i][6] = b[2]; w[i][7] = b[3]; }
    for (int it = blockIdx.x; it < M / 2; it += I.G) {
        const int m = 2 * it + half, s = m & (SEQ - 1);
        const bf16* row = HB + (size_t)m * LDH + c8;
        float acc[8], cb[8], x[8], y[8];
        unpack8(*(const v4u*)(row + H_CC), x); unpack8(*(const v4u*)(row + H_CH), y);
#pragma unroll
        for (int e = 0; e < 8; ++e) acc[e] = w[1][e] * (x[e] * y[e]);
        if (s > 0) { unpack8(*(const v4u*)(row - LDH + H_CC), x); unpack8(*(const v4u*)(row - LDH + H_CH), y);
#pragma unroll
            for (int e = 0; e < 8; ++e) acc[e] += w[0][e] * (x[e] * y[e]); }
        if (s < SEQ - 1) { unpack8(*(const v4u*)(row + LDH + H_CC), x); unpack8(*(const v4u*)(row + LDH + H_CH), y);
#pragma unroll
            for (int e = 0; e < 8; ++e) acc[e] += w[2][e] * (x[e] * y[e]); }
        unpack8(*(const v4u*)(row + H_CB), cb);
#pragma unroll
        for (int e = 0; e < 8; ++e) acc[e] *= cb[e];
        *(v4u*)(YC + (size_t)m * BW + c8) = pack8(acc);
    }
}
__device__ __forceinline__ void ln_phase(Frame& F, const float* V, const float* g, const float* b, float* XF, bf16* XBo) {
    const Ids I = phase_ids(F.wv);
    for (int m = I.gw; m < M; m += I.NGW) {
        const f32x4* vr = (const f32x4*)(V + (size_t)m * D) + I.lane;
        f32x4 v[16]; float s = 0.f;
#pragma unroll
        for (int j = 0; j < 16; ++j) { v[j] = vr[64 * j]; s += (v[j][0] + v[j][1]) + (v[j][2] + v[j][3]); }
        const float mean = wave_sum(s) * (1.f / D); float s2 = 0.f;
#pragma unroll
        for (int j = 0; j < 16; ++j) { v[j] = v[j] - mean; s2 += (v[j][0] * v[j][0] + v[j][1] * v[j][1]) + (v[j][2] * v[j][2] + v[j][3] * v[j][3]); }
        const float rstd = 1.f / sqrtf(wave_sum(s2) * (1.f / D) + LN_EPS);
        f32x4* xo = (f32x4*)(XF + (size_t)m * D) + I.lane; v2u* bo = (v2u*)(XBo + (size_t)m * D) + I.lane;
#pragma unroll
        for (int j = 0; j < 16; ++j) { const f32x4 gg = ((const f32x4*)g)[I.lane + 64 * j], bb = ((const f32x4*)b)[I.lane + 64 * j];
            const f32x4 o = v[j] * rstd * gg + bb; xo[64 * j] = o; v2u w; w.x = pk2(o[0], o[1]); w.y = pk2(o[2], o[3]); bo[64 * j] = w; }
    }
}
__device__ __forceinline__ void convglu_phase(Frame& F, int layer) {
    const Ids I = phase_ids(F.wv);
    const bf16* AU = WSP(const bf16, WS_AU); bf16* G = WSP(bf16, WS_G);
    const float* wc = INP(13) + (size_t)layer * 3 * FF; const float* bc = INP(14) + (size_t)layer * FF;
    constexpr int J = FF / 8; const size_t total = (size_t)M * J, stride = (size_t)I.G * 512;
    for (size_t idx = (size_t)blockIdx.x * 512 + I.tid; idx < total; idx += stride) {
        const int m = (int)(idx / J), c8 = (int)(idx % J) * 8, s = m & (SEQ - 1);
        const bf16* row = AU + (size_t)m * (2 * FF) + c8;
        float a[8], acc[8], wv[8];
        { const f32x4 x = *(const f32x4*)(bc + c8), y = *(const f32x4*)(bc + c8 + 4); acc[0] = x[0]; acc[1] = x[1]; acc[2] = x[2]; acc[3] = x[3]; acc[4] = y[0]; acc[5] = y[1]; acc[6] = y[2]; acc[7] = y[3]; }
#define CG_TAP(i, ptr) { unpack8(*(const v4u*)(ptr), a); const f32x4 x = *(const f32x4*)(wc + (i) * FF + c8), y = *(const f32x4*)(wc + (i) * FF + c8 + 4); \
            wv[0] = x[0]; wv[1] = x[1]; wv[2] = x[2]; wv[3] = x[3]; wv[4] = y[0]; wv[5] = y[1]; wv[6] = y[2]; wv[7] = y[3]; _Pragma("unroll") for (int e = 0; e < 8; ++e) acc[e] += wv[e] * a[e]; }
        CG_TAP(1, row)
        if (s > 0) CG_TAP(0, row - 2 * FF)
        if (s < SEQ - 1) CG_TAP(2, row + 2 * FF)
#undef CG_TAP
        float u[8]; unpack8(*(const v4u*)(row + FF), u);
#pragma unroll
        for (int e = 0; e < 8; e += 2) { const pg8::f32x2 gl = pg8::gelu_pk((pg8::f32x2){acc[e], acc[e + 1]}); acc[e] = gl.x * u[e]; acc[e + 1] = gl.y * u[e + 1]; }
        *(v4u*)(G + (size_t)m * FF + c8) = pack8(acc);
    }
}
__device__ __forceinline__ void gla_combine_phase(Frame& F, int layer) {
    const Ids I = phase_ids(F.wv);
    const float* O0 = WSP(const float, WS_O); const float* O1 = O0 + (size_t)M * 2048; const bf16* HB = WSP(const bf16, WS_HB); bf16* YG = WSP(bf16, WS_YG);
    const float* ng = INP(7) + (size_t)layer * 2048;
    for (int idx = I.gw; idx < M * 4; idx += I.NGW) {
        const int m = idx >> 2, h = idx & 3; const size_t off = (size_t)m * 2048 + h * 512 + 8 * I.lane;
        const f32x4 a0 = *(const f32x4*)(O0 + off), a1 = *(const f32x4*)(O0 + off + 4), b0 = *(const f32x4*)(O1 + off), b1 = *(const f32x4*)(O1 + off + 4);
        float o[8] = {a0[0] + b0[0], a0[1] + b0[1], a0[2] + b0[2], a0[3] + b0[3], a1[0] + b1[0], a1[1] + b1[1], a1[2] + b1[2], a1[3] + b1[3]};
        float ss = 0.f;
#pragma unroll
        for (int e = 0; e < 8; ++e) ss += o[e] * o[e];
        const float rs = 1.f / sqrtf(wave_sum(ss) * (1.f / 512.f) + RMS_EPS);
        float r[8]; unpack8(*(const v4u*)(HB + (size_t)m * LDH + H_GR + h * 512 + 8 * I.lane), r);
        const f32x4 g0 = *(const f32x4*)(ng + h * 512 + 8 * I.lane), g1 = *(const f32x4*)(ng + h * 512 + 8 * I.lane + 4);
        const float gg[8] = {g0[0], g0[1], g0[2], g0[3], g1[0], g1[1], g1[2], g1[3]};
#pragma unroll
        for (int e = 0; e < 8; ++e) o[e] = o[e] * rs * gg[e] * (r[e] / (1.f + __expf(-r[e])));
        *(v4u*)(YG + off) = pack8(o);
    }
}

constexpr int NA_RPB_OFF = 15 * 8192;
__device__ __forceinline__ void na_phase(Frame& F, int layer) {
    const Ids I = phase_ids(F.wv);
    const bf16* HB = WSP(const bf16, WS_HB); const bf16* VT = WSP(const bf16, WS_VT); bf16* YN = WSP(bf16, WS_YN);
    const float* rpb = INP(4) + (size_t)layer * 16 * 465;
    LAS float* rpbs = (LAS float*)(F.lds + NA_RPB_OFF);
    const int fr = I.lane & 15, q4 = I.lane >> 4;
    const int sb_ = I.lane * 16, swz = sb_ ^ (((sb_ >> 9) & 1) << 5), rl = swz >> 6, cl = (swz & 63) >> 1;
    const int ob = fr * 64 + 16 * q4, lo = ob ^ (((ob >> 9) & 1) << 5);
    for (int it = blockIdx.x; it < 2048; it += I.G) {
        const int rblk = it & 7, cblk = (it >> 3) & 3, h = (it >> 5) & 15, b = it >> 9;
        const int r = rblk * 8 + I.wave, c0 = cblk * 16;
        const int krs = min(max(rblk * 8 - 4, 0), 49), rs = min(max(r - 4, 0), 56), cs = min(max(c0 - 8, 0), 32), koff = rs - krs;
        const int mq = b * SEQ + r * 64 + c0 + fr;
        asm volatile("s_waitcnt lgkmcnt(0)" ::: "memory"); __builtin_amdgcn_s_barrier(); asm volatile("" ::: "memory");
#pragma unroll
        for (int i = 0; i < 15; ++i) { const int q = I.wave * 15 + i, kr = q >> 3, pc = q & 7, slab = pc >> 2, j = pc & 3;
            const int key = pg8::perm32((j >> 1) * 16 + rl), col = slab * 64 + (j & 1) * 32 + cl;
            __builtin_amdgcn_global_load_lds((const GAS unsigned*)(HB + (size_t)(b * SEQ + (krs + kr) * 64 + cs + key) * LDH + H_NK + h * 128 + col), (LAS unsigned*)(F.lds + kr * 8192 + pc * 1024), 16, 0, 0); }
        for (int i = I.tid; i < 465; i += 512) rpbs[i] = rpb[h * 465 + i];
        const bf16* qp = HB + (size_t)mq * LDH + H_NQ + h * 128 + 8 * q4;
        bf16x8 qf[4];
#pragma unroll
        for (int s = 0; s < 4; ++s) qf[s] = *(const bf16x8*)(qp + 32 * s);
        asm volatile("s_waitcnt vmcnt(0) lgkmcnt(0)" ::: "memory"); __builtin_amdgcn_s_barrier(); asm volatile("" ::: "memory");
        const int cq = c0 + fr, ws = min(max(cq - 8, 0), 48);
        f32x4 sc[8][2];
        float mx = -1e30f;
#pragma unroll
        for (int sp = 0; sp < 8; ++sp)
#pragma unroll
            for (int u = 0; u < 2; ++u) {
                const LAS unsigned char* kb = F.lds + (koff + sp) * 8192 + lo;
                f32x4 d = (f32x4){0.f, 0.f, 0.f, 0.f};
#pragma unroll
                for (int s = 0; s < 4; ++s) d = mfma16(*(const LAS bf16x8*)(kb + (s >> 1) * 4096 + (2 * u + (s & 1)) * 1024), qf[s], d);
                const int brow = (rs + sp - r + 7) * 31;
#pragma unroll
                for (int j = 0; j < 4; ++j) { const int kc = cs + 8 * q4 + 4 * u + j; const bool valid = (kc >= ws) && (kc < ws + 16);
                    const int bi = min(max(kc - cq + 15, 0), 30);
                    const float v = valid ? d[j] * 0.08838834764831845f + rpbs[brow + bi] : -1e30f;
                    sc[sp][u][j] = v; mx = fmaxf(mx, v); }
            }
        mx = fmaxf(mx, __shfl_xor(mx, 16)); mx = fmaxf(mx, __shfl_xor(mx, 32));
        float sum = 0.f;
        bf16x8 pf[8];
#pragma unroll
        for (int sp = 0; sp < 8; ++sp) { float p[8];
#pragma unroll
            for (int u = 0; u < 2; ++u)
#pragma unroll
                for (int j = 0; j < 4; ++j) { const float e = __builtin_amdgcn_exp2f((sc[sp][u][j] - mx) * 1.44269504f); p[4 * u + j] = e; sum += e; }
            const v4u w = pack8(p); pf[sp] = __builtin_bit_cast(bf16x8, w); }
        sum += __shfl_xor(sum, 16); sum += __shfl_xor(sum, 32);
        const float inv = 1.f / sum;
        asm volatile("s_waitcnt lgkmcnt(0)" ::: "memory"); __builtin_amdgcn_s_barrier(); asm volatile("" ::: "memory");
#pragma unroll
        for (int i = 0; i < 15; ++i) { const int q = I.wave * 15 + i, kr = q >> 3, dt = q & 7;
            __builtin_amdgcn_global_load_lds((const GAS unsigned*)(VT + (size_t)(h * 128 + 16 * dt + rl) * M + b * SEQ + (krs + kr) * 64 + cs + cl), (LAS unsigned*)(F.lds + kr * 8192 + dt * 1024), 16, 0, 0); }
        asm volatile("s_waitcnt vmcnt(0)" ::: "memory"); __builtin_amdgcn_s_barrier(); asm volatile("" ::: "memory");
#pragma unroll
        for (int dt = 0; dt < 8; ++dt) { f32x4 o = (f32x4){0.f, 0.f, 0.f, 0.f};
#pragma unroll
            for (int sp = 0; sp < 8; ++sp) o = mfma16(*(const LAS bf16x8*)(F.lds + (koff + sp) * 8192 + dt * 1024 + lo), pf[sp], o);
            v2u w; w.x = pk2(o[0] * inv, o[1] * inv); w.y = pk2(o[2] * inv, o[3] * inv);
            *(v2u*)(YN + (size_t)mq * BW + h * 128 + 16 * dt + 4 * q4) = w; }
    }
}

__device__ __forceinline__ float logsigmoid16(float z) { const float e = __builtin_amdgcn_exp2f(-1.44269504f * fabsf(z)); return (fminf(z, 0.f) - 0.69314718f * __builtin_amdgcn_logf(1.0f + e)) * 0.0625f; }
__device__ __forceinline__ void gla_prep_phase(Frame& F, int layer) {
    const Ids I = phase_ids(F.wv);
    constexpr int RS = 264;
    LAS bf16* qs = (LAS bf16*)F.lds; LAS bf16* ks = qs + 2 * 64 * RS; LAS float* gas = (LAS float*)(ks + 2 * 64 * RS);
    const bf16* HB = WSP(const bf16, WS_HB); const float* GA = WSP(const float, WS_GA);
    bf16* QIN = WSP(bf16, WS_QIN); bf16* KOT = WSP(bf16, WS_KOT); bf16* ATT = WSP(bf16, WS_ATT); float* DEC = WSP(float, WS_DEC);
    const float* wdec = INP(5) + (size_t)layer * 2 * 16 * 1024; const float* bdec = INP(6) + (size_t)layer * 2 * 1024;
    const int dir = I.tid >> 8, c = I.tid & 255, fr = I.lane & 15, q4 = I.lane >> 4;
    for (int it = blockIdx.x; it < 1024; it += I.G) {
        const int h = it & 3, chunk = (it >> 2) & 63, b = it >> 8, m0 = b * SEQ + chunk * 64, ch = h * 256 + c;
        __syncthreads();
        ((LAS f32x4*)gas)[I.tid] = ((const f32x4*)(GA + (size_t)m0 * 32))[I.tid];
        float w[16];
#pragma unroll
        for (int r = 0; r < 16; ++r) w[r] = wdec[(dir * 16 + r) * 1024 + ch];
        const float bd = bdec[dir * 1024 + ch];
        __syncthreads();
        const LAS float* ga = gas + dir * 16;
        float pre[64]; float run = 0.f;
#pragma unroll
        for (int t = 0; t < 64; ++t) { float z = bd;
#pragma unroll
            for (int r = 0; r < 16; ++r) z += ga[t * 32 + r] * w[r];
            run += logsigmoid16(z); pre[t] = run; }
        const float tot = run, dec = __builtin_amdgcn_exp2f(tot * 1.44269504f);
        unsigned ko[32];
        const bf16* qg = HB + (size_t)m0 * LDH + H_GQ + ch; const bf16* kg = HB + (size_t)m0 * LDH + H_GK + ch;
        bf16* qo = QIN + ((size_t)dir * M + m0) * 1024 + ch;
#pragma unroll
        for (int tt = 0; tt < 32; ++tt) { float kov[2];
#pragma unroll
            for (int e = 0; e < 2; ++e) { const int t = 2 * tt + e;
                const float cum = dir == 0 ? pre[t] : tot - (t > 0 ? pre[t > 0 ? t - 1 : 0] : 0.f);
                const float e1 = __builtin_amdgcn_exp2f(cum * 1.44269504f), einv = __builtin_amdgcn_rcpf(e1);
                const float qv = bf1(qg[(size_t)t * LDH]), kv = bf1(kg[(size_t)t * LDH]);
                const float q_in = qv * 0.0625f * e1, k_in = kv * einv; kov[e] = k_in * dec;
                const unsigned qb = pk2(q_in, 0.f) & 0xffffu, kb = pk2(k_in, 0.f) & 0xffffu;
                qs[(dir * 64 + t) * RS + c] = (bf16)qb; ks[(dir * 64 + t) * RS + c] = (bf16)kb; qo[(size_t)t * 1024] = (bf16)qb; }
            ko[tt] = pk2(kov[0], kov[1]); }
        { v4u* kd = (v4u*)(KOT + ((size_t)dir * 1024 + ch) * M + m0);
#pragma unroll
            for (int i = 0; i < 8; ++i) { v4u w4; w4.x = ko[4 * i]; w4.y = ko[4 * i + 1]; w4.z = ko[4 * i + 2]; w4.w = ko[4 * i + 3]; kd[i] = w4; } }
        DEC[(((size_t)dir * 4 + b) * 64 + chunk) * 1024 + ch] = dec;
        __syncthreads();
        { const int adir = I.wave >> 2, mt = I.wave & 3, i = 16 * mt + fr;
          const LAS bf16* qrow = qs + (adir * 64 + i) * RS + 8 * q4;
          bf16* arow = ATT + (((((size_t)adir * 4 + b) * 4 + h) * 64 + chunk) * 64 + i) * 64;
#pragma unroll
          for (int nt = 0; nt < 4; ++nt) { const LAS bf16* krow = ks + (adir * 64 + 16 * nt + fr) * RS + 8 * q4;
              f32x4 d = (f32x4){0.f, 0.f, 0.f, 0.f};
#pragma unroll
              for (int s = 0; s < 8; ++s) d = mfma16(*(const LAS bf16x8*)(krow + 32 * s), *(const LAS bf16x8*)(qrow + 32 * s), d);
              const int j0 = 16 * nt + 4 * q4; float v[4];
#pragma unroll
              for (int jj = 0; jj < 4; ++jj) { const bool keep = adir == 0 ? (j0 + jj <= i) : (j0 + jj >= i); v[jj] = keep ? d[jj] : 0.f; }
              v2u w2; w2.x = pk2(v[0], v[1]); w2.y = pk2(v[2], v[3]); *(v2u*)(arow + j0) = w2; } }
    }
}
constexpr int SCAN_Q = 0, SCAN_K = 32768, SCAN_A = 65536, SCAN_D = 73728, SCAN_BUF = 74752;
__device__ __forceinline__ void scan_stage(const bf16* QIN, const bf16* KOT, const bf16* ATT, const float* DEC, LAS unsigned char* buf, int lw, int lane, int dir, int b, int h, int c) {
    const int m0 = b * SEQ + c * 64;
    const int sb_ = lane * 16, swz = sb_ ^ (((sb_ >> 9) & 1) << 5), rl = swz >> 6, cl = (swz & 63) >> 1;
#pragma unroll
    for (int i = 0; i < 8; ++i) { const int q = lw * 8 + i, sl = q >> 3, j = q & 7, R = (j >> 1) * 16 + rl, C = (j & 1) * 32 + cl;
        __builtin_amdgcn_global_load_lds((const GAS unsigned*)(QIN + ((size_t)dir * M + m0 + R) * 1024 + h * 256 + sl * 64 + C), (LAS unsigned*)(buf + SCAN_Q + sl * 8192 + j * 1024), 16, 0, 0); }
#pragma unroll
    for (int i = 0; i < 8; ++i) { const int k = lw * 8 + i, hh = k >> 4, j = k & 15, Rg = 128 * hh + (j >> 1) * 16 + rl, C = (j & 1) * 32 + cl, Rb = (Rg & ~31) + pg8::perm32(Rg & 31);
        __builtin_amdgcn_global_load_lds((const GAS unsigned*)(KOT + ((size_t)dir * 1024 + h * 256 + Rb) * M + m0 + C), (LAS unsigned*)(buf + SCAN_K + hh * 16384 + j * 1024), 16, 0, 0); }
    const bf16* ab = ATT + ((((size_t)dir * 4 + b) * 4 + h) * 64 + c) * 4096;
#pragma unroll
    for (int i = 0; i < 2; ++i) { const int j = lw * 2 + i, R = (j >> 1) * 16 + rl, C = (j & 1) * 32 + cl;
        __builtin_amdgcn_global_load_lds((const GAS unsigned*)(ab + R * 64 + C), (LAS unsigned*)(buf + SCAN_A + j * 1024), 16, 0, 0); }
    if (lw == 0) __builtin_amdgcn_global_load_lds((const GAS unsigned*)(DEC + (((size_t)dir * 4 + b) * 64 + c) * 1024 + h * 256 + lane * 4), (LAS unsigned*)(buf + SCAN_D), 16, 0, 0);
}
__device__ __forceinline__ void gla_scan_phase(Frame& F) {
    const Ids I = phase_ids(F.wv);
    const bf16* VT = WSP(const bf16, WS_VT); const bf16* QIN = WSP(const bf16, WS_QIN); const bf16* KOT = WSP(const bf16, WS_KOT); const bf16* ATT = WSP(const bf16, WS_ATT);
    const float* DEC = WSP(const float, WS_DEC); float* O = WSP(float, WS_O);
    const int fr = I.lane & 15, q4 = I.lane >> 4;
    for (int bt = blockIdx.x; bt < 256; bt += I.G) {
        const int x = bt & 7, y = bt >> 3, sc = x * 4 + (y >> 3), eq = y & 7;
        const int dir = sc & 1, h = (sc >> 1) & 3, b = sc >> 3;
        asm volatile("s_waitcnt vmcnt(0) lgkmcnt(0)" ::: "memory"); __builtin_amdgcn_s_barrier(); asm volatile("" ::: "memory");
        if (I.wave >= 4) {
            const int lw = I.wave - 4;
            scan_stage(QIN, KOT, ATT, DEC, F.lds, lw, I.lane, dir, b, h, dir ? 63 : 0);
            asm volatile("s_waitcnt vmcnt(0)" ::: "memory"); __builtin_amdgcn_s_barrier(); asm volatile("" ::: "memory");
            for (int step = 0; step < 64; ++step) {
                if (step + 1 < 64) scan_stage(QIN, KOT, ATT, DEC, F.lds + ((step + 1) & 1) * SCAN_BUF, lw, I.lane, dir, b, h, dir ? 62 - step : step + 1);
                asm volatile("s_waitcnt vmcnt(0)" ::: "memory"); __builtin_amdgcn_s_barrier(); asm volatile("" ::: "memory");
            }
        } else {
            const int es = eq * 4 + I.wave;
            f32x4 st[16];
#pragma unroll
            for (int t = 0; t < 16; ++t) st[t] = (f32x4){0.f, 0.f, 0.f, 0.f};
            const bf16* vrow = VT + (size_t)(2048 + h * 512 + es * 16 + fr) * M + b * SEQ + 8 * q4;
            const int ob = fr * 64 + 16 * q4, lo = ob ^ (((ob >> 9) & 1) << 5);
            bf16x8 vf[2];
            { const int c0 = dir ? 63 : 0;
#pragma unroll
              for (int sp = 0; sp < 2; ++sp) vf[sp] = *(const bf16x8*)(vrow + c0 * 64 + 32 * sp); }
            asm volatile("" ::: "memory"); __builtin_amdgcn_s_barrier(); asm volatile("" ::: "memory");
            for (int step = 0; step < 64; ++step) {
                const int c = dir ? 63 - step : step, m0 = b * SEQ + c * 64;
                const LAS unsigned char* bb = F.lds + (step & 1) * SCAN_BUF + lo;
                bf16x8 vn[2];
                { const int cn = step + 1 < 64 ? (dir ? 62 - step : step + 1) : c;
#pragma unroll
                  for (int sp = 0; sp < 2; ++sp) vn[sp] = *(const bf16x8*)(vrow + cn * 64 + 32 * sp); }
                bf16x8 sb[8];
#pragma unroll
                for (int s = 0; s < 8; ++s) { v4u w; w.x = pk2(st[2 * s][0], st[2 * s][1]); w.y = pk2(st[2 * s][2], st[2 * s][3]); w.z = pk2(st[2 * s + 1][0], st[2 * s + 1][1]); w.w = pk2(st[2 * s + 1][2], st[2 * s + 1][3]); sb[s] = __builtin_bit_cast(bf16x8, w); }
#pragma unroll
                for (int mt = 0; mt < 4; ++mt) { f32x4 o = (f32x4){0.f, 0.f, 0.f, 0.f};
#pragma unroll
                    for (int s = 0; s < 8; ++s) o = mfma16(sb[s], *(const LAS bf16x8*)(bb + SCAN_Q + (s >> 1) * 8192 + (2 * mt + (s & 1)) * 1024), o);
#pragma unroll
                    for (int sp = 0; sp < 2; ++sp) o = mfma16(vf[sp], *(const LAS bf16x8*)(bb + SCAN_A + (2 * mt + sp) * 1024), o);
                    *(f32x4*)(O + ((size_t)dir * M + m0 + 16 * mt + fr) * 2048 + h * 512 + es * 16 + 4 * q4) = o; }
                const LAS unsigned char* dbase = F.lds + (step & 1) * SCAN_BUF + SCAN_D + 32 * q4;
#pragma unroll
                for (int s = 0; s < 8; ++s)
#pragma unroll
                    for (int u = 0; u < 2; ++u) { const int t = 2 * s + u;
                        const f32x4 dc = *(const LAS f32x4*)(dbase + (32 * s + 4 * u) * 4);
                        f32x4 a = st[t] * dc;
#pragma unroll
                        for (int sp = 0; sp < 2; ++sp) a = mfma16(*(const LAS bf16x8*)(bb + SCAN_K + (s >> 2) * 16384 + ((2 * (s & 3) + u) * 2 + sp) * 1024), vf[sp], a);
                        st[t] = a; }
                vf[0] = vn[0]; vf[1] = vn[1];
                asm volatile("s_waitcnt lgkmcnt(0)" ::: "memory"); __builtin_amdgcn_s_barrier(); asm volatile("" ::: "memory");
            }
        }
    }
}


#ifndef PHM
#define PHM 0xffff
#endif
#ifndef REPM
#define REPM 0
#endif
#define RP(bit) for (int rep_ = 0; rep_ < ((REPM & (bit)) ? 2 : 1); ++rep_)
__global__ void __launch_bounds__(NWAVES * 64, 2) enc_fwd(Args args) {
    extern __shared__ __attribute__((aligned(16))) unsigned char lds[];
    Frame F;
    F.lds = (LAS unsigned char*)lds; F.wv = __builtin_amdgcn_readfirstlane(threadIdx.x >> 6);
    volatile LAS unsigned* MISC = (volatile LAS unsigned*)(F.lds + MISC_OFF);
    if (threadIdx.x < 128) MISC[threadIdx.x] = 0u;
    __syncthreads();
    (void)xcd_barrier_post((unsigned*)(GAS unsigned*)(args.ws + WS_CTL) + CW_BAR, MISC + 8);
#if MK_MULTI
#define IN(k) (kargs()->ph_lo <= (k) && (k) < kargs()->ph_hi)
#else
#define IN(k) true
#endif
#define SEAM(k) do { if (IN((k) + 1)) { XcdBarrier bb; bb.wv = (unsigned)F.wv; bb.bar = (unsigned*)(GAS unsigned*)(kargs()->ws + WS_CTL) + CW_BAR; bb.x = (unsigned)__builtin_amdgcn_readfirstlane((int)xb_xcc_id()); bb.st = (volatile LAS unsigned*)(F.lds + MISC_OFF) + 8; xcd_barrier(bb); } } while (0)
    LAS unsigned char* ring = F.lds;

    if (IN(0)) { RP(1) p0_prologue(F); SEAM(0); }

    for (int layer = 0; layer < DEPTH; ++layer) {
        const int pb = 1 + 11 * layer;
#define WL ((unsigned char*)(kargs()->ws + WS_W + (size_t)layer * SZ_WL))

        const pg8::bf16_t* XB = WSP(const pg8::bf16_t, WS_XB);
        if (IN(pb + 0)) { RP(2) {
            { pg8::Gemm g{XB, (const pg8::bf16_t*)(WL + OFF_WIN), M, NIN_MAIN, D}; pg8::StaticOrder S; S.init(M, NIN_MAIN, (int)gridDim.x, (int)blockIdx.x);
              pg8::EpiIn E{WSP(pg8::bf16_t, WS_HB), LDH, WSP(float, WS_GA), WSP(pg8::bf16_t, WS_GATES), INP(2) + (size_t)layer * 3 * D};
              pg8::gemm_phase<pg8::EpiIn, pg8::StaticOrder, true, true>(ring, g, S, E, F.wv); }
            { pg8::Gemm g{(const pg8::bf16_t*)(WL + OFF_WIN) + (size_t)NIN_MAIN * D, XB, 4096, M, D}; pg8::StaticOrder S; S.init(4096, M, (int)gridDim.x, (int)blockIdx.x);
              pg8::EpiBf16 E{WSP(pg8::bf16_t, WS_VT), M};
              pg8::gemm_phase<pg8::EpiBf16, pg8::StaticOrder, true, true>(ring, g, S, E, F.wv); } }
            SEAM(pb + 0);
        }
        if (IN(pb + 1)) { RP(4) conv_mixer_phase(F, layer); RP(8) gla_prep_phase(F, layer); RP(16) na_phase(F, layer); SEAM(pb + 1); }
        if (IN(pb + 2)) { RP(32) gla_scan_phase(F); SEAM(pb + 2); }
        if (IN(pb + 3)) { RP(64) gla_combine_phase(F, layer); SEAM(pb + 3); }
        if (IN(pb + 4)) { RP(128) {
            pg8::StaticOrder S; S.init(M, D, (int)gridDim.x, (int)blockIdx.x);
            { pg8::Gemm g{WSP(const pg8::bf16_t, WS_YC), (const pg8::bf16_t*)(WL + OFF_WBR), M, D, BW};
              pg8::EpiBranch<0> E{WSP(pg8::bf16_t, WS_MIXED), WSP(const pg8::bf16_t, WS_GATES)}; pg8::gemm_phase<pg8::EpiBranch<0>, pg8::StaticOrder, true, true>(ring, g, S, E, F.wv); }
            { pg8::Gemm g{WSP(const pg8::bf16_t, WS_YN), (const pg8::bf16_t*)(WL + OFF_WBR) + (size_t)D * BW, M, D, BW};
              pg8::EpiBranch<1> E{WSP(pg8::bf16_t, WS_MIXED), WSP(const pg8::bf16_t, WS_GATES)}; pg8::gemm_phase<pg8::EpiBranch<1>, pg8::StaticOrder, true, true>(ring, g, S, E, F.wv); }
            { pg8::Gemm g{WSP(const pg8::bf16_t, WS_YG), (const pg8::bf16_t*)(WL + OFF_WBR) + (size_t)2 * D * BW, M, D, BW};
              pg8::EpiBranch<2> E{WSP(pg8::bf16_t, WS_MIXED), WSP(const pg8::bf16_t, WS_GATES)}; pg8::gemm_phase<pg8::EpiBranch<2>, pg8::StaticOrder, true, true>(ring, g, S, E, F.wv); } }
            SEAM(pb + 4);
        }
        const float* xres = layer == 0 ? INP(0) : WSP(const float, WS_XR);
        if (IN(pb + 5)) { {
            pg8::Gemm g{WSP(const pg8::bf16_t, WS_MIXED), (const pg8::bf16_t*)(WL + OFF_WO), M, D, D}; pg8::StaticOrder S; S.init(M, D, (int)gridDim.x, (int)blockIdx.x);
            pg8::EpiResid E{WSP(float, WS_XR), xres, D, ALPHA}; pg8::gemm_phase<pg8::EpiResid, pg8::StaticOrder, true, true>(ring, g, S, E, F.wv); }
            SEAM(pb + 5);
        }
        if (IN(pb + 6)) { ln_phase(F, WSP(const float, WS_XR), INP(10) + (size_t)layer * D, INP(11) + (size_t)layer * D, WSP(float, WS_XR), WSP(bf16, WS_XB)); SEAM(pb + 6); }
        if (IN(pb + 7)) { RP(1024) {
            pg8::Gemm g{XB, (const pg8::bf16_t*)(WL + OFF_WFI), M, 2 * FF, D}; pg8::StaticOrder S; S.init(M, 2 * FF, (int)gridDim.x, (int)blockIdx.x);
            pg8::EpiBf16 E{WSP(pg8::bf16_t, WS_AU), 2 * FF}; pg8::gemm_phase<pg8::EpiBf16, pg8::StaticOrder, true, true>(ring, g, S, E, F.wv); }
            SEAM(pb + 7);
        }
        if (IN(pb + 8)) { RP(2048) convglu_phase(F, layer); SEAM(pb + 8); }
        if (IN(pb + 9)) { {
            pg8::Gemm g{WSP(const pg8::bf16_t, WS_G), (const pg8::bf16_t*)(WL + OFF_WFO), M, D, FF}; pg8::StaticOrder S; S.init(M, D, (int)gridDim.x, (int)blockIdx.x);
            pg8::EpiResid E{WSP(float, WS_XR), WSP(const float, WS_XR), D, ALPHA}; pg8::gemm_phase<pg8::EpiResid, pg8::StaticOrder, true, true>(ring, g, S, E, F.wv); }
            SEAM(pb + 9);
        }
        if (IN(pb + 10)) { ln_phase(F, WSP(const float, WS_XR), INP(16) + (size_t)layer * D, INP(17) + (size_t)layer * D, layer == DEPTH - 1 ? OUTP : WSP(float, WS_XR), WSP(bf16, WS_XB)); SEAM(pb + 10); }
    }
#undef IN
#undef SEAM
}

extern "C" void kernel_launch(void* const* d_in, const int* in_sizes, int n_in, void* d_out, int out_size, void* d_ws, size_t ws_size, hipStream_t stream) {
    static int grid = 0;
    if (grid == 0) {
        if (n_in != 18 || in_sizes[0] != M * D || out_size != M * D || ws_size < WS_END) { fprintf(stderr, "kernel_launch: unexpected sizes: n_in %d in0 %d out %d ws %zu (need %zu); nothing launched\n", n_in, n_in > 0 ? in_sizes[0] : -1, out_size, ws_size, (size_t)WS_END); grid = -1; return; }
        int dev = 0, cus = 0, per_cu = 0;
        if (hipGetDevice(&dev) != hipSuccess || hipDeviceGetAttribute(&cus, hipDeviceAttributeMultiprocessorCount, dev) != hipSuccess) { grid = -1; return; }
        if (hipFuncSetAttribute((const void*)enc_fwd, hipFuncAttributeMaxDynamicSharedMemorySize, LDS_BYTES) != hipSuccess) { fprintf(stderr, "kernel_launch: hipFuncSetAttribute failed\n"); grid = -1; return; }
        if (hipOccupancyMaxActiveBlocksPerMultiprocessor(&per_cu, (const void*)enc_fwd, NWAVES * 64, LDS_BYTES) != hipSuccess || per_cu < 1) { fprintf(stderr, "kernel_launch: occupancy query reports %d workgroups per CU\n", per_cu); grid = -1; (void)hipGetLastError(); return; }
        (void)hipGetLastError();
        grid = cus;
    }
    if (grid < 0) return;
    if (hipMemsetAsync((char*)d_ws + WS_CTL, 0, CTL_ZERO_BYTES, stream) != hipSuccess) return;
    Args a{};
    for (int i = 0; i < 18; ++i) a.in[i] = (GAS const float*)d_in[i];
    a.out = (GAS float*)d_out; a.ws = (GAS unsigned char*)d_ws;
#if MK_MULTI
    for (int p = 0; p < N_PHASES; ++p) { a.ph_lo = p; a.ph_hi = p + 1; hipLaunchKernelGGL(enc_fwd, dim3(grid), dim3(NWAVES * 64), LDS_BYTES, stream, a); }
#else
    a.ph_lo = 0; a.ph_hi = N_PHASES;
    hipLaunchKernelGGL(enc_fwd, dim3(grid), dim3(NWAVES * 64), LDS_BYTES, stream, a);
#endif
}
```

```cpp
#include <hip/hip_runtime.h>
#include <cstdio>
#include <cstdint>
#ifndef GAS
#define GAS __attribute__((address_space(1)))
#endif
struct Args { GAS const float* in[18]; GAS float* out; GAS unsigned char* ws; int ph_lo, ph_hi; };
typedef __attribute__((address_space(4))) const Args CArgs;
__device__ __forceinline__ CArgs* kargs() { CArgs* p = (CArgs*)__builtin_amdgcn_kernarg_segment_ptr(); asm volatile("" : "+s"(p)); return p; }
#define INP(i) ((const float*)kargs()->in[i])
#define OUTP ((float*)kargs()->out)

namespace pg8 {
#define PG8_LAS __attribute__((address_space(3)))
typedef unsigned short bf16_t;
typedef short bf16x8 __attribute__((ext_vector_type(8)));
typedef float f32x4 __attribute__((ext_vector_type(4)));
typedef unsigned u32x4 __attribute__((ext_vector_type(4)));
constexpr int BM = 256, BK = 64, HALF = 128, HTB = HALF * BK * 2  , STAGE_BYTES = 8 * HTB, NXCD = 8, WGM = 8;

__host__ __device__ __forceinline__ int lds_byte(int r, int c) { const int st = (r >> 4) * 2 + (c >> 5), rr = r & 15, cc = c & 31, ob = rr * 64 + cc * 2; return st * 1024 + (ob ^ (((ob >> 9) & 1) << 5)); }
__host__ __device__ __forceinline__ void stage_rc(int b, int& R, int& C) { const int st = b / 1024, sb = b % 1024, swz = sb ^ (((sb >> 9) & 1) << 5); R = (st >> 1) * 16 + swz / 64; C = (st & 1) * 32 + (swz % 64) / 2; }
__host__ __device__ __forceinline__ int perm32(int rho) { const int n = rho >> 4, i = rho & 15; return 8 * (i >> 2) + 4 * n + (i & 3); }

#ifndef PG8_ROT
#define PG8_ROT 0
#endif
struct Unit { int pm, pn; };
struct Gemm { const bf16_t* A; const bf16_t* Bt; int M, N, K; };

struct StaticOrder {
    int nM, nN, nwg, G, c;
    __host__ __device__ void init(int M, int N, int G_, int c_) { nM = M / BM; nN = N / BM; nwg = nM * nN; G = G_; c = c_; }
    __host__ __device__ bool next(int i, Unit& u) const {
        const long L = (long)i * G + c; if (L >= nwg) return false;
        int wgid = (int)L; { const int q = nwg / NXCD, r = nwg % NXCD, xcd = wgid % NXCD, off = wgid / NXCD; wgid = (xcd < r ? xcd * (q + 1) : r * (q + 1) + (xcd - r) * q) + off; }
        const int nig = WGM * nN, gid = wgid / nig, fm = gid * WGM, gsz = (nM - fm) < WGM ? (nM - fm) : WGM;
        u.pm = fm + ((wgid % nig) % gsz); u.pn = (wgid % nig) / gsz;
        if (PG8_ROT) { const int step = nN / NXCD > 0 ? nN / NXCD : 1; u.pn = (u.pn + step * gid) % nN; }
        return true;
    }
    __device__ __forceinline__ void a_ready(const Unit&) const {}
    __device__ __forceinline__ void done(const Unit&) const {}
};

__device__ __forceinline__ unsigned cvt_pk_bf16(float lo, float hi) { unsigned r; asm volatile("s_nop 1\n\tv_cvt_pk_bf16_f32 %0, %1, %2" : "=v"(r) : "v"(lo), "v"(hi)); return r; }
typedef float f32x2 __attribute__((ext_vector_type(2)));
__device__ __forceinline__ f32x2 gelu_pk(f32x2 v) {
    const f32x2 av = __builtin_elementwise_abs(v), d = av * 0.2316418882f + 1.0f;
    f32x2 t; t.x = __builtin_amdgcn_rcpf(d.x); t.y = __builtin_amdgcn_rcpf(d.y);
    f32x2 q = t * 0.5307027145f + (-0.7265760135f); q = q * t + 0.7107068705f; q = q * t + (-0.142248368f); q = q * t + 0.127414796f; q = q * t;
    const f32x2 s = (v * v) * (-0.72134752044f);
    f32x2 e; e.x = __builtin_amdgcn_exp2f(s.x); e.y = __builtin_amdgcn_exp2f(s.y);
    const f32x2 m = v * (q * e), r = v - m;
    f32x2 o; o.x = v.x < 0.f ? m.x : r.x; o.y = v.y < 0.f ? m.y : r.y; return o;
}

__device__ __forceinline__ float bf_lo(unsigned w) { return __uint_as_float(w << 16); }
__device__ __forceinline__ float bf_hi(unsigned w) { return __uint_as_float(w & 0xffff0000u); }
__device__ __forceinline__ float sigmoidf_fast(float v) { return __builtin_amdgcn_rcpf(1.0f + __builtin_amdgcn_exp2f(-1.44269504f * v)); }

template <bool NT = false> struct EpiBf16T {
    static constexpr bool PERM = true, AFTER_DRAIN = false;
    bf16_t* O; int ldc; float sc;
    __device__ __forceinline__ void operator()(const f32x4 (&acc)[2][2][4][2], const Unit& u, int wr, int wc, int fr, int fq) const {
        asm volatile("" : "+v"(fr), "+v"(fq));
        const int row0 = u.pm * BM + wr * 64 + fr, col0 = u.pn * BM + wc * 32 + 8 * fq;
#pragma unroll
        for (int ai = 0; ai < 2; ++ai)
#pragma unroll
            for (int m = 0; m < 4; ++m) { bf16_t* rowp = O + (size_t)(row0 + ai * HALF + m * 16) * ldc + col0;
#pragma unroll
                for (int bj = 0; bj < 2; ++bj) { const f32x4 v0 = acc[ai][bj][m][0] * sc, v1 = acc[ai][bj][m][1] * sc;
                    u32x4 w; w.x = cvt_pk_bf16(v0[0], v0[1]); w.y = cvt_pk_bf16(v0[2], v0[3]); w.z = cvt_pk_bf16(v1[0], v1[1]); w.w = cvt_pk_bf16(v1[2], v1[3]);
                    if (NT) __builtin_nontemporal_store(w, (u32x4*)(rowp + bj * HALF)); else *(u32x4*)(rowp + bj * HALF) = w; } }
    }
};
typedef EpiBf16T<false> EpiBf16;
struct EpiIn {
    static constexpr bool PERM = true, AFTER_DRAIN = false;
    bf16_t* HB; int ldh;
    __device__ __forceinline__ void operator()(const f32x4 (&acc)[2][2][4][2], const Unit& u, int wr, int wc, int fr, int fq) const {
        asm volatile("" : "+v"(fr), "+v"(fq));
        const int row0 = u.pm * BM + wr * 64 + fr;
        const int colt = u.pn < 24 ? u.pn * BM : (u.pn < 32 ? 10240 + (u.pn - 24) * BM : 12288 + (u.pn - 32) * BM);
        const int col0 = colt + wc * 32 + 8 * fq;
#pragma unroll
        for (int ai = 0; ai < 2; ++ai)
#pragma unroll
            for (int m = 0; m < 4; ++m) { bf16_t* rowp = HB + (size_t)(row0 + ai * HALF + m * 16) * ldh + col0;
#pragma unroll
                for (int bj = 0; bj < 2; ++bj) { const f32x4 v0 = acc[ai][bj][m][0], v1 = acc[ai][bj][m][1];
                    u32x4 w; w.x = cvt_pk_bf16(v0[0], v0[1]); w.y = cvt_pk_bf16(v0[2], v0[3]); w.z = cvt_pk_bf16(v1[0], v1[1]); w.w = cvt_pk_bf16(v1[2], v1[3]);
                    *(u32x4*)(rowp + bj * HALF) = w; } }
    }
};
struct EpiF8 {
    static constexpr bool PERM = true, AFTER_DRAIN = false;
    bf16_t* HB; int ldh; bf16_t* GATES; const float* bgate; float sc;
    __device__ __forceinline__ void operator()(const f32x4 (&acc)[2][2][4][2], const Unit& u, int wr, int wc, int fr, int fq) const {
        asm volatile("" : "+v"(fr), "+v"(fq));
        const int row0 = u.pm * BM + wr * 64 + fr;
        if (u.pn < 16) {
            const int col0 = 6144 + u.pn * BM + wc * 32 + 8 * fq;
#pragma unroll
            for (int ai = 0; ai < 2; ++ai)
#pragma unroll
                for (int m = 0; m < 4; ++m) { bf16_t* rowp = HB + (size_t)(row0 + ai * HALF + m * 16) * ldh + col0;
#pragma unroll
                    for (int bj = 0; bj < 2; ++bj) { const f32x4 v0 = acc[ai][bj][m][0] * sc, v1 = acc[ai][bj][m][1] * sc;
                        u32x4 w; w.x = cvt_pk_bf16(v0[0], v0[1]); w.y = cvt_pk_bf16(v0[2], v0[3]); w.z = cvt_pk_bf16(v1[0], v1[1]); w.w = cvt_pk_bf16(v1[2], v1[3]);
                        *(u32x4*)(rowp + bj * HALF) = w; } }
        } else {
            const int col0 = (u.pn - 16) * BM + wc * 32 + 8 * fq;
            f32x4 bv[2][2];
#pragma unroll
            for (int bj = 0; bj < 2; ++bj)
#pragma unroll
                for (int n = 0; n < 2; ++n) bv[bj][n] = *(const f32x4*)(bgate + col0 + bj * HALF + 4 * n);
#pragma unroll
            for (int ai = 0; ai < 2; ++ai)
#pragma unroll
                for (int m = 0; m < 4; ++m) { bf16_t* rowp = GATES + (size_t)(row0 + ai * HALF + m * 16) * 12288 + col0;
#pragma unroll
                    for (int bj = 0; bj < 2; ++bj) { const f32x4 v0 = acc[ai][bj][m][0] * sc + bv[bj][0], v1 = acc[ai][bj][m][1] * sc + bv[bj][1];
                        u32x4 w; w.x = cvt_pk_bf16(sigmoidf_fast(v0[0]), sigmoidf_fast(v0[1])); w.y = cvt_pk_bf16(sigmoidf_fast(v0[2]), sigmoidf_fast(v0[3]));
                        w.z = cvt_pk_bf16(sigmoidf_fast(v1[0]), sigmoidf_fast(v1[1])); w.w = cvt_pk_bf16(sigmoidf_fast(v1[2]), sigmoidf_fast(v1[3]));
                        *(u32x4*)(rowp + bj * HALF) = w; } }
        }
    }
};
struct EpiGates {
    static constexpr bool PERM = true, AFTER_DRAIN = false;
    bf16_t* GATES; const float* bgate; float sc;
    __device__ __forceinline__ void operator()(const f32x4 (&acc)[2][2][4][2], const Unit& u, int wr, int wc, int fr, int fq) const {
        asm volatile("" : "+v"(fr), "+v"(fq));
        const int row0 = u.pm * BM + wr * 64 + fr, col0 = u.pn * BM + wc * 32 + 8 * fq;
#pragma unroll
        for (int ai = 0; ai < 2; ++ai)
#pragma unroll
            for (int m = 0; m < 4; ++m) { bf16_t* rowp = GATES + (size_t)(row0 + ai * HALF + m * 16) * 12288 + col0;
                asm volatile("" ::: "memory");
#pragma unroll
                for (int bj = 0; bj < 2; ++bj) { const f32x4 v0 = acc[ai][bj][m][0] * sc + *(const f32x4*)(bgate + col0 + bj * HALF), v1 = acc[ai][bj][m][1] * sc + *(const f32x4*)(bgate + col0 + bj * HALF + 4);
                    u32x4 w; w.x = cvt_pk_bf16(sigmoidf_fast(v0[0]), sigmoidf_fast(v0[1])); w.y = cvt_pk_bf16(sigmoidf_fast(v0[2]), sigmoidf_fast(v0[3]));
                    w.z = cvt_pk_bf16(sigmoidf_fast(v1[0]), sigmoidf_fast(v1[1])); w.w = cvt_pk_bf16(sigmoidf_fast(v1[2]), sigmoidf_fast(v1[3]));
                    *(u32x4*)(rowp + bj * HALF) = w; } }
    }
};
template <int I> struct EpiBranch {
    static constexpr bool PERM = true, AFTER_DRAIN = false;
    bf16_t* MIXED; const bf16_t* GATES; float sc;
    __device__ __forceinline__ void operator()(const f32x4 (&acc)[2][2][4][2], const Unit& u, int wr, int wc, int fr, int fq) const {
        asm volatile("" : "+v"(fr), "+v"(fq));
        const int row0 = u.pm * BM + wr * 64 + fr, col0 = u.pn * BM + wc * 32 + 8 * fq;
#pragma unroll
        for (int ai = 0; ai < 2; ++ai)
#pragma unroll
            for (int m = 0; m < 4; ++m) { const size_t r = (size_t)(row0 + ai * HALF + m * 16);
                if (m == 0) asm volatile("" ::: "memory");
#pragma unroll
                for (int bj = 0; bj < 2; ++bj) {
                    const u32x4 g = *(const u32x4*)(GATES + r * 12288 + I * 4096 + col0 + bj * HALF);
                    bf16_t* mp = MIXED + r * 4096 + col0 + bj * HALF;
                    u32x4 p = (u32x4){0u, 0u, 0u, 0u}; if (I) p = *(const u32x4*)mp;
                    const f32x4 a0 = acc[ai][bj][m][0] * sc, a1 = acc[ai][bj][m][1] * sc;
                    u32x4 w;
                    w.x = cvt_pk_bf16(bf_lo(p.x) + bf_lo(g.x) * a0[0], bf_hi(p.x) + bf_hi(g.x) * a0[1]);
                    w.y = cvt_pk_bf16(bf_lo(p.y) + bf_lo(g.y) * a0[2], bf_hi(p.y) + bf_hi(g.y) * a0[3]);
                    w.z = cvt_pk_bf16(bf_lo(p.z) + bf_lo(g.z) * a1[0], bf_hi(p.z) + bf_hi(g.z) * a1[1]);
                    w.w = cvt_pk_bf16(bf_lo(p.w) + bf_lo(g.w) * a1[2], bf_hi(p.w) + bf_hi(g.w) * a1[3]);
                    *(u32x4*)mp = w; } }
    }
};
template <bool NORM> struct EpiResid {
    static constexpr bool PERM = false, AFTER_DRAIN = false;
    float* V; const float* xres; int ldc; float alpha; int gi, bi; unsigned goff; unsigned long long st_off;
    __device__ __forceinline__ void operator()(const f32x4 (&acc)[2][2][4][2], const Unit& u, int wr, int wc, int fr, int fq) const {
        asm volatile("" : "+v"(fr), "+v"(fq));
        const int row0 = u.pm * BM + wr * 64 + fr, col0 = u.pn * BM + wc * 32 + 4 * fq;
        const float* g = nullptr; const float* b = nullptr; const float* st = nullptr;
        if (NORM) { g = (const float*)kargs()->in[gi] + goff; b = (const float*)kargs()->in[bi] + goff; st = (const float*)(GAS const float*)(kargs()->ws + st_off); }
#pragma unroll
        for (int ai = 0; ai < 2; ++ai)
#pragma unroll
            for (int m = 0; m < 4; ++m) { const int r = row0 + ai * HALF + m * 16; const size_t off = (size_t)r * ldc + col0;
                if ((m & 1) == 0) asm volatile("" ::: "memory");
                float mu = 0.f, rs = 1.f; if (NORM) { const f32x2 s2 = *(const f32x2*)(st + 2 * (size_t)r); mu = s2.x; rs = s2.y; }
#pragma unroll
                for (int bj = 0; bj < 2; ++bj)
#pragma unroll
                    for (int n = 0; n < 2; ++n) { f32x4 xr = *(const f32x4*)(xres + off + bj * HALF + n * 16);
                        if (NORM) xr = (xr - mu) * rs * *(const f32x4*)(g + col0 + bj * HALF + n * 16) + *(const f32x4*)(b + col0 + bj * HALF + n * 16);
                        *(f32x4*)(V + off + bj * HALF + n * 16) = xr * alpha + acc[ai][bj][m][n]; } }
    }
};

typedef int pg8_v4i __attribute__((ext_vector_type(4)));
typedef int pg8_v8i __attribute__((ext_vector_type(8)));
__device__ __forceinline__ pg8_v8i pg8_cat(bf16x8 lo, bf16x8 hi) { return __builtin_shufflevector(__builtin_bit_cast(pg8_v4i, lo), __builtin_bit_cast(pg8_v4i, hi), 0, 1, 2, 3, 4, 5, 6, 7); }
template <class Epi, class Sched, bool ALIGN_EPI = false, bool SP2 = false, bool FP8 = false>
__device__ __forceinline__ void gemm_phase(PG8_LAS unsigned char* lds, const Gemm g, const Sched& S, const Epi& E, const int wv  ) {
    int tid_; asm volatile("v_mbcnt_lo_u32_b32 %0, -1, 0\n\tv_mbcnt_hi_u32_b32 %0, -1, %0" : "=v"(tid_)); tid_ += wv * 64; asm volatile("" : "+v"(tid_));
    const int tid = tid_, wid = __builtin_amdgcn_readfirstlane(tid >> 6), lane = tid & 63, wr = wid >> 2, wc = wid & 3, fr = lane & 15, fq = lane >> 4;
    const int K = g.K, nt = K / BK;
    unsigned voffA[2], voffB[2];
#pragma unroll
    for (int i = 0; i < 2; ++i) { int R, C; stage_rc(tid * 16 + i * 8192, R, C); const int Rb = Epi::PERM ? ((R & ~31) + perm32(R & 31)) : R;
        voffA[i] = (unsigned)(R * K + C) * 2u; voffB[i] = (unsigned)(Rb * K + C) * 2u; }
    const size_t kstep = (size_t)(BK * 2);
    const size_t hstep = (size_t)HALF * K * 2;
    const size_t tstep = 2 * hstep;
    const unsigned ldsw = (unsigned)wid * 1024u;
    const int aoff = lds_byte(wr * 64 + fr, fq * 8), boff = lds_byte(wc * 32 + fr, fq * 8);
#define PG8_SA(b, h) (((b) * 2 + (h)) * HTB)
#define PG8_SB(b, h) ((4 + (b) * 2 + (h)) * HTB)
#define PG8_STAGE(bufoff, gbase, voff) do { _Pragma("unroll") for (int _i = 0; _i < 2; ++_i) \
        __builtin_amdgcn_global_load_lds((const unsigned*)((const char*)(gbase) + (voff)[_i]), (PG8_LAS unsigned*)(lds + (bufoff) + ldsw + _i * 8192), 16, 0, 0); } while (0)
#define PG8_LD8(addr) __builtin_shufflevector(*(const PG8_LAS pg8_v4i*)(addr), *(const PG8_LAS pg8_v4i*)((addr) + 1024), 0, 1, 2, 3, 4, 5, 6, 7)
#define PG8_LDA(dst, b, h) do { if constexpr (FP8) { _Pragma("unroll") for (int m = 0; m < 4; ++m) dst##8[m] = PG8_LD8(lds + PG8_SA(b, h) + aoff + m * 2048); } \
        else { _Pragma("unroll") for (int m = 0; m < 4; ++m) _Pragma("unroll") for (int k = 0; k < 2; ++k) dst[m][k] = *(const PG8_LAS bf16x8*)(lds + PG8_SA(b, h) + aoff + m * 2048 + k * 1024); } } while (0)
#define PG8_LDB(dst, b, h) do { if constexpr (FP8) { _Pragma("unroll") for (int n = 0; n < 2; ++n) dst##8[n] = PG8_LD8(lds + PG8_SB(b, h) + boff + n * 2048); } \
        else { _Pragma("unroll") for (int n = 0; n < 2; ++n) _Pragma("unroll") for (int k = 0; k < 2; ++k) dst[n][k] = *(const PG8_LAS bf16x8*)(lds + PG8_SB(b, h) + boff + n * 2048 + k * 1024); } } while (0)
#define PG8_MMA(ai, bj, At, Bt) do { __builtin_amdgcn_s_setprio(1); if constexpr (FP8) { _Pragma("unroll") for (int m = 0; m < 4; ++m) _Pragma("unroll") for (int n = 0; n < 2; ++n) \
        asm volatile("v_mfma_f32_16x16x128_f8f6f4 %0, %1, %2, %0" : "+v"(acc[ai][bj][m][n]) : "v"(Bt##8[n]), "v"(At##8[m])); }     \
      else { _Pragma("unroll") for (int m = 0; m < 4; ++m) _Pragma("unroll") for (int n = 0; n < 2; ++n) _Pragma("unroll") for (int k = 0; k < 2; ++k) \
        acc[ai][bj][m][n] = __builtin_amdgcn_mfma_f32_16x16x32_bf16(Bt[n][k], At[m][k], acc[ai][bj][m][n], 0, 0, 0); } __builtin_amdgcn_s_setprio(0); } while (0)
#define PG8_WAIT_V(n) asm volatile("s_waitcnt vmcnt(" #n ")" ::: "memory")
#define PG8_WAIT_L(n) asm volatile("s_waitcnt lgkmcnt(" #n ")" ::: "memory")
#define PG8_BAR __builtin_amdgcn_s_barrier()
#define PG8_SCHED __builtin_amdgcn_sched_barrier(0)
    Unit cur, nxt; int ui = 0;
    if (!S.next(0, cur)) return;
    f32x4 acc[2][2][4][2];
#pragma unroll
    for (int a = 0; a < 2; ++a)
#pragma unroll
        for (int b = 0; b < 2; ++b)
#pragma unroll
            for (int m = 0; m < 4; ++m)
#pragma unroll
                for (int n = 0; n < 2; ++n) acc[a][b][m][n] = (f32x4){0.f, 0.f, 0.f, 0.f};
    bf16x8 At[4][2], B0[2][2], B1[2][2];
    pg8_v8i At8[4], B08[2], B18[2];
    const char* cA = (const char*)g.A + (size_t)cur.pm * tstep; const char* cB = (const char*)g.Bt + (size_t)cur.pn * tstep;
    S.a_ready(cur);
    if constexpr (SP2) {
        PG8_STAGE(PG8_SB(0, 0), cB, voffB); PG8_STAGE(PG8_SB(0, 1), cB + hstep, voffB); PG8_STAGE(PG8_SA(0, 0), cA, voffA); PG8_STAGE(PG8_SA(0, 1), cA + hstep, voffA);
        if (wr == 1) PG8_BAR;
        PG8_WAIT_V(2); PG8_BAR;
        PG8_STAGE(PG8_SB(1, 0), cB + kstep, voffB); PG8_STAGE(PG8_SA(1, 0), cA + kstep, voffA); PG8_STAGE(PG8_SB(1, 1), cB + hstep + kstep, voffB);
        PG8_WAIT_V(6); PG8_BAR;
    } else {
        PG8_STAGE(PG8_SB(0, 0), cB, voffB); PG8_STAGE(PG8_SA(0, 0), cA, voffA); PG8_STAGE(PG8_SB(0, 1), cB + hstep, voffB); PG8_STAGE(PG8_SA(0, 1), cA + hstep, voffA);
        if (wr == 1) PG8_BAR;
        PG8_WAIT_V(4); PG8_BAR;
        PG8_STAGE(PG8_SB(1, 0), cB + kstep, voffB); PG8_STAGE(PG8_SA(1, 0), cA + kstep, voffA); PG8_STAGE(PG8_SB(1, 1), cB + hstep + kstep, voffB);
        PG8_WAIT_V(6); PG8_BAR;
    }
    for (;;) {
        const bool has_next = S.next(ui + 1, nxt);
        const char* nA = has_next ? (const char*)g.A + (size_t)nxt.pm * tstep : cA; const char* nB = has_next ? (const char*)g.Bt + (size_t)nxt.pn * tstep : cB;
        for (int t = 0; t < nt; t += 2) {
            const bool last = (t == nt - 2);
            const char* a1 = cA + (size_t)(t + 1) * kstep;
            const char* a2 = last ? nA : cA + (size_t)(t + 2) * kstep; const char* b2 = last ? nB : cB + (size_t)(t + 2) * kstep;
            const char* a3 = a2 + kstep; const char* b3 = b2 + kstep;
            if (last && has_next) S.a_ready(nxt);
            if constexpr (SP2) {
            PG8_LDB(B0, 0, 0); PG8_LDB(B1, 0, 1); PG8_SCHED; PG8_LDA(At, 0, 0); PG8_STAGE(PG8_SA(1, 1), a1 + hstep, voffA);
            PG8_WAIT_V(8); PG8_WAIT_L(0); PG8_BAR; PG8_MMA(0, 0, At, B0); PG8_MMA(0, 1, At, B1); PG8_BAR; PG8_SCHED;
            PG8_LDA(At, 0, 1); PG8_STAGE(PG8_SB(0, 0), b2, voffB); PG8_STAGE(PG8_SB(0, 1), b2 + hstep, voffB); PG8_STAGE(PG8_SA(0, 0), a2, voffA);
            PG8_WAIT_V(8); PG8_WAIT_L(0); PG8_BAR; PG8_MMA(1, 0, At, B0); PG8_MMA(1, 1, At, B1); PG8_BAR; PG8_SCHED;
            PG8_LDB(B0, 1, 0); PG8_LDB(B1, 1, 1); PG8_SCHED; PG8_LDA(At, 1, 0); PG8_STAGE(PG8_SA(0, 1), a2 + hstep, voffA);
            PG8_WAIT_V(8); PG8_WAIT_L(0); PG8_BAR; PG8_MMA(0, 0, At, B0); PG8_MMA(0, 1, At, B1); PG8_BAR; PG8_SCHED;
            PG8_LDA(At, 1, 1); PG8_STAGE(PG8_SB(1, 0), b3, voffB); PG8_STAGE(PG8_SB(1, 1), b3 + hstep, voffB); PG8_STAGE(PG8_SA(1, 0), a3, voffA);
            PG8_WAIT_V(8); PG8_WAIT_L(0); PG8_BAR; PG8_MMA(1, 0, At, B0); PG8_MMA(1, 1, At, B1); PG8_BAR; PG8_SCHED;
            } else {
            PG8_LDB(B0, 0, 0); PG8_SCHED; PG8_LDA(At, 0, 0); PG8_STAGE(PG8_SA(1, 1), a1 + hstep, voffA);
            PG8_WAIT_L(8); PG8_BAR; PG8_WAIT_L(0); PG8_MMA(0, 0, At, B0); PG8_BAR; PG8_SCHED;
            PG8_LDB(B1, 0, 1); PG8_STAGE(PG8_SB(0, 0), b2, voffB);
            PG8_BAR; PG8_WAIT_L(0); PG8_MMA(0, 1, At, B1); PG8_BAR;
            PG8_LDA(At, 0, 1); PG8_STAGE(PG8_SA(0, 0), a2, voffA);
            PG8_BAR; PG8_WAIT_L(0); PG8_MMA(1, 0, At, B0); PG8_BAR; PG8_SCHED;
            PG8_STAGE(PG8_SB(0, 1), b2 + hstep, voffB);
            PG8_WAIT_V(6); PG8_BAR; PG8_MMA(1, 1, At, B1); PG8_BAR;
            PG8_LDB(B0, 1, 0); PG8_SCHED; PG8_LDA(At, 1, 0); PG8_STAGE(PG8_SA(0, 1), a2 + hstep, voffA);
            PG8_WAIT_L(8); PG8_BAR; PG8_WAIT_L(0); PG8_MMA(0, 0, At, B0); PG8_BAR; PG8_SCHED;
            PG8_LDB(B1, 1, 1); PG8_STAGE(PG8_SB(1, 0), b3, voffB);
            PG8_BAR; PG8_WAIT_L(0); PG8_MMA(0, 1, At, B1); PG8_BAR;
            PG8_LDA(At, 1, 1); PG8_STAGE(PG8_SA(1, 0), a3, voffA);
            PG8_BAR; PG8_WAIT_L(0); PG8_MMA(1, 0, At, B0); PG8_BAR; PG8_SCHED;
            PG8_STAGE(PG8_SB(1, 1), b3 + hstep, voffB);
            PG8_WAIT_V(6); PG8_BAR; PG8_MMA(1, 1, At, B1); PG8_BAR;
            }
        }
        if constexpr (FP8) {
            asm volatile("s_nop 15\n\ts_nop 15\n\ts_nop 15" ::: "memory");
#pragma unroll
            for (int a_ = 0; a_ < 2; ++a_)
#pragma unroll
                for (int b_ = 0; b_ < 2; ++b_)
                    asm volatile("" : "+v"(acc[a_][b_][0][0]), "+v"(acc[a_][b_][0][1]), "+v"(acc[a_][b_][1][0]), "+v"(acc[a_][b_][1][1]), "+v"(acc[a_][b_][2][0]), "+v"(acc[a_][b_][2][1]), "+v"(acc[a_][b_][3][0]), "+v"(acc[a_][b_][3][1]));
        }
        if constexpr (ALIGN_EPI) { if (wr == 0) PG8_BAR; }
        if constexpr (!Epi::AFTER_DRAIN) { E(acc, cur, wr, wc, fr, fq); S.done(cur); }
        if (!has_next) break;
#pragma unroll
        for (int a = 0; a < 2; ++a)
#pragma unroll
            for (int b = 0; b < 2; ++b)
#pragma unroll
                for (int m = 0; m < 4; ++m)
#pragma unroll
                    for (int n = 0; n < 2; ++n) acc[a][b][m][n] = (f32x4){0.f, 0.f, 0.f, 0.f};
        cur = nxt; cA = nA; cB = nB; ++ui;
        if constexpr (ALIGN_EPI) { if (wr == 1) PG8_BAR; }
    }
    PG8_WAIT_V(0);
    if constexpr (!ALIGN_EPI) { if (wr == 0) PG8_BAR; }
    PG8_BAR;
    if constexpr (Epi::AFTER_DRAIN) { E.fused(acc, cur, wr, wc, fr, fq, lds, wid, lane); S.done(cur); }
#undef PG8_SA
#undef PG8_SB
#undef PG8_STAGE
#undef PG8_LD8
#undef PG8_LDA
#undef PG8_LDB
#undef PG8_MMA
#undef PG8_WAIT_V
#undef PG8_WAIT_L
#undef PG8_BAR
#undef PG8_SCHED
}
}

constexpr int NWAVES = 8;
constexpr int NB = 4, SEQ = 4096, M = NB * SEQ, D = 4096, BW = 2048, FF = 11008, DEPTH = 2;
constexpr int IN_WIDTH = 30752;
constexpr int NIN_MAIN = 26880, NIN_PAD = 30976;
constexpr int N16A = 10496, N8A = 16384, N16V = 2048, N8V = 2048;
constexpr size_t WIN_16A = 0, WIN_8A = WIN_16A + (size_t)N16A * D * 2, WIN_16V = WIN_8A + (size_t)N8A * D, WIN_8V = WIN_16V + (size_t)N16V * D * 2;
constexpr int LDH = 14336;
constexpr int H_CB = 0, H_CC = 2048, H_CH = 4096, H_NQ = 6144, H_NK = 8192, H_GQ = 10240, H_GK = 11264, H_GR = 12288;
constexpr float LN_EPS = 1e-5f, RMS_EPS = 1e-6f, ALPHA = 1.41421356237f;
#ifndef MK_MULTI
#define MK_MULTI 0
#endif
constexpr int N_PHASES = 1 + 11 * DEPTH;

constexpr size_t MiB = 1u << 20;
constexpr size_t alm(size_t x) { return (x + MiB - 1) / MiB * MiB; }
constexpr size_t WS_CTL = 0, CTL_ZERO_BYTES = 1 * MiB;
constexpr size_t SZ_WIN = alm((size_t)NIN_PAD * D * 2), SZ_WBR = alm((size_t)3 * D * BW * 2), SZ_WO = alm((size_t)D * D * 2), SZ_WFI = alm((size_t)2 * FF * D * 2), SZ_WFO = alm((size_t)D * FF * 2);
constexpr size_t OFF_WIN = 0, OFF_WBR = OFF_WIN + SZ_WIN, OFF_WO = OFF_WBR + SZ_WBR, OFF_WFI = OFF_WO + SZ_WO, OFF_WFO = OFF_WFI + SZ_WFI, SZ_WL = OFF_WFO + SZ_WFO;
constexpr size_t WS_W = 1 * MiB;
constexpr int MB = SEQ;
constexpr size_t WS_ARENA = WS_W + DEPTH * SZ_WL;
constexpr size_t A_XB = 0;
constexpr size_t A_XB8 = A_XB + alm((size_t)MB * D * 2);
constexpr size_t A_XR = A_XB8 + alm((size_t)MB * D);
constexpr size_t A_ST = A_XR + alm((size_t)MB * D * 4);
constexpr size_t A_U = A_ST + alm((size_t)MB * 2 * 4);
constexpr size_t A_HB = A_U;
constexpr size_t A_GATES = A_HB + alm((size_t)MB * LDH * 2);
constexpr size_t A_VT = A_GATES + alm((size_t)MB * 12288 * 2);
constexpr size_t A_YC = A_VT + alm((size_t)4096 * MB * 2);
constexpr size_t A_YN = A_YC + alm((size_t)MB * BW * 2);
constexpr size_t A_YG = A_YN + alm((size_t)MB * BW * 2);
constexpr size_t A_QIN = A_YG + alm((size_t)MB * BW * 2);
constexpr size_t A_KOT = A_QIN + alm((size_t)2 * MB * 1024 * 2);
constexpr size_t A_ATT = A_KOT + alm((size_t)2 * 1024 * MB * 2);
constexpr size_t A_DEC = A_ATT + alm((size_t)2 * 4 * 64 * 64 * 64 * 2);
constexpr size_t A_O = A_DEC + alm((size_t)2 * 64 * 1024 * 4);
constexpr size_t A_MIXED = A_O + alm((size_t)2 * MB * 2048 * 2);
constexpr size_t ARENA = A_MIXED + alm((size_t)MB * D * 2);
constexpr size_t A_AU = A_U;
constexpr size_t A_G = A_AU + alm((size_t)MB * 2 * FF * 2);
static_assert(A_G + alm((size_t)MB * FF * 2) <= A_MIXED, "the FFN overlay must stay below MIXED");
constexpr size_t WS_END = WS_ARENA + NB * ARENA;
static_assert(WS_END <= (size_t)3844 * MiB, "d_ws budget: 4 x the largest input tensor");
constexpr int CW_BAR = 4096;
constexpr int CW_CONV = 64;

constexpr int RING_BYTES = 131072;
constexpr int LDS_BYTES = 159744;
constexpr int MISC_OFF = LDS_BYTES - 512;

#ifndef GAS
#define GAS __attribute__((address_space(1)))
#endif
#define LAS __attribute__((address_space(3)))
typedef unsigned short bf16;
typedef unsigned v4u __attribute__((ext_vector_type(4)));
typedef unsigned v2u __attribute__((ext_vector_type(2)));
typedef float f32x4 __attribute__((ext_vector_type(4)));
typedef short bf16x8 __attribute__((ext_vector_type(8)));
typedef GAS unsigned gu32;
#define LDS_WAIT() asm volatile("s_waitcnt lgkmcnt(0)" ::: "memory")
#define VM_WAIT() asm volatile("s_waitcnt vmcnt(0)" ::: "memory")
__device__ __forceinline__ unsigned pk2(float lo, float hi) { return pg8::cvt_pk_bf16(lo, hi); }
__device__ __forceinline__ unsigned f2bf_sw(float x) { const unsigned u = __float_as_uint(x); return (u + 0x7fffu + ((u >> 16) & 1u)) >> 16; }
__device__ __forceinline__ unsigned pk2_sw(float lo, float hi) { return f2bf_sw(lo) | (f2bf_sw(hi) << 16); }
__device__ __forceinline__ float bflo(unsigned w) { return __uint_as_float(w << 16); }
__device__ __forceinline__ float bfhi(unsigned w) { return __uint_as_float(w & 0xffff0000u); }
__device__ __forceinline__ float bf1(bf16 b) { return __uint_as_float(((unsigned)b) << 16); }
__device__ __forceinline__ void unpack8(const v4u w, float (&f)[8]) { f[0] = bflo(w.x); f[1] = bfhi(w.x); f[2] = bflo(w.y); f[3] = bfhi(w.y); f[4] = bflo(w.z); f[5] = bfhi(w.z); f[6] = bflo(w.w); f[7] = bfhi(w.w); }
__device__ __forceinline__ v4u pack8(const float (&f)[8]) { v4u w; w.x = pk2(f[0], f[1]); w.y = pk2(f[2], f[3]); w.z = pk2(f[4], f[5]); w.w = pk2(f[6], f[7]); return w; }
__device__ __forceinline__ float shx(float v, int m, int lane) { return __int_as_float(__builtin_amdgcn_ds_bpermute((lane ^ m) << 2, __float_as_int(v))); }
__device__ __forceinline__ float wave_sum(float v, int lane) {
#pragma unroll
    for (int o = 1; o < 64; o <<= 1) v += shx(v, o, lane);
    return v;
}
#ifndef FP8_EMU
#define FP8_EMU 0
#endif
#ifndef FP8_GATES
#define FP8_GATES 1
#endif
__device__ __forceinline__ float q8_e4m3(float v) {
    const float a = fminf(fabsf(v), 448.f); float r;
    if (a < 0.015625f) r = rintf(a * 512.f) * (1.f / 512.f);
    else { unsigned u = __float_as_uint(a); u = (u + 0x7FFFFu + ((u >> 20) & 1u)) & 0xFFF00000u; r = fminf(__uint_as_float(u), 448.f); }
    return copysignf(r, v);
}
__device__ __forceinline__ unsigned cvt4_fp8(float a, float b, float c, float d) { int w = __builtin_amdgcn_cvt_pk_fp8_f32(a, b, 0, false); w = __builtin_amdgcn_cvt_pk_fp8_f32(c, d, w, true); return (unsigned)w; }
__device__ __forceinline__ f32x4 mfma16(bf16x8 a, bf16x8 b, f32x4 c) { return __builtin_amdgcn_mfma_f32_16x16x32_bf16(a, b, c, 0, 0, 0); }

#define XB_TMO      128
#define XB_XCNT(j)  (256  + 64 * (j))
#define XB_XSUB(j)  (1280 + 64 * (j))
#define XB_XGEN(j)  (2304 + 64 * (j))
#define XB_TOP      3328
#define XB_TOPGEN   3392
#define XCD_BAR_WORDS 3456
#define XB_SPIN_CAP (1u << 18)

__device__ __forceinline__ unsigned xb_ld(unsigned* p)              { return __hip_atomic_load(p, __ATOMIC_RELAXED, __HIP_MEMORY_SCOPE_AGENT); }
__device__ __forceinline__ unsigned xb_add(unsigned* p, unsigned v) { return __hip_atomic_fetch_add(p, v, __ATOMIC_RELAXED, __HIP_MEMORY_SCOPE_AGENT); }
__device__ __forceinline__ unsigned xb_xcc_id() { return (unsigned)__builtin_amdgcn_s_getreg((3 << 11) | 20) & 0xFu; }
#define XB_SPIN(cond, bar) do { unsigned _sp = 0; while (cond) { __builtin_amdgcn_s_sleep(1); \
    if ((++_sp & 255u) == 0u) { if (xb_ld(&(bar)[XB_TMO])) break; if (_sp > XB_SPIN_CAP) { atomicAdd(&(bar)[XB_TMO], 1u); break; } } } } while (0)

__device__ __forceinline__ unsigned xb_lane_id() { unsigned t; asm volatile("v_mbcnt_lo_u32_b32 %0, -1, 0\n\tv_mbcnt_hi_u32_b32 %0, -1, %0" : "=v"(t)); return t; }
struct XcdBarrier {
    unsigned wv;
    unsigned G;
    unsigned* bar; unsigned x;
    volatile LAS unsigned* st;
};

__device__ __forceinline__ XcdBarrier xcd_barrier_post(unsigned* bar, volatile LAS unsigned* st) {
    XcdBarrier b; b.wv = 0u; b.G = 0u; b.bar = bar; b.x = xb_xcc_id(); b.st = st;
    if (threadIdx.x == 0) (void)xb_add(&bar[XB_XCNT(b.x)], 1u);
    return b;
}
__device__ __forceinline__ void xcd_barrier_complete(unsigned* bar, unsigned x, const unsigned G, unsigned& nloc, unsigned& nx) {
    unsigned sum, cnt, mine, sp = 0u;
    for (;;) {
        sum = 0u; cnt = 0u; mine = 0u;
#pragma unroll
        for (unsigned j = 0; j < 16; ++j) { const unsigned c = xb_ld(&bar[XB_XCNT(j)]); sum += c; cnt += (c > 0u) ? 1u : 0u; mine = (j == x) ? c : mine; }
        if (sum == G) break;
        __builtin_amdgcn_s_sleep(1);
        if ((++sp & 255u) == 0u) { if (xb_ld(&bar[XB_TMO])) break; if (sp > XB_SPIN_CAP) { atomicAdd(&bar[XB_TMO], 1u); break; } }
    }
    nloc = mine > 0u ? mine : 1u; nx = cnt > 0u ? cnt : 1u;
}

__device__ __forceinline__ void xcd_barrier(const XcdBarrier& b) {
    asm volatile("s_waitcnt vmcnt(0)" ::: "memory");
    __syncthreads();
    if (b.wv == 0u && xb_lane_id() == 0u) {
        unsigned* bar = b.bar;
        __builtin_amdgcn_s_waitcnt(0);
        unsigned nloc = b.st[0], nx = b.st[1];
        if (nloc == 0u) { xcd_barrier_complete(bar, b.x, b.G, nloc, nx); b.st[0] = nloc; b.st[1] = nx; }
        const unsigned old = xb_add(&bar[XB_XSUB(b.x)], 1u);
        const unsigned gen = old / nloc;
        if (old + 1u == (gen + 1u) * nloc) {
            __builtin_amdgcn_fence(__ATOMIC_RELEASE, "agent");
            asm volatile("s_waitcnt vmcnt(0)" ::: "memory");
            const unsigned og = xb_add(&bar[XB_TOP], 1u);
            const unsigned tg = og / nx;
            if (og + 1u == (tg + 1u) * nx) xb_add(&bar[XB_TOPGEN], 1u);
            else XB_SPIN(xb_ld(&bar[XB_TOPGEN]) == tg, bar);
            __builtin_amdgcn_fence(__ATOMIC_ACQUIRE, "agent");
            xb_add(&bar[XB_XGEN(b.x)], 1u);
            asm volatile("s_waitcnt vmcnt(0)" ::: "memory");
        } else {
            XB_SPIN(xb_ld(&bar[XB_XGEN(b.x)]) == gen, bar);
            __builtin_amdgcn_fence(__ATOMIC_ACQUIRE, "agent");
            asm volatile("s_waitcnt vmcnt(0)" ::: "memory");
        }
    }
    __syncthreads();
}

struct Frame { LAS unsigned char* lds; int wv, grp, gb; };
struct Ids { int tid, lane, wave, G, gw, NGW, bi; };
__device__ __forceinline__ Ids phase_ids(const int wv) { Ids I; int t; asm volatile("v_mbcnt_lo_u32_b32 %0, -1, 0\n\tv_mbcnt_hi_u32_b32 %0, -1, %0" : "=v"(t)); t += wv * 64; asm volatile("" : "+v"(t)); I.tid = t; I.lane = t & 63; I.wave = __builtin_amdgcn_readfirstlane(t >> 6);
    int g = gridDim.x; asm volatile("" : "+s"(g)); I.G = g; I.bi = blockIdx.x; I.gw = blockIdx.x * NWAVES + I.wave; I.NGW = g * NWAVES; return I; }
__device__ __forceinline__ Ids group_ids(const Frame& F) { Ids I = phase_ids(F.wv); int gb = F.gb; asm volatile("" : "+s"(gb)); I.G = 64; I.bi = gb; I.gw = gb * NWAVES + I.wave; I.NGW = 64 * NWAVES; return I; }
#define WSP(T, off) ((T*)(GAS T*)(kargs()->ws + (off)))
#define WSB(T, off) ((T*)(GAS T*)(kargs()->ws + WS_ARENA + (size_t)F.grp * ARENA + (off)))


__device__ __forceinline__ int win_src(int r) {
    if (r < 6144) return r;
    if (r < 8192) return 12288 + (r - 6144);
    if (r < 10240) return 16384 + (r - 8192);
    if (r < 10496) return r == 10240 ? 18432 : -1;
    if (r < 14592) return 6144 + (r - 10496);
    if (r < 26880) return 18464 + (r - 14592);
    if (r < 28928) return 14336 + (r - 26880);
    return 10240 + (r - 28928);
}
__device__ __forceinline__ void tr_item(const float* W, size_t ldw, int K, int k0, int srcA, int srcB, bf16* WT, int n0, LAS float* scr, int lane, float qs = 0.f, bool f8 = false) {
    const int src = lane < 32 ? srcA : srcB; const int cl = lane & 31;
    if (src >= 0) { const float* p = W + (size_t)k0 * ldw + src + cl;
#pragma unroll 32
        for (int kk = 0; kk < 64; ++kk) { float v = __builtin_nontemporal_load(&p[(size_t)kk * ldw]); if (qs != 0.f) v = q8_e4m3(v * qs) / qs; scr[kk * 65 + lane] = v; }
    } else {
#pragma unroll 32
        for (int kk = 0; kk < 64; ++kk) scr[kk * 65 + lane] = 0.f;
    }
    LDS_WAIT(); asm volatile("" ::: "memory");
    const int c = lane & 7;
    if (f8) {
        unsigned char* W8 = (unsigned char*)WT;
#pragma unroll
        for (int j = 0; j < 8; ++j) { const int n = (lane >> 3) + 8 * j; const LAS float* s = scr + (8 * c) * 65 + n;
            v2u o; o.x = cvt4_fp8(s[0 * 65] * 64.f, s[1 * 65] * 64.f, s[2 * 65] * 64.f, s[3 * 65] * 64.f); o.y = cvt4_fp8(s[4 * 65] * 64.f, s[5 * 65] * 64.f, s[6 * 65] * 64.f, s[7 * 65] * 64.f);
            __builtin_nontemporal_store(o, (v2u*)(W8 + (size_t)(n0 + n) * K + k0 + 8 * c)); }
    } else {
#pragma unroll
    for (int j = 0; j < 8; ++j) { const int n = (lane >> 3) + 8 * j; const LAS float* s = scr + (8 * c) * 65 + n;
        v4u o; o.x = pk2(s[0 * 65], s[1 * 65]); o.y = pk2(s[2 * 65], s[3 * 65]); o.z = pk2(s[4 * 65], s[5 * 65]); o.w = pk2(s[6 * 65], s[7 * 65]);
        __builtin_nontemporal_store(o, (v4u*)(WT + (size_t)(n0 + n) * K + k0 + 8 * c)); }
    }
    LDS_WAIT(); asm volatile("" ::: "memory");
}
__device__ __forceinline__ void tr_matrix(const Ids& I, const float* W, int K, int N, bf16* WT, LAS float* scr, bool f8 = false) {
    const int nnb = N / 64, items = (K / 256) * nnb;
    for (int it = I.gw; it < items; it += I.NGW) { const int kg = it / nnb, nb = it % nnb;
        for (int kq = 0; kq < 4; ++kq) tr_item(W, (size_t)N, K, (kg * 4 + kq) * 64, nb * 64, nb * 64 + 32, WT, nb * 64, scr, I.lane, 0.f, f8); }
}
__device__ __forceinline__ void tr_win(const Ids& I, int gw, int NGW, int l, LAS float* scr) {
    unsigned char* wl = (unsigned char*)(kargs()->ws + WS_W + (size_t)l * SZ_WL);
    const float* W = INP(1) + (size_t)l * D * IN_WIDTH; unsigned char* WB = wl + OFF_WIN;
    const int nnb = NIN_PAD / 64, items = (D / 256) * nnb;
    for (int it = gw; it < items; it += NGW) { const int kg = it / nnb, nb = it % nnb, r = nb * 64; const int sa = win_src(r), sb = win_src(r + 32);
        bf16* dst; int drow; bool f8;
        if (r < N16A) { dst = (bf16*)(WB + WIN_16A); drow = r; f8 = false; }
        else if (r < N16A + N8A) { dst = (bf16*)(WB + WIN_8A); drow = r - N16A; f8 = true; }
        else if (r < N16A + N8A + N16V) { dst = (bf16*)(WB + WIN_16V); drow = r - (N16A + N8A); f8 = false; }
        else { dst = (bf16*)(WB + WIN_8V); drow = r - (N16A + N8A + N16V); f8 = true; }
        for (int kq = 0; kq < 4; ++kq) tr_item(W, (size_t)IN_WIDTH, D, (kg * 4 + kq) * 64, sa, sb, dst, drow, scr, I.lane, 0.f, f8); }
}
__device__ __forceinline__ void tr_bro(Ids I, int gw, int NGW, int l, LAS float* scr) {
    unsigned char* wl = (unsigned char*)(kargs()->ws + WS_W + (size_t)l * SZ_WL);
    I.gw = gw; I.NGW = NGW;
    for (int i = 0; i < 3; ++i) tr_matrix(I, INP(8) + ((size_t)l * 3 + i) * BW * D, BW, D, (bf16*)(wl + OFF_WBR) + (size_t)i * D * BW, scr, i == 1);
    tr_matrix(I, INP(9) + (size_t)l * D * D, D, D, (bf16*)(wl + OFF_WO), scr);
}
__device__ __forceinline__ void tr_ffn(Ids I, int gw, int NGW, int l, LAS float* scr) {
    unsigned char* wl = (unsigned char*)(kargs()->ws + WS_W + (size_t)l * SZ_WL);
    I.gw = gw; I.NGW = NGW;
    tr_matrix(I, INP(12) + (size_t)l * D * 2 * FF, D, 2 * FF, (bf16*)(wl + OFF_WFI), scr);
    tr_matrix(I, INP(15) + (size_t)l * FF * D, FF, D, (bf16*)(wl + OFF_WFO), scr);
}
__device__ __forceinline__ void p0_prologue_a(Frame& F) {
    const Ids I = phase_ids(F.wv);
    LAS float* scr = (LAS float*)(F.lds + I.wave * 16640);
    tr_win(I, I.gw, I.NGW, 0, scr);
    { const f32x4* x4 = (const f32x4*)INP(0); const size_t n8 = (size_t)M * D / 8, nb8 = (size_t)MB * D / 8, stride = (size_t)I.G * 512;
      for (size_t i = (size_t)blockIdx.x * 512 + I.tid; i < n8; i += stride) { const f32x4 a = x4[2 * i], b = x4[2 * i + 1]; v4u w; w.x = pk2(a[0], a[1]); w.y = pk2(a[2], a[3]); w.z = pk2(b[0], b[1]); w.w = pk2(b[2], b[3]);
          unsigned char* ar = (unsigned char*)(kargs()->ws + WS_ARENA + (i / nb8) * ARENA); const size_t li = i % nb8;
          ((v4u*)(ar + A_XB))[li] = w;
          v2u q; q.x = cvt4_fp8(a[0], a[1], a[2], a[3]); q.y = cvt4_fp8(b[0], b[1], b[2], b[3]); ((v2u*)(ar + A_XB8))[li] = q; } }
}
__device__ __forceinline__ void p0_prologue_full(Frame& F) {
    const Ids I = phase_ids(F.wv);
    LAS float* scr = (LAS float*)(F.lds + I.wave * 16640);
    p0_prologue_a(F);
    tr_bro(I, I.gw, I.NGW, 0, scr); tr_ffn(I, I.gw, I.NGW, 0, scr);
    tr_win(I, I.gw, I.NGW, 1, scr); tr_bro(I, I.gw, I.NGW, 1, scr); tr_ffn(I, I.gw, I.NGW, 1, scr);
}
__device__ __forceinline__ void p0_prologue_b(Frame& F) {
    const Ids I = phase_ids(F.wv);
    LAS float* scr = (LAS float*)(F.lds + I.wave * 16640);
    const int gwv = F.gb * NWAVES + I.wave;
    if (F.grp == 1) { tr_bro(I, gwv, 512, 0, scr); tr_bro(I, gwv, 512, 1, scr); }
    else if (F.grp == 2) { tr_ffn(I, gwv, 512, 0, scr); }
    else if (F.grp == 3) { tr_win(I, gwv, 512, 1, scr); tr_ffn(I, gwv, 512, 1, scr); }
    asm volatile("s_waitcnt vmcnt(0)" ::: "memory"); __syncthreads();
    if (I.tid == 0) { __builtin_amdgcn_fence(__ATOMIC_RELEASE, "agent"); asm volatile("s_waitcnt vmcnt(0)" ::: "memory");
        __hip_atomic_fetch_add((unsigned*)(GAS unsigned*)(kargs()->ws + WS_CTL) + CW_CONV, 1u, __ATOMIC_RELAXED, __HIP_MEMORY_SCOPE_AGENT); }
}
__device__ __forceinline__ void wait_weights(Frame& F) {
    const Ids I = phase_ids(F.wv);
    if (I.tid == 0) { unsigned* c = (unsigned*)(GAS unsigned*)(kargs()->ws + WS_CTL) + CW_CONV; unsigned sp = 0;
        while (__hip_atomic_load(c, __ATOMIC_RELAXED, __HIP_MEMORY_SCOPE_AGENT) < 192u) { __builtin_amdgcn_s_sleep(8); if (++sp > (1u << 22)) break; }
        __builtin_amdgcn_fence(__ATOMIC_ACQUIRE, "agent"); asm volatile("s_waitcnt vmcnt(0)" ::: "memory"); }
    __syncthreads();
}

__device__ __forceinline__ void conv_mixer_phase(Frame& F, int layer) {
    const Ids I = group_ids(F);
    const bf16* HB = WSB(const bf16, A_HB); bf16* YC = WSB(bf16, A_YC); const float* wc = INP(3) + (size_t)layer * 3 * BW;
    for (int task = I.gw; task < (MB / 32) * 4; task += I.NGW) {
        const int chunk = task & 3, m0 = (task >> 2) * 32, c8 = (chunk * 64 + I.lane) * 8;
        float w[3][8];
#pragma unroll
        for (int i = 0; i < 3; ++i) { const f32x4 a = *(const f32x4*)(wc + i * BW + c8), b = *(const f32x4*)(wc + i * BW + c8 + 4);
            w[i][0] = a[0]; w[i][1] = a[1]; w[i][2] = a[2]; w[i][3] = a[3]; w[i][4] = b[0]; w[i][5] = b[1]; w[i][6] = b[2]; w[i][7] = b[3]; }
        const bf16* row = HB + (size_t)m0 * LDH + c8;
        float pv[8], cv[8], nv[8], x[8], y[8];
        if ((m0 & (SEQ - 1)) != 0) { unpack8(*(const v4u*)(row - LDH + H_CC), x); unpack8(*(const v4u*)(row - LDH + H_CH), y);
#pragma unroll
            for (int e = 0; e < 8; ++e) pv[e] = x[e] * y[e]; }
        else {
#pragma unroll
            for (int e = 0; e < 8; ++e) pv[e] = 0.f; }
        unpack8(*(const v4u*)(row + H_CC), x); unpack8(*(const v4u*)(row + H_CH), y);
#pragma unroll
        for (int e = 0; e < 8; ++e) cv[e] = x[e] * y[e];
#pragma unroll 4
        for (int t = 0; t < 32; ++t) {
            const int m = m0 + t;
            if ((m & (SEQ - 1)) != SEQ - 1) { unpack8(*(const v4u*)(row + LDH + H_CC), x); unpack8(*(const v4u*)(row + LDH + H_CH), y);
#pragma unroll
                for (int e = 0; e < 8; ++e) nv[e] = x[e] * y[e]; }
            else {
#pragma unroll
                for (int e = 0; e < 8; ++e) nv[e] = 0.f; }
            float cb[8], acc[8]; unpack8(*(const v4u*)(row + H_CB), cb);
#pragma unroll
            for (int e = 0; e < 8; ++e) { acc[e] = cb[e] * (w[0][e] * pv[e] + w[1][e] * cv[e] + w[2][e] * nv[e]); pv[e] = cv[e]; cv[e] = nv[e]; }
            *(v4u*)(YC + (size_t)m * BW + c8) = pack8(acc);
            row += LDH;
        }
    }
}
__device__ __forceinline__ void ln_phase(Frame& F, const float* V, const float* g, const float* b, float* XF, bf16* XBo, bf16* XB8o = nullptr, float* st = nullptr) {
    const Ids I = group_ids(F);
    f32x4 v[16], vn[16];
    if (I.gw < MB) { const f32x4* vr = (const f32x4*)(V + (size_t)I.gw * D) + I.lane;
#pragma unroll
        for (int j = 0; j < 16; ++j) vn[j] = __builtin_nontemporal_load(&vr[64 * j]); }
    for (int m = I.gw; m < MB; m += I.NGW) {
#pragma unroll
        for (int j = 0; j < 16; ++j) v[j] = vn[j];
        if (m + I.NGW < MB) { const f32x4* vr = (const f32x4*)(V + (size_t)(m + I.NGW) * D) + I.lane;
#pragma unroll
            for (int j = 0; j < 16; ++j) vn[j] = __builtin_nontemporal_load(&vr[64 * j]); }
        float s = 0.f;
#pragma unroll
        for (int j = 0; j < 16; ++j) s += (v[j][0] + v[j][1]) + (v[j][2] + v[j][3]);
        const float mean = wave_sum(s, I.lane) * (1.f / D); float s2 = 0.f;
#pragma unroll
        for (int j = 0; j < 16; ++j) { v[j] = v[j] - mean; s2 += (v[j][0] * v[j][0] + v[j][1] * v[j][1]) + (v[j][2] * v[j][2] + v[j][3] * v[j][3]); }
        const float rstd = 1.f / sqrtf(wave_sum(s2, I.lane) * (1.f / D) + LN_EPS);
        if (st && I.lane == 0) { st[2 * (size_t)m] = mean; st[2 * (size_t)m + 1] = rstd; }
        f32x4* xo = (f32x4*)(XF + (size_t)m * D) + I.lane; v2u* bo = (v2u*)(XBo + (size_t)m * D) + I.lane;
#pragma unroll
        for (int j = 0; j < 16; ++j) { const f32x4 gg = ((const f32x4*)g)[I.lane + 64 * j], bb = ((const f32x4*)b)[I.lane + 64 * j];
            const f32x4 o = v[j] * rstd * gg + bb; if (XF) __builtin_nontemporal_store(o, &xo[64 * j]); if (XBo) { v2u w; w.x = pk2(o[0], o[1]); w.y = pk2(o[2], o[3]); __builtin_nontemporal_store(w, &bo[64 * j]); }
            if (FP8_EMU && XB8o) { v2u q; q.x = pk2(q8_e4m3(o[0]), q8_e4m3(o[1])); q.y = pk2(q8_e4m3(o[2]), q8_e4m3(o[3])); ((v2u*)(XB8o + (size_t)m * D) + I.lane)[64 * j] = q; }
            if (FP8_GATES && XB8o) ((unsigned*)((unsigned char*)XB8o + (size_t)m * D) + I.lane)[64 * j] = cvt4_fp8(o[0], o[1], o[2], o[3]); }
    }
}
__device__ __forceinline__ void convglu_phase(Frame& F, int layer) {
    const Ids I = group_ids(F);
    const bf16* AU = WSB(const bf16, A_AU); bf16* G = WSB(bf16, A_G);
    const float* wc = INP(13) + (size_t)layer * 3 * FF; const float* bc = INP(14) + (size_t)layer * FF;
    constexpr int NCH = FF / 256, NTASK = NCH * (MB / 32);
    for (int task = I.gw; task < NTASK; task += I.NGW) {
        const int chunk = task % NCH, m0 = ((task / NCH) * 2 + (I.lane >> 5)) * 16, c8 = (chunk * 32 + (I.lane & 31)) * 8;
        float w[3][8], bias[8];
#pragma unroll
        for (int i = 0; i < 3; ++i) { const f32x4 a = *(const f32x4*)(wc + i * FF + c8), b = *(const f32x4*)(wc + i * FF + c8 + 4);
            w[i][0] = a[0]; w[i][1] = a[1]; w[i][2] = a[2]; w[i][3] = a[3]; w[i][4] = b[0]; w[i][5] = b[1]; w[i][6] = b[2]; w[i][7] = b[3]; }
        { const f32x4 a = *(const f32x4*)(bc + c8), b = *(const f32x4*)(bc + c8 + 4); bias[0] = a[0]; bias[1] = a[1]; bias[2] = a[2]; bias[3] = a[3]; bias[4] = b[0]; bias[5] = b[1]; bias[6] = b[2]; bias[7] = b[3]; }
        const bf16* row = AU + (size_t)m0 * (2 * FF) + c8;
        float pv[8], cv[8], nv[8];
        if ((m0 & (SEQ - 1)) != 0) unpack8(*(const v4u*)(row - 2 * FF), pv);
        else {
#pragma unroll
            for (int e = 0; e < 8; ++e) pv[e] = 0.f; }
        unpack8(*(const v4u*)row, cv);
#pragma unroll 4
        for (int t = 0; t < 16; ++t) {
            const int m = m0 + t;
            if ((m & (SEQ - 1)) != SEQ - 1) unpack8(*(const v4u*)(row + 2 * FF), nv);
            else {
#pragma unroll
                for (int e = 0; e < 8; ++e) nv[e] = 0.f; }
            float u[8], acc[8]; unpack8(*(const v4u*)(row + FF), u);
#pragma unroll
            for (int e = 0; e < 8; ++e) { acc[e] = bias[e] + w[0][e] * pv[e] + w[1][e] * cv[e] + w[2][e] * nv[e]; pv[e] = cv[e]; cv[e] = nv[e]; }
#pragma unroll
            for (int e = 0; e < 8; e += 2) { const pg8::f32x2 gl = pg8::gelu_pk((pg8::f32x2){acc[e], acc[e + 1]}); acc[e] = gl.x * u[e]; acc[e + 1] = gl.y * u[e + 1]; }
            *(v4u*)(G + (size_t)m * FF + c8) = pack8(acc);
            row += 2 * FF;
        }
    }
}
__device__ __forceinline__ void gla_combine_phase(Frame& F, int layer) {
    const Ids I = group_ids(F);
    const bf16* O0 = WSB(const bf16, A_O); const bf16* O1 = O0 + (size_t)MB * 2048; const bf16* HB = WSB(const bf16, A_HB); bf16* YG = WSB(bf16, A_YG);
    const float* ng = INP(7) + (size_t)layer * 2048;
    for (int idx = I.gw; idx < MB * 4; idx += I.NGW) {
        const int m = idx >> 2, h = idx & 3; const size_t off = (size_t)m * 2048 + h * 512 + 8 * I.lane;
        float o[8], ob_[8]; unpack8(*(const v4u*)(O0 + off), o); unpack8(*(const v4u*)(O1 + off), ob_);
#pragma unroll
        for (int e = 0; e < 8; ++e) o[e] += ob_[e];
        float ss = 0.f;
#pragma unroll
        for (int e = 0; e < 8; ++e) ss += o[e] * o[e];
        const float rs = 1.f / sqrtf(wave_sum(ss, I.lane) * (1.f / 512.f) + RMS_EPS);
        float r[8]; unpack8(*(const v4u*)(HB + (size_t)m * LDH + H_GR + h * 512 + 8 * I.lane), r);
        const f32x4 g0 = *(const f32x4*)(ng + h * 512 + 8 * I.lane), g1 = *(const f32x4*)(ng + h * 512 + 8 * I.lane + 4);
        const float gg[8] = {g0[0], g0[1], g0[2], g0[3], g1[0], g1[1], g1[2], g1[3]};
#pragma unroll
        for (int e = 0; e < 8; ++e) o[e] = o[e] * rs * gg[e] * (r[e] / (1.f + __expf(-r[e])));
        *(v4u*)(YG + off) = pack8(o);
    }
}

constexpr int NA_RPB_OFF = 15 * 8192;
__device__ __forceinline__ void na_phase(Frame& F, int layer) {
    const Ids I = group_ids(F);
    const bf16* HB = WSB(const bf16, A_HB); const bf16* VT = WSB(const bf16, A_VT); bf16* YN = WSB(bf16, A_YN);
    const float* rpb = INP(4) + (size_t)layer * 16 * 465;
    LAS float* rpbs = (LAS float*)(F.lds + NA_RPB_OFF);
    const int fr = I.lane & 15, q4 = I.lane >> 4;
    const int sb_ = I.lane * 16, swz = sb_ ^ (((sb_ >> 9) & 1) << 5), rl = swz >> 6, cl = (swz & 63) >> 1;
    const int ob = fr * 64 + 16 * q4, lo = ob ^ (((ob >> 9) & 1) << 5);
    for (int it = I.bi; it < 512; it += I.G) {
        const int rblk = it & 7, cblk = (it >> 3) & 3, h = (it >> 5) & 15, b = 0;
        const int r = rblk * 8 + I.wave, c0 = cblk * 16;
        const int krs = min(max(rblk * 8 - 4, 0), 49), rs = min(max(r - 4, 0), 56), cs = min(max(c0 - 8, 0), 32), koff = rs - krs;
        const int mq = b * SEQ + r * 64 + c0 + fr;
        asm volatile("s_waitcnt lgkmcnt(0)" ::: "memory"); __builtin_amdgcn_s_barrier(); asm volatile("" ::: "memory");
#pragma unroll
        for (int i = 0; i < 15; ++i) { const int q = I.wave * 15 + i, kr = q >> 3, pc = q & 7, slab = pc >> 2, j = pc & 3;
            const int key = pg8::perm32((j >> 1) * 16 + rl), col = slab * 64 + (j & 1) * 32 + cl;
            __builtin_amdgcn_global_load_lds((const GAS unsigned*)(HB + (size_t)(b * SEQ + (krs + kr) * 64 + cs + key) * LDH + H_NK + h * 128 + col), (LAS unsigned*)(F.lds + kr * 8192 + pc * 1024), 16, 0, 0); }
        for (int i = I.tid; i < 465; i += 512) rpbs[i] = rpb[h * 465 + i];
        const bf16* qp = HB + (size_t)mq * LDH + H_NQ + h * 128 + 8 * q4;
        bf16x8 qf[4];
#pragma unroll
        for (int s = 0; s < 4; ++s) qf[s] = *(const bf16x8*)(qp + 32 * s);
        asm volatile("s_waitcnt vmcnt(0) lgkmcnt(0)" ::: "memory"); __builtin_amdgcn_s_barrier(); asm volatile("" ::: "memory");
        const int cq = c0 + fr, ws = min(max(cq - 8, 0), 48);
        f32x4 sc[8][2];
        float mx = -1e30f;
#pragma unroll
        for (int sp = 0; sp < 8; ++sp)
#pragma unroll
            for (int u = 0; u < 2; ++u) {
                const LAS unsigned char* kb = F.lds + (koff + sp) * 8192 + lo;
                f32x4 d = (f32x4){0.f, 0.f, 0.f, 0.f};
#pragma unroll
                for (int s = 0; s < 4; ++s) d = mfma16(*(const LAS bf16x8*)(kb + (s >> 1) * 4096 + (2 * u + (s & 1)) * 1024), qf[s], d);
                const int brow = (rs + sp - r + 7) * 31;
#pragma unroll
                for (int j = 0; j < 4; ++j) { const int kc = cs + 8 * q4 + 4 * u + j; const bool valid = (kc >= ws) && (kc < ws + 16);
                    const int bi = min(max(kc - cq + 15, 0), 30);
                    const float v = valid ? d[j] * 0.08838834764831845f + rpbs[brow + bi] : -1e30f;
                    sc[sp][u][j] = v; mx = fmaxf(mx, v); }
            }
        mx = fmaxf(mx, shx(mx, 16, I.lane)); mx = fmaxf(mx, shx(mx, 32, I.lane));
        float sum = 0.f;
        bf16x8 pf[8];
#pragma unroll
        for (int sp = 0; sp < 8; ++sp) { float p[8];
#pragma unroll
            for (int u = 0; u < 2; ++u)
#pragma unroll
                for (int j = 0; j < 4; ++j) { const float e = __builtin_amdgcn_exp2f((sc[sp][u][j] - mx) * 1.44269504f); p[4 * u + j] = e; sum += e; }
            const v4u w = pack8(p); pf[sp] = __builtin_bit_cast(bf16x8, w); }
        sum += shx(sum, 16, I.lane); sum += shx(sum, 32, I.lane);
        const float inv = 1.f / sum;
        asm volatile("s_waitcnt lgkmcnt(0)" ::: "memory"); __builtin_amdgcn_s_barrier(); asm volatile("" ::: "memory");
#pragma unroll
        for (int i = 0; i < 15; ++i) { const int q = I.wave * 15 + i, kr = q >> 3, dt = q & 7;
            __builtin_amdgcn_global_load_lds((const GAS unsigned*)(VT + (size_t)(h * 128 + 16 * dt + rl) * MB + b * SEQ + (krs + kr) * 64 + cs + cl), (LAS unsigned*)(F.lds + kr * 8192 + dt * 1024), 16, 0, 0); }
        asm volatile("s_waitcnt vmcnt(0)" ::: "memory"); __builtin_amdgcn_s_barrier(); asm volatile("" ::: "memory");
#pragma unroll
        for (int dt = 0; dt < 8; ++dt) { f32x4 o = (f32x4){0.f, 0.f, 0.f, 0.f};
#pragma unroll
            for (int sp = 0; sp < 8; ++sp) o = mfma16(*(const LAS bf16x8*)(F.lds + (koff + sp) * 8192 + dt * 1024 + lo), pf[sp], o);
            const float i16 = inv * 16.f;
            *(unsigned*)((unsigned char*)YN + (size_t)mq * BW + h * 128 + 16 * dt + 4 * q4) = cvt4_fp8(o[0] * i16, o[1] * i16, o[2] * i16, o[3] * i16); }
    }
}

__device__ __forceinline__ float logsigmoid16(float z) { const float e = __builtin_amdgcn_exp2f(-1.44269504f * fabsf(z)); return (fminf(z, 0.f) - 0.69314718f * __builtin_amdgcn_logf(1.0f + e)) * 0.0625f; }
__device__ __forceinline__ void gla_prep_phase(Frame& F, int layer) {
    const Ids I = group_ids(F);
    constexpr int RS = 264;
    LAS bf16* qs = (LAS bf16*)F.lds; LAS bf16* ks = qs + 2 * 64 * RS; LAS float* gas = (LAS float*)(ks + 2 * 64 * RS);
    const bf16* HB = WSB(const bf16, A_HB); const bf16* XBp = WSB(const bf16, A_XB);
    const bf16* WGA = (const bf16*)(kargs()->ws + WS_W + (size_t)layer * SZ_WL + OFF_WIN + WIN_16A) + (size_t)10240 * D;
    bf16* QIN = WSB(bf16, A_QIN); bf16* KOT = WSB(bf16, A_KOT); bf16* ATT = WSB(bf16, A_ATT); float* DEC = WSB(float, A_DEC);
    const float* wdec = INP(5) + (size_t)layer * 2 * 16 * 1024; const float* bdec = INP(6) + (size_t)layer * 2 * 1024;
    const int dir = I.tid >> 8, c = I.tid & 255, fr = I.lane & 15, q4 = I.lane >> 4;
    for (int it2 = I.bi; it2 < 64; it2 += I.G) {
      const int chunk = it2, m0 = chunk * 64;
      __syncthreads();
      { f32x4 ga_acc[4][2];
#pragma unroll
        for (int mt = 0; mt < 4; ++mt)
#pragma unroll
            for (int nt = 0; nt < 2; ++nt) ga_acc[mt][nt] = (f32x4){0.f, 0.f, 0.f, 0.f};
        const bf16* xa = XBp + (size_t)(m0 + fr) * D + I.wave * 512 + 8 * q4; const bf16* wb = WGA + (size_t)fr * D + I.wave * 512 + 8 * q4;
#pragma unroll 4
        for (int ks_ = 0; ks_ < 16; ++ks_) { bf16x8 af[4], bfr[2];
#pragma unroll
            for (int mt = 0; mt < 4; ++mt) af[mt] = *(const bf16x8*)(xa + (size_t)(16 * mt) * D + 32 * ks_);
#pragma unroll
            for (int nt = 0; nt < 2; ++nt) bfr[nt] = *(const bf16x8*)(wb + (size_t)(16 * nt) * D + 32 * ks_);
#pragma unroll
            for (int mt = 0; mt < 4; ++mt)
#pragma unroll
                for (int nt = 0; nt < 2; ++nt) ga_acc[mt][nt] = mfma16(af[mt], bfr[nt], ga_acc[mt][nt]); }
        LAS float* part = (LAS float*)F.lds + I.wave * 2048;
#pragma unroll
        for (int mt = 0; mt < 4; ++mt)
#pragma unroll
            for (int nt = 0; nt < 2; ++nt)
#pragma unroll
                for (int j = 0; j < 4; ++j) part[(16 * mt + 4 * q4 + j) * 32 + 16 * nt + fr] = ga_acc[mt][nt][j];
        __syncthreads();
        f32x4 s4 = ((const LAS f32x4*)F.lds)[I.tid];
#pragma unroll
        for (int w8 = 1; w8 < 8; ++w8) s4 += ((const LAS f32x4*)F.lds)[w8 * 512 + I.tid];
        ((LAS f32x4*)gas)[I.tid] = s4; }
      for (int h = 0; h < 4; ++h) {
        const int ch = h * 256 + c;
        __syncthreads();
        float w[16];
#pragma unroll
        for (int r = 0; r < 16; ++r) w[r] = wdec[(dir * 16 + r) * 1024 + ch];
        const float bd = bdec[dir * 1024 + ch];
        __syncthreads();
        const LAS float* ga = gas + dir * 16;
        const bf16* qg = HB + (size_t)m0 * LDH + H_GQ + ch; const bf16* kg = HB + (size_t)m0 * LDH + H_GK + ch;
        float pre[64]; float run = 0.f;
#pragma unroll
        for (int t = 0; t < 64; ++t) { float z = bd;
#pragma unroll
            for (int r = 0; r < 16; ++r) z += ga[t * 32 + r] * w[r];
            run += logsigmoid16(z); pre[t] = run; }
        const float tot = run, dec = __builtin_amdgcn_exp2f(tot * 1.44269504f);
        unsigned ko[32];
        bf16* qo = QIN + ((size_t)dir * MB + m0) * 1024 + ch;
#pragma unroll
        for (int tt = 0; tt < 32; ++tt) { float kov[2];
#pragma unroll
            for (int e = 0; e < 2; ++e) { const int t = 2 * tt + e;
                const float cum = dir == 0 ? pre[t] : tot - (t > 0 ? pre[t > 0 ? t - 1 : 0] : 0.f);
                const float e1 = __builtin_amdgcn_exp2f(cum * 1.44269504f), einv = __builtin_amdgcn_rcpf(e1);
                const float qv = bf1(qg[(size_t)t * LDH]), kv = bf1(kg[(size_t)t * LDH]);
                const float q_in = qv * 0.0625f * e1, k_in = kv * einv; kov[e] = k_in * dec;
                const unsigned qb = pk2(q_in, 0.f) & 0xffffu, kb = pk2(k_in, 0.f) & 0xffffu;
                qs[(dir * 64 + t) * RS + c] = (bf16)qb; ks[(dir * 64 + t) * RS + c] = (bf16)kb; qo[(size_t)t * 1024] = (bf16)qb; }
            ko[tt] = pk2(kov[0], kov[1]); }
        { v4u* kd = (v4u*)(KOT + ((size_t)dir * 1024 + ch) * MB + m0);
#pragma unroll
            for (int i = 0; i < 8; ++i) { v4u w4; w4.x = ko[4 * i]; w4.y = ko[4 * i + 1]; w4.z = ko[4 * i + 2]; w4.w = ko[4 * i + 3]; kd[i] = w4; } }
        DEC[((size_t)dir * 64 + chunk) * 1024 + ch] = dec;
        __syncthreads();
        { const int adir = I.wave >> 2, mt = I.wave & 3, i = 16 * mt + fr;
          const LAS bf16* qrow = qs + (adir * 64 + i) * RS + 8 * q4;
          bf16* arow = ATT + ((((size_t)adir * 4 + h) * 64 + chunk) * 64 + i) * 64;
#pragma unroll
          for (int nt = 0; nt < 4; ++nt) { const LAS bf16* krow = ks + (adir * 64 + 16 * nt + fr) * RS + 8 * q4;
              f32x4 d = (f32x4){0.f, 0.f, 0.f, 0.f};
#pragma unroll
              for (int s = 0; s < 8; ++s) d = mfma16(*(const LAS bf16x8*)(krow + 32 * s), *(const LAS bf16x8*)(qrow + 32 * s), d);
              const int j0 = 16 * nt + 4 * q4; float v[4];
#pragma unroll
              for (int jj = 0; jj < 4; ++jj) { const bool keep = adir == 0 ? (j0 + jj <= i) : (j0 + jj >= i); v[jj] = keep ? d[jj] : 0.f; }
              v2u w2; w2.x = pk2(v[0], v[1]); w2.y = pk2(v[2], v[3]); *(v2u*)(arow + j0) = w2; } }
      }
    }
}
constexpr int SCAN_Q = 0, SCAN_K = 32768, SCAN_A = 65536, SCAN_D = 73728, SCAN_BUF = 74752;
__device__ __forceinline__ void scan_stage(const bf16* QIN, const bf16* KOT, const bf16* ATT, const float* DEC, LAS unsigned char* buf, int lw, int lane, int dir, int h, int c) {
    const int m0 = c * 64;
    const int sb_ = lane * 16, swz = sb_ ^ (((sb_ >> 9) & 1) << 5), rl = swz >> 6, cl = (swz & 63) >> 1;
#pragma unroll
    for (int i = 0; i < 8; ++i) { const int q = lw * 8 + i, sl = q >> 3, j = q & 7, R = (j >> 1) * 16 + rl, C = (j & 1) * 32 + cl;
        __builtin_amdgcn_global_load_lds((const GAS unsigned*)(QIN + ((size_t)dir * MB + m0 + R) * 1024 + h * 256 + sl * 64 + C), (LAS unsigned*)(buf + SCAN_Q + sl * 8192 + j * 1024), 16, 0, 0); }
#pragma unroll
    for (int i = 0; i < 8; ++i) { const int k = lw * 8 + i, hh = k >> 4, j = k & 15, Rg = 128 * hh + (j >> 1) * 16 + rl, C = (j & 1) * 32 + cl, Rb = (Rg & ~31) + pg8::perm32(Rg & 31);
        __builtin_amdgcn_global_load_lds((const GAS unsigned*)(KOT + ((size_t)dir * 1024 + h * 256 + Rb) * MB + m0 + C), (LAS unsigned*)(buf + SCAN_K + hh * 16384 + j * 1024), 16, 0, 0); }
    const bf16* ab = ATT + (((size_t)dir * 4 + h) * 64 + c) * 4096;
#pragma unroll
    for (int i = 0; i < 2; ++i) { const int j = lw * 2 + i, R = (j >> 1) * 16 + rl, C = (j & 1) * 32 + cl;
        __builtin_amdgcn_global_load_lds((const GAS unsigned*)(ab + R * 64 + C), (LAS unsigned*)(buf + SCAN_A + j * 1024), 16, 0, 0); }
    if (lw == 0) __builtin_amdgcn_global_load_lds((const GAS unsigned*)(DEC + ((size_t)dir * 64 + c) * 1024 + h * 256 + lane * 4), (LAS unsigned*)(buf + SCAN_D), 16, 0, 0);
}
__device__ __forceinline__ void gla_scan_phase(Frame& F) {
    const Ids I = group_ids(F);
    const bf16* VT = WSB(const bf16, A_VT); const bf16* QIN = WSB(const bf16, A_QIN); const bf16* KOT = WSB(const bf16, A_KOT); const bf16* ATT = WSB(const bf16, A_ATT);
    const float* DEC = WSB(const float, A_DEC); bf16* O = WSB(bf16, A_O);
    const int fr = I.lane & 15, q4 = I.lane >> 4;
    for (int bt = I.bi; bt < 64; bt += I.G) {
        const int x = bt & 1, y = bt >> 1, sc = x * 4 + (y >> 3), eq = y & 7;
        const int dir = sc & 1, h = sc >> 1;
        asm volatile("s_waitcnt vmcnt(0) lgkmcnt(0)" ::: "memory"); __builtin_amdgcn_s_barrier(); asm volatile("" ::: "memory");
        if (I.wave >= 4) {
            const int lw = I.wave - 4;
            scan_stage(QIN, KOT, ATT, DEC, F.lds, lw, I.lane, dir, h, dir ? 63 : 0);
            asm volatile("s_waitcnt vmcnt(0)" ::: "memory"); __builtin_amdgcn_s_barrier(); asm volatile("" ::: "memory");
            for (int step = 0; step < 64; ++step) {
                if (step + 1 < 64) scan_stage(QIN, KOT, ATT, DEC, F.lds + ((step + 1) & 1) * SCAN_BUF, lw, I.lane, dir, h, dir ? 62 - step : step + 1);
                asm volatile("s_waitcnt vmcnt(0)" ::: "memory"); __builtin_amdgcn_s_barrier(); asm volatile("" ::: "memory");
            }
        } else {
            const int es = eq * 4 + I.wave;
            f32x4 st[16];
#pragma unroll
            for (int t = 0; t < 16; ++t) st[t] = (f32x4){0.f, 0.f, 0.f, 0.f};
            const bf16* vrow = VT + (size_t)(2048 + h * 512 + es * 16 + fr) * MB + 8 * q4;
            const int ob = fr * 64 + 16 * q4, lo = ob ^ (((ob >> 9) & 1) << 5);
            bf16x8 vf[2];
            { const int c0 = dir ? 63 : 0;
#pragma unroll
              for (int sp = 0; sp < 2; ++sp) vf[sp] = *(const bf16x8*)(vrow + c0 * 64 + 32 * sp); }
            asm volatile("" ::: "memory"); __builtin_amdgcn_s_barrier(); asm volatile("" ::: "memory");
            for (int step = 0; step < 64; ++step) {
                const int c = dir ? 63 - step : step, m0 = c * 64;
                const LAS unsigned char* bb = F.lds + (step & 1) * SCAN_BUF + lo;
                bf16x8 vn[2];
                { const int cn = step + 1 < 64 ? (dir ? 62 - step : step + 1) : c;
#pragma unroll
                  for (int sp = 0; sp < 2; ++sp) vn[sp] = *(const bf16x8*)(vrow + cn * 64 + 32 * sp); }
                bf16x8 sb[8];
#pragma unroll
                for (int s = 0; s < 8; ++s) { v4u w; w.x = pk2(st[2 * s][0], st[2 * s][1]); w.y = pk2(st[2 * s][2], st[2 * s][3]); w.z = pk2(st[2 * s + 1][0], st[2 * s + 1][1]); w.w = pk2(st[2 * s + 1][2], st[2 * s + 1][3]); sb[s] = __builtin_bit_cast(bf16x8, w); }
#pragma unroll
                for (int mt = 0; mt < 4; ++mt) { f32x4 o = (f32x4){0.f, 0.f, 0.f, 0.f};
#pragma unroll
                    for (int s = 0; s < 8; ++s) o = mfma16(sb[s], *(const LAS bf16x8*)(bb + SCAN_Q + (s >> 1) * 8192 + (2 * mt + (s & 1)) * 1024), o);
#pragma unroll
                    for (int sp = 0; sp < 2; ++sp) o = mfma16(vf[sp], *(const LAS bf16x8*)(bb + SCAN_A + (2 * mt + sp) * 1024), o);
                    { v2u w; w.x = pk2_sw(o[0], o[1]); w.y = pk2_sw(o[2], o[3]); *(v2u*)(O + ((size_t)dir * MB + m0 + 16 * mt + fr) * 2048 + h * 512 + es * 16 + 4 * q4) = w; } }
                const LAS unsigned char* dbase = F.lds + (step & 1) * SCAN_BUF + SCAN_D + 32 * q4;
#pragma unroll
                for (int s = 0; s < 8; ++s)
#pragma unroll
                    for (int u = 0; u < 2; ++u) { const int t = 2 * s + u;
                        const f32x4 dc = *(const LAS f32x4*)(dbase + (32 * s + 4 * u) * 4);
                        f32x4 a = st[t] * dc;
#pragma unroll
                        for (int sp = 0; sp < 2; ++sp) a = mfma16(*(const LAS bf16x8*)(bb + SCAN_K + (s >> 2) * 16384 + ((2 * (s & 3) + u) * 2 + sp) * 1024), vf[sp], a);
                        st[t] = a; }
                vf[0] = vn[0]; vf[1] = vn[1];
                asm volatile("s_waitcnt lgkmcnt(0)" ::: "memory"); __builtin_amdgcn_s_barrier(); asm volatile("" ::: "memory");
            }
        }
    }
}

#ifndef PG8_SP2
#define PG8_SP2 true
#endif
#ifndef PG8_ALIGN
#define PG8_ALIGN true
#endif
struct GroupOrder {
    int nA, nB, r, p, swapped;
    __device__ void init(int nB_, int gb, int swapped_) { nB = nB_; r = gb >> 1; p = gb & 1; swapped = swapped_; nA = 8; }
    __device__ bool next(int i, pg8::Unit& u) const {
        const int L = i * 32 + r;
        if (!swapped) { if (L >= 8 * nB) return false; u.pm = 8 * p + (L & 7); u.pn = L >> 3; return true; }
        if (L >= 64) return false; u.pn = 8 * p + (L & 7); u.pm = L >> 3; return true;
    }
    __device__ __forceinline__ void a_ready(const pg8::Unit&) const {}
    __device__ __forceinline__ void done(const pg8::Unit&) const {}
};
__global__ void __launch_bounds__(NWAVES * 64, 2) enc_fwd(Args args) {
    extern __shared__ __attribute__((aligned(16))) unsigned char lds[];
    Frame F;
    F.lds = (LAS unsigned char*)lds; F.wv = __builtin_amdgcn_readfirstlane(threadIdx.x >> 6);
    { const int bx = blockIdx.x; F.grp = (bx & 7) >> 1; F.gb = ((bx >> 3) << 1) | (bx & 1); }
    volatile LAS unsigned* MISC = (volatile LAS unsigned*)(F.lds + MISC_OFF);
    if (threadIdx.x < 128) MISC[threadIdx.x] = 0u;
    __syncthreads();
    { unsigned* ctl = (unsigned*)(GAS unsigned*)(args.ws + WS_CTL);
      (void)xcd_barrier_post(ctl + CW_BAR, MISC + 8);
      (void)xcd_barrier_post(ctl + CW_BAR + (1 + F.grp) * XCD_BAR_WORDS, MISC + 12); }
#define GRID_BAR() do { XcdBarrier bb; bb.wv = (unsigned)F.wv; bb.G = gridDim.x; bb.bar = (unsigned*)(GAS unsigned*)(kargs()->ws + WS_CTL) + CW_BAR; bb.x = (unsigned)__builtin_amdgcn_readfirstlane((int)xb_xcc_id()); bb.st = (volatile LAS unsigned*)(F.lds + MISC_OFF) + 8; xcd_barrier(bb); } while (0)
#define SEAM() do { XcdBarrier bb; bb.wv = (unsigned)F.wv; bb.G = 64u; bb.bar = (unsigned*)(GAS unsigned*)(kargs()->ws + WS_CTL) + CW_BAR + (1 + F.grp) * XCD_BAR_WORDS; bb.x = (unsigned)__builtin_amdgcn_readfirstlane((int)xb_xcc_id()); bb.st = (volatile LAS unsigned*)(F.lds + MISC_OFF) + 12; xcd_barrier(bb); } while (0)
    LAS unsigned char* ring = F.lds;

#ifndef GROUP_STAGGER
#define GROUP_STAGGER 0
#endif
#if GROUP_STAGGER
    p0_prologue_a(F);
    GRID_BAR();
    if (F.grp != 0) p0_prologue_b(F);
#else
    p0_prologue_full(F);
    GRID_BAR();
#endif

    for (int layer = 0; layer < DEPTH; ++layer) {
#define WL ((unsigned char*)(kargs()->ws + WS_W + (size_t)layer * SZ_WL))
        const pg8::bf16_t* XB = WSB(const pg8::bf16_t, A_XB);
        if (GROUP_STAGGER && layer == 1) wait_weights(F);
        { const unsigned char* WB = WL + OFF_WIN;
          { pg8::Gemm g{XB, (const pg8::bf16_t*)(WB + WIN_16A), MB, 10240, D}; GroupOrder S; S.init(40, F.gb, 0);
            pg8::EpiIn E{WSB(pg8::bf16_t, A_HB), LDH};
            pg8::gemm_phase<pg8::EpiIn, GroupOrder, PG8_ALIGN, PG8_SP2>(ring, g, S, E, F.wv); }
          { pg8::Gemm g{WSB(const pg8::bf16_t, A_XB8), (const pg8::bf16_t*)(WB + WIN_8A), MB, N8A, D / 2}; GroupOrder S; S.init(64, F.gb, 0);
            pg8::EpiF8 E{WSB(pg8::bf16_t, A_HB), LDH, WSB(pg8::bf16_t, A_GATES), INP(2) + (size_t)layer * 3 * D, 0.015625f};
            pg8::gemm_phase<pg8::EpiF8, GroupOrder, PG8_ALIGN, PG8_SP2, true>(ring, g, S, E, F.wv); }
          { pg8::Gemm g{(const pg8::bf16_t*)(WB + WIN_16V), XB, N16V, MB, D}; GroupOrder S; S.init(16, F.gb, 1);
            pg8::EpiBf16 E{WSB(pg8::bf16_t, A_VT) + (size_t)2048 * MB, MB, 1.f};
            pg8::gemm_phase<pg8::EpiBf16, GroupOrder, PG8_ALIGN, PG8_SP2>(ring, g, S, E, F.wv); }
          { pg8::Gemm g{(const pg8::bf16_t*)(WB + WIN_8V), WSB(const pg8::bf16_t, A_XB8), N8V, MB, D / 2}; GroupOrder S; S.init(16, F.gb, 1);
            pg8::EpiBf16 E{WSB(pg8::bf16_t, A_VT), MB, 0.015625f};
            pg8::gemm_phase<pg8::EpiBf16, GroupOrder, PG8_ALIGN, PG8_SP2, true>(ring, g, S, E, F.wv); } }
        SEAM();
        conv_mixer_phase(F, layer); gla_prep_phase(F, layer); na_phase(F, layer); SEAM();
        gla_scan_phase(F); SEAM();
        gla_combine_phase(F, layer); SEAM();
        if (GROUP_STAGGER && layer == 0) wait_weights(F);
        { GroupOrder S; S.init(16, F.gb, 0);
          { pg8::Gemm g{WSB(const pg8::bf16_t, A_YC), (const pg8::bf16_t*)(WL + OFF_WBR), MB, D, BW};
            pg8::EpiBranch<0> E{WSB(pg8::bf16_t, A_MIXED), WSB(const pg8::bf16_t, A_GATES), 1.f}; pg8::gemm_phase<pg8::EpiBranch<0>, GroupOrder, PG8_ALIGN, PG8_SP2>(ring, g, S, E, F.wv); }
          { pg8::Gemm g{WSB(const pg8::bf16_t, A_YN), (const pg8::bf16_t*)(WL + OFF_WBR) + (size_t)D * BW, MB, D, BW / 2};
            pg8::EpiBranch<1> E{WSB(pg8::bf16_t, A_MIXED), WSB(const pg8::bf16_t, A_GATES), 1.f / 1024.f}; pg8::gemm_phase<pg8::EpiBranch<1>, GroupOrder, PG8_ALIGN, PG8_SP2, true>(ring, g, S, E, F.wv); }
          { pg8::Gemm g{WSB(const pg8::bf16_t, A_YG), (const pg8::bf16_t*)(WL + OFF_WBR) + (size_t)2 * D * BW, MB, D, BW};
            pg8::EpiBranch<2> E{WSB(pg8::bf16_t, A_MIXED), WSB(const pg8::bf16_t, A_GATES), 1.f}; pg8::gemm_phase<pg8::EpiBranch<2>, GroupOrder, PG8_ALIGN, PG8_SP2>(ring, g, S, E, F.wv); } }
        SEAM();
        { pg8::Gemm g{WSB(const pg8::bf16_t, A_MIXED), (const pg8::bf16_t*)(WL + OFF_WO), MB, D, D}; GroupOrder S; S.init(16, F.gb, 0);
          if (layer == 0) { pg8::EpiResid<false> E{WSB(float, A_XR), INP(0) + (size_t)F.grp * MB * D, D, ALPHA, 0, 0, 0u, 0ull}; pg8::gemm_phase<pg8::EpiResid<false>, GroupOrder, PG8_ALIGN, PG8_SP2>(ring, g, S, E, F.wv); }
          else { pg8::EpiResid<true> E{WSB(float, A_XR), WSB(const float, A_XR), D, ALPHA, 16, 17, (unsigned)((layer - 1) * D), (unsigned long long)(WS_ARENA + (size_t)F.grp * ARENA + A_ST)};
                 pg8::gemm_phase<pg8::EpiResid<true>, GroupOrder, PG8_ALIGN, PG8_SP2>(ring, g, S, E, F.wv); } }
        SEAM();
        ln_phase(F, WSB(const float, A_XR), INP(10) + (size_t)layer * D, INP(11) + (size_t)layer * D, nullptr, WSB(bf16, A_XB), nullptr, WSB(float, A_ST)); SEAM();
        { pg8::Gemm g{XB, (const pg8::bf16_t*)(WL + OFF_WFI), MB, 2 * FF, D}; GroupOrder S; S.init(86, F.gb, 0);
          pg8::EpiBf16 E{WSB(pg8::bf16_t, A_AU), 2 * FF, 1.f}; pg8::gemm_phase<pg8::EpiBf16, GroupOrder, PG8_ALIGN, PG8_SP2>(ring, g, S, E, F.wv); }
        SEAM();
        convglu_phase(F, layer); SEAM();
        { pg8::Gemm g{WSB(const pg8::bf16_t, A_G), (const pg8::bf16_t*)(WL + OFF_WFO), MB, D, FF}; GroupOrder S; S.init(16, F.gb, 0);
          pg8::EpiResid<true> E{WSB(float, A_XR), WSB(const float, A_XR), D, ALPHA, 10, 11, (unsigned)(layer * D), (unsigned long long)(WS_ARENA + (size_t)F.grp * ARENA + A_ST)};
          pg8::gemm_phase<pg8::EpiResid<true>, GroupOrder, PG8_ALIGN, PG8_SP2>(ring, g, S, E, F.wv); }
        SEAM();
        if (layer == DEPTH - 1) ln_phase(F, WSB(const float, A_XR), INP(16) + (size_t)layer * D, INP(17) + (size_t)layer * D, OUTP + (size_t)F.grp * MB * D, nullptr, nullptr, nullptr);
        else { ln_phase(F, WSB(const float, A_XR), INP(16) + (size_t)layer * D, INP(17) + (size_t)layer * D, nullptr, WSB(bf16, A_XB), WSB(bf16, A_XB8), WSB(float, A_ST)); SEAM(); }
    }
#undef SEAM
#undef GRID_BAR
}

extern "C" void kernel_launch(void* const* d_in, const int* in_sizes, int n_in, void* d_out, int out_size, void* d_ws, size_t ws_size, hipStream_t stream) {
    static int grid = 0;
    if (grid == 0) {
        if (n_in != 18 || in_sizes[0] != M * D || out_size != M * D || ws_size < WS_END) { fprintf(stderr, "kernel_launch: unexpected sizes: n_in %d in0 %d out %d ws %zu (need %zu); nothing launched\n", n_in, n_in > 0 ? in_sizes[0] : -1, out_size, ws_size, (size_t)WS_END); grid = -1; return; }
        int dev = 0, cus = 0, per_cu = 0;
        if (hipGetDevice(&dev) != hipSuccess || hipDeviceGetAttribute(&cus, hipDeviceAttributeMultiprocessorCount, dev) != hipSuccess) { grid = -1; return; }
        if (hipFuncSetAttribute((const void*)enc_fwd, hipFuncAttributeMaxDynamicSharedMemorySize, LDS_BYTES) != hipSuccess) { fprintf(stderr, "kernel_launch: hipFuncSetAttribute failed\n"); grid = -1; return; }
        if (hipOccupancyMaxActiveBlocksPerMultiprocessor(&per_cu, (const void*)enc_fwd, NWAVES * 64, LDS_BYTES) != hipSuccess || per_cu < 1) { fprintf(stderr, "kernel_launch: occupancy query reports %d workgroups per CU\n", per_cu); grid = -1; (void)hipGetLastError(); return; }
        (void)hipGetLastError();
        grid = cus;
        if (grid != 256) { fprintf(stderr, "kernel_launch: built for a 256-CU device (4 groups of 64 workgroups), found %d CUs; nothing launched\n", cus); grid = -1; return; }
    }
    if (grid < 0) return;
    if (hipMemsetAsync((char*)d_ws + WS_CTL, 0, CTL_ZERO_BYTES, stream) != hipSuccess) return;
    Args a{};
    for (int i = 0; i < 18; ++i) a.in[i] = (GAS const float*)d_in[i];
    a.out = (GAS float*)d_out; a.ws = (GAS unsigned char*)d_ws;
    a.ph_lo = 0; a.ph_hi = N_PHASES;
    hipLaunchKernelGGL(enc_fwd, dim3(grid), dim3(NWAVES * 64), LDS_BYTES, stream, a);
}
```

```cpp
#include <hip/hip_runtime.h>
#include <cstdio>
#include <cstdint>
#ifndef GAS
#define GAS __attribute__((address_space(1)))
#endif
struct Args { GAS const float* in[18]; GAS float* out; GAS unsigned char* ws; int ph_lo, ph_hi; };
typedef __attribute__((address_space(4))) const Args CArgs;
__device__ __forceinline__ CArgs* kargs() { CArgs* p = (CArgs*)__builtin_amdgcn_kernarg_segment_ptr(); asm volatile("" : "+s"(p)); return p; }
#define INP(i) ((const float*)kargs()->in[i])
#define OUTP ((float*)kargs()->out)

namespace pg8 {
#define PG8_LAS __attribute__((address_space(3)))
typedef unsigned short bf16_t;
typedef short bf16x8 __attribute__((ext_vector_type(8)));
typedef float f32x4 __attribute__((ext_vector_type(4)));
typedef unsigned u32x4 __attribute__((ext_vector_type(4)));
constexpr int BM = 256, BK = 64, HALF = 128, HTB = HALF * BK * 2  , STAGE_BYTES = 8 * HTB, NXCD = 8, WGM = 8;

__host__ __device__ __forceinline__ int lds_byte(int r, int c) { const int st = (r >> 4) * 2 + (c >> 5), rr = r & 15, cc = c & 31, ob = rr * 64 + cc * 2; return st * 1024 + (ob ^ (((ob >> 9) & 1) << 5)); }
__host__ __device__ __forceinline__ void stage_rc(int b, int& R, int& C) { const int st = b / 1024, sb = b % 1024, swz = sb ^ (((sb >> 9) & 1) << 5); R = (st >> 1) * 16 + swz / 64; C = (st & 1) * 32 + (swz % 64) / 2; }
__host__ __device__ __forceinline__ int perm32(int rho) { const int n = rho >> 4, i = rho & 15; return 8 * (i >> 2) + 4 * n + (i & 3); }

#ifndef PG8_ROT
#define PG8_ROT 0
#endif
struct Unit { int pm, pn; };
struct Gemm { const bf16_t* A; const bf16_t* Bt; int M, N, K; };

struct StaticOrder {
    int nM, nN, nwg, G, c;
    __host__ __device__ void init(int M, int N, int G_, int c_) { nM = M / BM; nN = N / BM; nwg = nM * nN; G = G_; c = c_; }
    __host__ __device__ bool next(int i, Unit& u) const {
        const long L = (long)i * G + c; if (L >= nwg) return false;
        int wgid = (int)L; { const int q = nwg / NXCD, r = nwg % NXCD, xcd = wgid % NXCD, off = wgid / NXCD; wgid = (xcd < r ? xcd * (q + 1) : r * (q + 1) + (xcd - r) * q) + off; }
        const int nig = WGM * nN, gid = wgid / nig, fm = gid * WGM, gsz = (nM - fm) < WGM ? (nM - fm) : WGM;
        u.pm = fm + ((wgid % nig) % gsz); u.pn = (wgid % nig) / gsz;
        if (PG8_ROT) { const int step = nN / NXCD > 0 ? nN / NXCD : 1; u.pn = (u.pn + step * gid) % nN; }
        return true;
    }
    __device__ __forceinline__ void a_ready(const Unit&) const {}
    __device__ __forceinline__ void done(const Unit&) const {}
};

__device__ __forceinline__ unsigned cvt_pk_bf16(float lo, float hi) { unsigned r; asm volatile("s_nop 1\n\tv_cvt_pk_bf16_f32 %0, %1, %2" : "=v"(r) : "v"(lo), "v"(hi)); return r; }
typedef float f32x2 __attribute__((ext_vector_type(2)));
__device__ __forceinline__ f32x2 gelu_pk(f32x2 v) {
    const f32x2 av = __builtin_elementwise_abs(v), d = av * 0.2316418882f + 1.0f;
    f32x2 t; t.x = __builtin_amdgcn_rcpf(d.x); t.y = __builtin_amdgcn_rcpf(d.y);
    f32x2 q = t * 0.5307027145f + (-0.7265760135f); q = q * t + 0.7107068705f; q = q * t + (-0.142248368f); q = q * t + 0.127414796f; q = q * t;
    const f32x2 s = (v * v) * (-0.72134752044f);
    f32x2 e; e.x = __builtin_amdgcn_exp2f(s.x); e.y = __builtin_amdgcn_exp2f(s.y);
    const f32x2 m = v * (q * e), r = v - m;
    f32x2 o; o.x = v.x < 0.f ? m.x : r.x; o.y = v.y < 0.f ? m.y : r.y; return o;
}

__device__ __forceinline__ float bf_lo(unsigned w) { return __uint_as_float(w << 16); }
__device__ __forceinline__ float bf_hi(unsigned w) { return __uint_as_float(w & 0xffff0000u); }
__device__ __forceinline__ float sigmoidf_fast(float v) { return __builtin_amdgcn_rcpf(1.0f + __builtin_amdgcn_exp2f(-1.44269504f * v)); }

template <bool NT = false> struct EpiBf16T {
    static constexpr bool PERM = true, AFTER_DRAIN = false;
    bf16_t* O; int ldc; float sc;
    __device__ __forceinline__ void operator()(const f32x4 (&acc)[2][2][4][2], const Unit& u, int wr, int wc, int fr, int fq) const {
        asm volatile("" : "+v"(fr), "+v"(fq));
        const int row0 = u.pm * BM + wr * 64 + fr, col0 = u.pn * BM + wc * 32 + 8 * fq;
#pragma unroll
        for (int ai = 0; ai < 2; ++ai)
#pragma unroll
            for (int m = 0; m < 4; ++m) { bf16_t* rowp = O + (size_t)(row0 + ai * HALF + m * 16) * ldc + col0;
#pragma unroll
                for (int bj = 0; bj < 2; ++bj) { const f32x4 v0 = acc[ai][bj][m][0] * sc, v1 = acc[ai][bj][m][1] * sc;
                    u32x4 w; w.x = cvt_pk_bf16(v0[0], v0[1]); w.y = cvt_pk_bf16(v0[2], v0[3]); w.z = cvt_pk_bf16(v1[0], v1[1]); w.w = cvt_pk_bf16(v1[2], v1[3]);
                    if (NT) __builtin_nontemporal_store(w, (u32x4*)(rowp + bj * HALF)); else *(u32x4*)(rowp + bj * HALF) = w; } }
    }
};
typedef EpiBf16T<false> EpiBf16;
template <int CTRL> __device__ __forceinline__ float dppf(float old, float src) { return __builtin_bit_cast(float, __builtin_amdgcn_update_dpp(__builtin_bit_cast(int, old), __builtin_bit_cast(int, src), CTRL, 0xf, 0xf, false)); }
typedef unsigned u32x2 __attribute__((ext_vector_type(2)));
struct EpiConvIn {
    static constexpr bool PERM = true, AFTER_DRAIN = false;
    bf16_t* HB; int ldh; bf16_t* YC; float* HALO; const float* wconv; PG8_LAS unsigned char* br;
    __device__ __forceinline__ void operator()(const f32x4 (&acc)[2][2][4][2], const Unit& u, int wr, int wc, int fr, int fq) const {
        asm volatile("" : "+v"(fr), "+v"(fq));
        const int row0 = u.pm * BM + wr * 64 + fr;
        if (u.pn >= 32) {
            const int col0 = 10240 + (u.pn - 32) * BM + wc * 32 + 8 * fq;
#pragma unroll
            for (int ai = 0; ai < 2; ++ai)
#pragma unroll
                for (int m = 0; m < 4; ++m) { bf16_t* rowp = HB + (size_t)(row0 + ai * HALF + m * 16) * ldh + col0;
#pragma unroll
                    for (int bj = 0; bj < 2; ++bj) { const f32x4 v0 = acc[ai][bj][m][0], v1 = acc[ai][bj][m][1];
                        u32x4 w; w.x = cvt_pk_bf16(v0[0], v0[1]); w.y = cvt_pk_bf16(v0[2], v0[3]); w.z = cvt_pk_bf16(v1[0], v1[1]); w.w = cvt_pk_bf16(v1[2], v1[3]);
                        *(u32x4*)(rowp + bj * HALF) = w; } }
            return;
        }
        const int chl = 16 * wc + 4 * fq, ch = u.pn * 64 + chl;
        PG8_LAS float* BR = (PG8_LAS float*)br;
        f32x4 p[2][4];
#pragma unroll
        for (int ai = 0; ai < 2; ++ai)
#pragma unroll
            for (int m = 0; m < 4; ++m) p[ai][m] = acc[ai][0][m][1] * acc[ai][1][m][0];
#pragma unroll
        for (int ai = 0; ai < 2; ++ai) { const int q = 2 * ai + wr;
            if (fr == 0) *(PG8_LAS f32x4*)(BR + (0 * 4 + q) * 64 + chl) = p[ai][0];
            if (fr == 15) *(PG8_LAS f32x4*)(BR + (1 * 4 + q) * 64 + chl) = p[ai][3]; }
        asm volatile("s_waitcnt lgkmcnt(0)" ::: "memory"); __builtin_amdgcn_s_barrier(); asm volatile("" ::: "memory");
        const f32x4 w0 = *(const f32x4*)(wconv + ch), w1 = *(const f32x4*)(wconv + 2048 + ch), w2 = *(const f32x4*)(wconv + 4096 + ch);
#pragma unroll
        for (int ai = 0; ai < 2; ++ai) { const int q = 2 * ai + wr;
            const f32x4 xup = q > 0 ? *(const PG8_LAS f32x4*)(BR + (1 * 4 + (q - 1)) * 64 + chl) : (f32x4){0.f, 0.f, 0.f, 0.f};
            const f32x4 xdn = q < 3 ? *(const PG8_LAS f32x4*)(BR + (0 * 4 + (q + 1)) * 64 + chl) : (f32x4){0.f, 0.f, 0.f, 0.f};
#pragma unroll
            for (int m = 0; m < 4; ++m) { const int r = 128 * ai + 64 * wr + 16 * m + fr; const size_t row = (size_t)u.pm * BM + r;
                f32x4 part;
#pragma unroll
                for (int j = 0; j < 4; ++j) { const float a = p[ai][m][j];
                    const float oup = m > 0 ? dppf<0x121>(0.f, p[ai][m > 0 ? m - 1 : 0][j]) : xup[j];
                    const float odn = m < 3 ? dppf<0x12f>(0.f, p[ai][m < 3 ? m + 1 : 3][j]) : xdn[j];
                    const float up = dppf<0x111>(oup, a), dn = dppf<0x101>(odn, a);
                    part[j] = w0[j] * up + w1[j] * a + w2[j] * dn; }
                const f32x4 bv = acc[ai][0][m][0], y = bv * part, gr = acc[ai][1][m][1];
                if (r == 0 || r == BM - 1) { float* hp = HALO + ((size_t)(u.pm * 2 + (r ? 1 : 0)) * 3) * 2048 + ch;
                    *(f32x4*)hp = p[ai][m]; *(f32x4*)(hp + 2048) = part; *(f32x4*)(hp + 4096) = bv; }
                u32x2 wy; wy.x = cvt_pk_bf16(y[0], y[1]); wy.y = cvt_pk_bf16(y[2], y[3]);
                *(u32x2*)(YC + row * 2048 + ch) = wy;
                u32x2 wg; wg.x = cvt_pk_bf16(gr[0], gr[1]); wg.y = cvt_pk_bf16(gr[2], gr[3]);
                *(u32x2*)(HB + row * ldh + 12288 + ch) = wg; } }
    }
};
struct EpiF8 {
    static constexpr bool PERM = true, AFTER_DRAIN = false;
    bf16_t* HB; int ldh; bf16_t* GATES; const float* bgate; float sc;
    __device__ __forceinline__ void operator()(const f32x4 (&acc)[2][2][4][2], const Unit& u, int wr, int wc, int fr, int fq) const {
        asm volatile("" : "+v"(fr), "+v"(fq));
        const int row0 = u.pm * BM + wr * 64 + fr;
        if (u.pn < 16) {
            const int col0 = 6144 + u.pn * BM + wc * 32 + 8 * fq;
#pragma unroll
            for (int ai = 0; ai < 2; ++ai)
#pragma unroll
                for (int m = 0; m < 4; ++m) { bf16_t* rowp = HB + (size_t)(row0 + ai * HALF + m * 16) * ldh + col0;
#pragma unroll
                    for (int bj = 0; bj < 2; ++bj) { const f32x4 v0 = acc[ai][bj][m][0] * sc, v1 = acc[ai][bj][m][1] * sc;
                        u32x4 w; w.x = cvt_pk_bf16(v0[0], v0[1]); w.y = cvt_pk_bf16(v0[2], v0[3]); w.z = cvt_pk_bf16(v1[0], v1[1]); w.w = cvt_pk_bf16(v1[2], v1[3]);
                        *(u32x4*)(rowp + bj * HALF) = w; } }
        } else {
            const int col0 = (u.pn - 16) * BM + wc * 32 + 8 * fq;
            f32x4 bv[2][2];
#pragma unroll
            for (int bj = 0; bj < 2; ++bj)
#pragma unroll
                for (int n = 0; n < 2; ++n) bv[bj][n] = *(const f32x4*)(bgate + col0 + bj * HALF + 4 * n);
#pragma unroll
            for (int ai = 0; ai < 2; ++ai)
#pragma unroll
                for (int m = 0; m < 4; ++m) { bf16_t* rowp = GATES + (size_t)(row0 + ai * HALF + m * 16) * 12288 + col0;
#pragma unroll
                    for (int bj = 0; bj < 2; ++bj) { const f32x4 v0 = acc[ai][bj][m][0] * sc + bv[bj][0], v1 = acc[ai][bj][m][1] * sc + bv[bj][1];
                        u32x4 w; w.x = cvt_pk_bf16(sigmoidf_fast(v0[0]), sigmoidf_fast(v0[1])); w.y = cvt_pk_bf16(sigmoidf_fast(v0[2]), sigmoidf_fast(v0[3]));
                        w.z = cvt_pk_bf16(sigmoidf_fast(v1[0]), sigmoidf_fast(v1[1])); w.w = cvt_pk_bf16(sigmoidf_fast(v1[2]), sigmoidf_fast(v1[3]));
                        *(u32x4*)(rowp + bj * HALF) = w; } }
        }
    }
};
struct EpiGates {
    static constexpr bool PERM = true, AFTER_DRAIN = false;
    bf16_t* GATES; const float* bgate; float sc;
    __device__ __forceinline__ void operator()(const f32x4 (&acc)[2][2][4][2], const Unit& u, int wr, int wc, int fr, int fq) const {
        asm volatile("" : "+v"(fr), "+v"(fq));
        const int row0 = u.pm * BM + wr * 64 + fr, col0 = u.pn * BM + wc * 32 + 8 * fq;
#pragma unroll
        for (int ai = 0; ai < 2; ++ai)
#pragma unroll
            for (int m = 0; m < 4; ++m) { bf16_t* rowp = GATES + (size_t)(row0 + ai * HALF + m * 16) * 12288 + col0;
                asm volatile("" ::: "memory");
#pragma unroll
                for (int bj = 0; bj < 2; ++bj) { const f32x4 v0 = acc[ai][bj][m][0] * sc + *(const f32x4*)(bgate + col0 + bj * HALF), v1 = acc[ai][bj][m][1] * sc + *(const f32x4*)(bgate + col0 + bj * HALF + 4);
                    u32x4 w; w.x = cvt_pk_bf16(sigmoidf_fast(v0[0]), sigmoidf_fast(v0[1])); w.y = cvt_pk_bf16(sigmoidf_fast(v0[2]), sigmoidf_fast(v0[3]));
                    w.z = cvt_pk_bf16(sigmoidf_fast(v1[0]), sigmoidf_fast(v1[1])); w.w = cvt_pk_bf16(sigmoidf_fast(v1[2]), sigmoidf_fast(v1[3]));
                    *(u32x4*)(rowp + bj * HALF) = w; } }
    }
};
template <int I> struct EpiBranch {
    static constexpr bool PERM = true, AFTER_DRAIN = false;
    bf16_t* MIXED; const bf16_t* GATES; float sc;
    __device__ __forceinline__ void operator()(const f32x4 (&acc)[2][2][4][2], const Unit& u, int wr, int wc, int fr, int fq) const {
        asm volatile("" : "+v"(fr), "+v"(fq));
        const int row0 = u.pm * BM + wr * 64 + fr, col0 = u.pn * BM + wc * 32 + 8 * fq;
#pragma unroll
        for (int ai = 0; ai < 2; ++ai) {
            u32x4 g[4][2], p[4][2];
            asm volatile("" ::: "memory");
#pragma unroll
            for (int m = 0; m < 4; ++m) { const size_t r = (size_t)(row0 + ai * HALF + m * 16);
#pragma unroll
                for (int bj = 0; bj < 2; ++bj) { g[m][bj] = *(const u32x4*)(GATES + r * 12288 + I * 4096 + col0 + bj * HALF);
                    if (I) p[m][bj] = *(const u32x4*)(MIXED + r * 4096 + col0 + bj * HALF); else p[m][bj] = (u32x4){0u, 0u, 0u, 0u}; } }
            if (I) asm volatile("" : "+v"(g[0][0]), "+v"(g[0][1]), "+v"(g[1][0]), "+v"(g[1][1]), "+v"(g[2][0]), "+v"(g[2][1]), "+v"(g[3][0]), "+v"(g[3][1]),
                                     "+v"(p[0][0]), "+v"(p[0][1]), "+v"(p[1][0]), "+v"(p[1][1]), "+v"(p[2][0]), "+v"(p[2][1]), "+v"(p[3][0]), "+v"(p[3][1]));
            else asm volatile("" : "+v"(g[0][0]), "+v"(g[0][1]), "+v"(g[1][0]), "+v"(g[1][1]), "+v"(g[2][0]), "+v"(g[2][1]), "+v"(g[3][0]), "+v"(g[3][1]));
#pragma unroll
            for (int m = 0; m < 4; ++m) { const size_t r = (size_t)(row0 + ai * HALF + m * 16);
#pragma unroll
                for (int bj = 0; bj < 2; ++bj) {
                    bf16_t* mp = MIXED + r * 4096 + col0 + bj * HALF;
                    const u32x4 gg = g[m][bj], pp = p[m][bj];
                    const f32x4 a0 = acc[ai][bj][m][0] * sc, a1 = acc[ai][bj][m][1] * sc;
                    u32x4 w;
                    w.x = cvt_pk_bf16(bf_lo(pp.x) + bf_lo(gg.x) * a0[0], bf_hi(pp.x) + bf_hi(gg.x) * a0[1]);
                    w.y = cvt_pk_bf16(bf_lo(pp.y) + bf_lo(gg.y) * a0[2], bf_hi(pp.y) + bf_hi(gg.y) * a0[3]);
                    w.z = cvt_pk_bf16(bf_lo(pp.z) + bf_lo(gg.z) * a1[0], bf_hi(pp.z) + bf_hi(gg.z) * a1[1]);
                    w.w = cvt_pk_bf16(bf_lo(pp.w) + bf_lo(gg.w) * a1[2], bf_hi(pp.w) + bf_hi(gg.w) * a1[3]);
                    *(u32x4*)mp = w; } }
        }
    }
};
struct EpiGlu {
    static constexpr bool PERM = true, AFTER_DRAIN = false;
    bf16_t* G; float* HALO; const float* wconv; const float* bconv; PG8_LAS unsigned char* br;
    static constexpr int FFN = 11008;
    __device__ __forceinline__ void operator()(const f32x4 (&acc)[2][2][4][2], const Unit& u, int wr, int wc, int fr, int fq) const {
        asm volatile("" : "+v"(fr), "+v"(fq));
        const int cl = wc * 32 + 8 * fq, cg = u.pn * 128 + cl;
        PG8_LAS float* BR = (PG8_LAS float*)br;
#pragma unroll
        for (int ai = 0; ai < 2; ++ai) { const int q = 2 * ai + wr;
            if (fr == 0) { *(PG8_LAS f32x4*)(BR + (0 * 4 + q) * 128 + cl) = acc[ai][0][0][0]; *(PG8_LAS f32x4*)(BR + (0 * 4 + q) * 128 + cl + 4) = acc[ai][0][0][1]; }
            if (fr == 15) { *(PG8_LAS f32x4*)(BR + (1 * 4 + q) * 128 + cl) = acc[ai][0][3][0]; *(PG8_LAS f32x4*)(BR + (1 * 4 + q) * 128 + cl + 4) = acc[ai][0][3][1]; } }
        asm volatile("s_waitcnt lgkmcnt(0)" ::: "memory"); __builtin_amdgcn_s_barrier(); asm volatile("" ::: "memory");
        f32x4 w0[2], w1[2], w2[2], bs[2];
#pragma unroll
        for (int n = 0; n < 2; ++n) { w0[n] = *(const f32x4*)(wconv + cg + 4 * n); w1[n] = *(const f32x4*)(wconv + FFN + cg + 4 * n); w2[n] = *(const f32x4*)(wconv + 2 * FFN + cg + 4 * n); bs[n] = *(const f32x4*)(bconv + cg + 4 * n); }
#pragma unroll
        for (int ai = 0; ai < 2; ++ai) { const int q = 2 * ai + wr;
            f32x4 xup[2], xdn[2];
#pragma unroll
            for (int n = 0; n < 2; ++n) { xup[n] = q > 0 ? *(const PG8_LAS f32x4*)(BR + (1 * 4 + (q - 1)) * 128 + cl + 4 * n) : (f32x4){0.f, 0.f, 0.f, 0.f};
                                          xdn[n] = q < 3 ? *(const PG8_LAS f32x4*)(BR + (0 * 4 + (q + 1)) * 128 + cl + 4 * n) : (f32x4){0.f, 0.f, 0.f, 0.f}; }
#pragma unroll
            for (int m = 0; m < 4; ++m) { const int r = 128 * ai + 64 * wr + 16 * m + fr; const size_t row = (size_t)u.pm * BM + r;
                f32x4 pre[2];
#pragma unroll
                for (int n = 0; n < 2; ++n)
#pragma unroll
                    for (int j = 0; j < 4; ++j) { const float a = acc[ai][0][m][n][j];
                        const float oup = m > 0 ? dppf<0x121>(0.f, acc[ai][0][m > 0 ? m - 1 : 0][n][j]) : xup[n][j];
                        const float odn = m < 3 ? dppf<0x12f>(0.f, acc[ai][0][m < 3 ? m + 1 : 3][n][j]) : xdn[n][j];
                        const float up = dppf<0x111>(oup, a), dn = dppf<0x101>(odn, a);
                        pre[n][j] = bs[n][j] + w0[n][j] * up + w1[n][j] * a + w2[n][j] * dn; }
                if (r == 0 || r == BM - 1) {
                    float* hp = HALO + ((size_t)(u.pm * 2 + (r ? 1 : 0)) * 3) * FFN + cg;
#pragma unroll
                    for (int n = 0; n < 2; ++n) { *(f32x4*)(hp + 4 * n) = acc[ai][0][m][n]; *(f32x4*)(hp + FFN + 4 * n) = pre[n]; *(f32x4*)(hp + 2 * FFN + 4 * n) = acc[ai][1][m][n]; } }
                u32x4 w;
                { const f32x2 g0 = gelu_pk((f32x2){pre[0][0], pre[0][1]}), g1 = gelu_pk((f32x2){pre[0][2], pre[0][3]}), g2 = gelu_pk((f32x2){pre[1][0], pre[1][1]}), g3 = gelu_pk((f32x2){pre[1][2], pre[1][3]});
                  const f32x4 u0 = acc[ai][1][m][0], u1 = acc[ai][1][m][1];
                  w.x = cvt_pk_bf16(g0.x * u0[0], g0.y * u0[1]); w.y = cvt_pk_bf16(g1.x * u0[2], g1.y * u0[3]); w.z = cvt_pk_bf16(g2.x * u1[0], g2.y * u1[1]); w.w = cvt_pk_bf16(g3.x * u1[2], g3.y * u1[3]); }
                *(u32x4*)(G + row * FFN + cg) = w; } }
    }
};
template <bool NORM> struct EpiResid {
    static constexpr bool PERM = false, AFTER_DRAIN = false;
    float* V; const float* xres; int ldc; float alpha; int gi, bi; unsigned goff; unsigned long long st_off;
    __device__ __forceinline__ void operator()(const f32x4 (&acc)[2][2][4][2], const Unit& u, int wr, int wc, int fr, int fq) const {
        asm volatile("" : "+v"(fr), "+v"(fq));
        const int row0 = u.pm * BM + wr * 64 + fr, col0 = u.pn * BM + wc * 32 + 4 * fq;
        const float* g = nullptr; const float* b = nullptr; const float* st = nullptr;
        if (NORM) { g = (const float*)kargs()->in[gi] + goff; b = (const float*)kargs()->in[bi] + goff; st = (const float*)(GAS const float*)(kargs()->ws + st_off); }
        f32x4 gv[2][2], bv[2][2];
        if (NORM) {
#pragma unroll
            for (int bj = 0; bj < 2; ++bj)
#pragma unroll
                for (int n = 0; n < 2; ++n) { gv[bj][n] = *(const f32x4*)(g + col0 + bj * HALF + n * 16); bv[bj][n] = *(const f32x4*)(b + col0 + bj * HALF + n * 16); }
        }
        constexpr int RG = NORM ? 2 : 4;
#pragma unroll
        for (int ai = 0; ai < 2; ++ai)
#pragma unroll
            for (int m0 = 0; m0 < 4; m0 += RG) {
                f32x4 xr[RG][2][2]; f32x2 s2[RG];
                asm volatile("" ::: "memory");
#pragma unroll
                for (int mm = 0; mm < RG; ++mm) { const int r = row0 + ai * HALF + (m0 + mm) * 16; const size_t off = (size_t)r * ldc + col0;
                    if (NORM) s2[mm] = *(const f32x2*)(st + 2 * (size_t)r); else s2[mm] = (f32x2){0.f, 1.f};
#pragma unroll
                    for (int bj = 0; bj < 2; ++bj)
#pragma unroll
                        for (int n = 0; n < 2; ++n) xr[mm][bj][n] = *(const f32x4*)(xres + off + bj * HALF + n * 16); }
                if constexpr (NORM) {
                    if (ai == 0 && m0 == 0) asm volatile("" : "+v"(gv[0][0]), "+v"(gv[0][1]), "+v"(gv[1][0]), "+v"(gv[1][1]), "+v"(bv[0][0]), "+v"(bv[0][1]), "+v"(bv[1][0]), "+v"(bv[1][1]));
                    asm volatile("" : "+v"(xr[0][0][0]), "+v"(xr[0][0][1]), "+v"(xr[0][1][0]), "+v"(xr[0][1][1]), "+v"(xr[1][0][0]), "+v"(xr[1][0][1]), "+v"(xr[1][1][0]), "+v"(xr[1][1][1]), "+v"(s2[0]), "+v"(s2[1]));
                } else {
                    asm volatile("" : "+v"(xr[0][0][0]), "+v"(xr[0][0][1]), "+v"(xr[0][1][0]), "+v"(xr[0][1][1]), "+v"(xr[1][0][0]), "+v"(xr[1][0][1]), "+v"(xr[1][1][0]), "+v"(xr[1][1][1]),
                                      "+v"(xr[RG - 2][0][0]), "+v"(xr[RG - 2][0][1]), "+v"(xr[RG - 2][1][0]), "+v"(xr[RG - 2][1][1]), "+v"(xr[RG - 1][0][0]), "+v"(xr[RG - 1][0][1]), "+v"(xr[RG - 1][1][0]), "+v"(xr[RG - 1][1][1]));
                }
#pragma unroll
                for (int mm = 0; mm < RG; ++mm) { const int r = row0 + ai * HALF + (m0 + mm) * 16; const size_t off = (size_t)r * ldc + col0;
#pragma unroll
                    for (int bj = 0; bj < 2; ++bj)
#pragma unroll
                        for (int n = 0; n < 2; ++n) { f32x4 x = xr[mm][bj][n];
                            if (NORM) x = (x - s2[mm].x) * s2[mm].y * gv[bj][n] + bv[bj][n];
                            *(f32x4*)(V + off + bj * HALF + n * 16) = x * alpha + acc[ai][bj][m0 + mm][n]; } }
            }
    }
};

typedef int pg8_v4i __attribute__((ext_vector_type(4)));
typedef int pg8_v8i __attribute__((ext_vector_type(8)));
__device__ __forceinline__ pg8_v8i pg8_cat(bf16x8 lo, bf16x8 hi) { return __builtin_shufflevector(__builtin_bit_cast(pg8_v4i, lo), __builtin_bit_cast(pg8_v4i, hi), 0, 1, 2, 3, 4, 5, 6, 7); }
template <class Epi, class Sched, bool ALIGN_EPI = false, bool SP2 = false, bool FP8 = false>
__device__ __forceinline__ void gemm_phase(PG8_LAS unsigned char* lds, const Gemm g, const Sched& S, const Epi& E, const int wv  ) {
    int tid_; asm volatile("v_mbcnt_lo_u32_b32 %0, -1, 0\n\tv_mbcnt_hi_u32_b32 %0, -1, %0" : "=v"(tid_)); tid_ += wv * 64; asm volatile("" : "+v"(tid_));
    const int tid = tid_, wid = __builtin_amdgcn_readfirstlane(tid >> 6), lane = tid & 63, wr = wid >> 2, wc = wid & 3, fr = lane & 15, fq = lane >> 4;
    const int K = g.K, nt = K / BK;
    unsigned voffA[2], voffB[2];
#pragma unroll
    for (int i = 0; i < 2; ++i) { int R, C; stage_rc(tid * 16 + i * 8192, R, C); const int Rb = Epi::PERM ? ((R & ~31) + perm32(R & 31)) : R;
        voffA[i] = (unsigned)(R * K + C) * 2u; voffB[i] = (unsigned)(Rb * K + C) * 2u; }
    const size_t kstep = (size_t)(BK * 2);
    const size_t hstep = (size_t)HALF * K * 2;
    const size_t tstep = 2 * hstep;
    const unsigned ldsw = (unsigned)wid * 1024u;
    const int aoff = lds_byte(wr * 64 + fr, fq * 8), boff = lds_byte(wc * 32 + fr, fq * 8);
#define PG8_SA(b, h) (((b) * 2 + (h)) * HTB)
#define PG8_SB(b, h) ((4 + (b) * 2 + (h)) * HTB)
#define PG8_STAGE(bufoff, gbase, voff) do { _Pragma("unroll") for (int _i = 0; _i < 2; ++_i) \
        __builtin_amdgcn_global_load_lds((const unsigned*)((const char*)(gbase) + (voff)[_i]), (PG8_LAS unsigned*)(lds + (bufoff) + ldsw + _i * 8192), 16, 0, 0); } while (0)
#define PG8_LD8(addr) __builtin_shufflevector(*(const PG8_LAS pg8_v4i*)(addr), *(const PG8_LAS pg8_v4i*)((addr) + 1024), 0, 1, 2, 3, 4, 5, 6, 7)
#define PG8_LDA(dst, b, h) do { if constexpr (FP8) { _Pragma("unroll") for (int m = 0; m < 4; ++m) dst##8[m] = PG8_LD8(lds + PG8_SA(b, h) + aoff + m * 2048); } \
        else { _Pragma("unroll") for (int m = 0; m < 4; ++m) _Pragma("unroll") for (int k = 0; k < 2; ++k) dst[m][k] = *(const PG8_LAS bf16x8*)(lds + PG8_SA(b, h) + aoff + m * 2048 + k * 1024); } } while (0)
#define PG8_LDB(dst, b, h) do { if constexpr (FP8) { _Pragma("unroll") for (int n = 0; n < 2; ++n) dst##8[n] = PG8_LD8(lds + PG8_SB(b, h) + boff + n * 2048); } \
        else { _Pragma("unroll") for (int n = 0; n < 2; ++n) _Pragma("unroll") for (int k = 0; k < 2; ++k) dst[n][k] = *(const PG8_LAS bf16x8*)(lds + PG8_SB(b, h) + boff + n * 2048 + k * 1024); } } while (0)
#define PG8_MMA(ai, bj, At, Bt) do { __builtin_amdgcn_s_setprio(1); if constexpr (FP8) { _Pragma("unroll") for (int m = 0; m < 4; ++m) _Pragma("unroll") for (int n = 0; n < 2; ++n) \
        asm volatile("v_mfma_f32_16x16x128_f8f6f4 %0, %1, %2, %0" : "+v"(acc[ai][bj][m][n]) : "v"(Bt##8[n]), "v"(At##8[m])); }     \
      else { _Pragma("unroll") for (int m = 0; m < 4; ++m) _Pragma("unroll") for (int n = 0; n < 2; ++n) _Pragma("unroll") for (int k = 0; k < 2; ++k) \
        acc[ai][bj][m][n] = __builtin_amdgcn_mfma_f32_16x16x32_bf16(Bt[n][k], At[m][k], acc[ai][bj][m][n], 0, 0, 0); } __builtin_amdgcn_s_setprio(0); } while (0)
#define PG8_WAIT_V(n) asm volatile("s_waitcnt vmcnt(" #n ")" ::: "memory")
#define PG8_WAIT_L(n) asm volatile("s_waitcnt lgkmcnt(" #n ")" ::: "memory")
#define PG8_BAR __builtin_amdgcn_s_barrier()
#define PG8_SCHED __builtin_amdgcn_sched_barrier(0)
    Unit cur, nxt; int ui = 0;
    if (!S.next(0, cur)) return;
    f32x4 acc[2][2][4][2];
#pragma unroll
    for (int a = 0; a < 2; ++a)
#pragma unroll
        for (int b = 0; b < 2; ++b)
#pragma unroll
            for (int m = 0; m < 4; ++m)
#pragma unroll
                for (int n = 0; n < 2; ++n) acc[a][b][m][n] = (f32x4){0.f, 0.f, 0.f, 0.f};
    bf16x8 At[4][2], B0[2][2], B1[2][2];
    pg8_v8i At8[4], B08[2], B18[2];
    const char* cA = (const char*)g.A + (size_t)cur.pm * tstep; const char* cB = (const char*)g.Bt + (size_t)cur.pn * tstep;
    S.a_ready(cur);
    if constexpr (SP2) {
        PG8_STAGE(PG8_SB(0, 0), cB, voffB); PG8_STAGE(PG8_SB(0, 1), cB + hstep, voffB); PG8_STAGE(PG8_SA(0, 0), cA, voffA); PG8_STAGE(PG8_SA(0, 1), cA + hstep, voffA);
        if (wr == 1) PG8_BAR;
        PG8_WAIT_V(2); PG8_BAR;
        PG8_STAGE(PG8_SB(1, 0), cB + kstep, voffB); PG8_STAGE(PG8_SA(1, 0), cA + kstep, voffA); PG8_STAGE(PG8_SB(1, 1), cB + hstep + kstep, voffB);
        PG8_WAIT_V(6); PG8_BAR;
    } else {
        PG8_STAGE(PG8_SB(0, 0), cB, voffB); PG8_STAGE(PG8_SA(0, 0), cA, voffA); PG8_STAGE(PG8_SB(0, 1), cB + hstep, voffB); PG8_STAGE(PG8_SA(0, 1), cA + hstep, voffA);
        if (wr == 1) PG8_BAR;
        PG8_WAIT_V(4); PG8_BAR;
        PG8_STAGE(PG8_SB(1, 0), cB + kstep, voffB); PG8_STAGE(PG8_SA(1, 0), cA + kstep, voffA); PG8_STAGE(PG8_SB(1, 1), cB + hstep + kstep, voffB);
        PG8_WAIT_V(6); PG8_BAR;
    }
    for (;;) {
        const bool has_next = S.next(ui + 1, nxt);
        const char* nA = has_next ? (const char*)g.A + (size_t)nxt.pm * tstep : cA; const char* nB = has_next ? (const char*)g.Bt + (size_t)nxt.pn * tstep : cB;
        for (int t = 0; t < nt; t += 2) {
            const bool last = (t == nt - 2);
            const char* a1 = cA + (size_t)(t + 1) * kstep;
            const char* a2 = last ? nA : cA + (size_t)(t + 2) * kstep; const char* b2 = last ? nB : cB + (size_t)(t + 2) * kstep;
            const char* a3 = a2 + kstep; const char* b3 = b2 + kstep;
            if (last && has_next) S.a_ready(nxt);
            if constexpr (SP2) {
            PG8_LDB(B0, 0, 0); PG8_LDB(B1, 0, 1); PG8_SCHED; PG8_LDA(At, 0, 0); PG8_STAGE(PG8_SA(1, 1), a1 + hstep, voffA);
            PG8_WAIT_V(8); PG8_WAIT_L(0); PG8_BAR; PG8_MMA(0, 0, At, B0); PG8_MMA(0, 1, At, B1); PG8_BAR; PG8_SCHED;
            PG8_LDA(At, 0, 1); PG8_STAGE(PG8_SB(0, 0), b2, voffB); PG8_STAGE(PG8_SB(0, 1), b2 + hstep, voffB); PG8_STAGE(PG8_SA(0, 0), a2, voffA);
            PG8_WAIT_V(8); PG8_WAIT_L(0); PG8_BAR; PG8_MMA(1, 0, At, B0); PG8_MMA(1, 1, At, B1); PG8_BAR; PG8_SCHED;
            PG8_LDB(B0, 1, 0); PG8_LDB(B1, 1, 1); PG8_SCHED; PG8_LDA(At, 1, 0); PG8_STAGE(PG8_SA(0, 1), a2 + hstep, voffA);
            PG8_WAIT_V(8); PG8_WAIT_L(0); PG8_BAR; PG8_MMA(0, 0, At, B0); PG8_MMA(0, 1, At, B1); PG8_BAR; PG8_SCHED;
            PG8_LDA(At, 1, 1); PG8_STAGE(PG8_SB(1, 0), b3, voffB); PG8_STAGE(PG8_SB(1, 1), b3 + hstep, voffB); PG8_STAGE(PG8_SA(1, 0), a3, voffA);
            PG8_WAIT_V(8); PG8_WAIT_L(0); PG8_BAR; PG8_MMA(1, 0, At, B0); PG8_MMA(1, 1, At, B1); PG8_BAR; PG8_SCHED;
            } else {
            PG8_LDB(B0, 0, 0); PG8_SCHED; PG8_LDA(At, 0, 0); PG8_STAGE(PG8_SA(1, 1), a1 + hstep, voffA);
            PG8_WAIT_L(8); PG8_BAR; PG8_WAIT_L(0); PG8_MMA(0, 0, At, B0); PG8_BAR; PG8_SCHED;
            PG8_LDB(B1, 0, 1); PG8_STAGE(PG8_SB(0, 0), b2, voffB);
            PG8_BAR; PG8_WAIT_L(0); PG8_MMA(0, 1, At, B1); PG8_BAR;
            PG8_LDA(At, 0, 1); PG8_STAGE(PG8_SA(0, 0), a2, voffA);
            PG8_BAR; PG8_WAIT_L(0); PG8_MMA(1, 0, At, B0); PG8_BAR; PG8_SCHED;
            PG8_STAGE(PG8_SB(0, 1), b2 + hstep, voffB);
            PG8_WAIT_V(6); PG8_BAR; PG8_MMA(1, 1, At, B1); PG8_BAR;
            PG8_LDB(B0, 1, 0); PG8_SCHED; PG8_LDA(At, 1, 0); PG8_STAGE(PG8_SA(0, 1), a2 + hstep, voffA);
            PG8_WAIT_L(8); PG8_BAR; PG8_WAIT_L(0); PG8_MMA(0, 0, At, B0); PG8_BAR; PG8_SCHED;
            PG8_LDB(B1, 1, 1); PG8_STAGE(PG8_SB(1, 0), b3, voffB);
            PG8_BAR; PG8_WAIT_L(0); PG8_MMA(0, 1, At, B1); PG8_BAR;
            PG8_LDA(At, 1, 1); PG8_STAGE(PG8_SA(1, 0), a3, voffA);
            PG8_BAR; PG8_WAIT_L(0); PG8_MMA(1, 0, At, B0); PG8_BAR; PG8_SCHED;
            PG8_STAGE(PG8_SB(1, 1), b3 + hstep, voffB);
            PG8_WAIT_V(6); PG8_BAR; PG8_MMA(1, 1, At, B1); PG8_BAR;
            }
        }
        if constexpr (FP8) {
            asm volatile("s_nop 15\n\ts_nop 15\n\ts_nop 15" ::: "memory");
#pragma unroll
            for (int a_ = 0; a_ < 2; ++a_)
#pragma unroll
                for (int b_ = 0; b_ < 2; ++b_)
                    asm volatile("" : "+v"(acc[a_][b_][0][0]), "+v"(acc[a_][b_][0][1]), "+v"(acc[a_][b_][1][0]), "+v"(acc[a_][b_][1][1]), "+v"(acc[a_][b_][2][0]), "+v"(acc[a_][b_][2][1]), "+v"(acc[a_][b_][3][0]), "+v"(acc[a_][b_][3][1]));
        }
        if constexpr (ALIGN_EPI) { if (wr == 0) PG8_BAR; }
        if constexpr (!Epi::AFTER_DRAIN) { E(acc, cur, wr, wc, fr, fq); S.done(cur); }
        if (!has_next) break;
#pragma unroll
        for (int a = 0; a < 2; ++a)
#pragma unroll
            for (int b = 0; b < 2; ++b)
#pragma unroll
                for (int m = 0; m < 4; ++m)
#pragma unroll
                    for (int n = 0; n < 2; ++n) acc[a][b][m][n] = (f32x4){0.f, 0.f, 0.f, 0.f};
        cur = nxt; cA = nA; cB = nB; ++ui;
        if constexpr (ALIGN_EPI) { if (wr == 1) PG8_BAR; }
    }
    PG8_WAIT_V(0);
    if constexpr (!ALIGN_EPI) { if (wr == 0) PG8_BAR; }
    PG8_BAR;
    if constexpr (Epi::AFTER_DRAIN) { E.fused(acc, cur, wr, wc, fr, fq, lds, wid, lane); S.done(cur); }
#undef PG8_SA
#undef PG8_SB
#undef PG8_STAGE
#undef PG8_LD8
#undef PG8_LDA
#undef PG8_LDB
#undef PG8_MMA
#undef PG8_WAIT_V
#undef PG8_WAIT_L
#undef PG8_BAR
#undef PG8_SCHED
}
}

constexpr int NWAVES = 8;
constexpr int NB = 4, SEQ = 4096, M = NB * SEQ, D = 4096, BW = 2048, FF = 11008, DEPTH = 2;
constexpr int IN_WIDTH = 30752;
constexpr int NIN_MAIN = 26880, NIN_PAD = 30976;
constexpr int N16A = 10496, N8A = 16384, N16V = 2048, N8V = 2048;
constexpr size_t WIN_16A = 0, WIN_8A = WIN_16A + (size_t)N16A * D * 2, WIN_16V = WIN_8A + (size_t)N8A * D, WIN_8V = WIN_16V + (size_t)N16V * D * 2;
constexpr int LDH = 14336;
constexpr int H_CB = 0, H_CC = 2048, H_CH = 4096, H_NQ = 6144, H_NK = 8192, H_GQ = 10240, H_GK = 11264, H_GR = 12288;
constexpr float LN_EPS = 1e-5f, RMS_EPS = 1e-6f, ALPHA = 1.41421356237f;
#ifndef MK_MULTI
#define MK_MULTI 0
#endif
constexpr int N_PHASES = 1 + 11 * DEPTH;

constexpr size_t MiB = 1u << 20;
constexpr size_t alm(size_t x) { return (x + MiB - 1) / MiB * MiB; }
constexpr size_t WS_CTL = 0, CTL_ZERO_BYTES = 1 * MiB;
constexpr size_t SZ_WIN = alm((size_t)NIN_PAD * D * 2), SZ_WBR = alm((size_t)3 * D * BW * 2), SZ_WO = alm((size_t)D * D * 2), SZ_WFI = alm((size_t)2 * FF * D * 2), SZ_WFO = alm((size_t)D * FF * 2);
constexpr size_t OFF_WIN = 0, OFF_WBR = OFF_WIN + SZ_WIN, OFF_WO = OFF_WBR + SZ_WBR, OFF_WFI = OFF_WO + SZ_WO, OFF_WFO = OFF_WFI + SZ_WFI, SZ_WL = OFF_WFO + SZ_WFO;
constexpr size_t WS_W = 1 * MiB;
constexpr int MB = SEQ;
constexpr size_t WS_ARENA = WS_W + DEPTH * SZ_WL;
constexpr size_t A_XB = 0;
constexpr size_t A_XB8 = A_XB + alm((size_t)MB * D * 2);
constexpr size_t A_XR = A_XB8 + alm((size_t)MB * D);
constexpr size_t A_ST = A_XR + alm((size_t)MB * D * 4);
constexpr size_t A_HALOC = A_ST + alm((size_t)MB * 2 * 4);
constexpr size_t A_U = A_HALOC + alm((size_t)16 * 2 * 3 * BW * 4);
constexpr size_t A_HB = A_U;
constexpr size_t A_GATES = A_HB + alm((size_t)MB * LDH * 2);
constexpr size_t A_VT = A_GATES + alm((size_t)MB * 12288 * 2);
constexpr size_t A_YC = A_VT + alm((size_t)4096 * MB * 2);
constexpr size_t A_YN = A_YC + alm((size_t)MB * BW * 2);
constexpr size_t A_YG = A_YN + alm((size_t)MB * BW * 2);
constexpr size_t A_QIN = A_YG + alm((size_t)MB * BW * 2);
constexpr size_t A_KOT = A_QIN + alm((size_t)2 * MB * 1024 * 2);
constexpr size_t A_ATT = A_KOT + alm((size_t)2 * 1024 * MB * 2);
constexpr size_t A_DEC = A_ATT + alm((size_t)2 * 4 * 64 * 64 * 64 * 2);
constexpr size_t A_O = A_DEC + alm((size_t)2 * 64 * 1024 * 4);
constexpr size_t A_MIXED = A_O + alm((size_t)2 * MB * 2048 * 2);
constexpr size_t ARENA = A_MIXED + alm((size_t)MB * D * 2);
constexpr size_t A_HALO = A_U;
constexpr size_t A_G = A_HALO + alm((size_t)16 * 2 * 3 * FF * 4);
static_assert(A_G + alm((size_t)MB * FF * 2) <= A_MIXED, "the FFN overlay must stay below MIXED");
constexpr size_t WS_END = WS_ARENA + NB * ARENA;
static_assert(WS_END <= (size_t)3844 * MiB, "d_ws budget: 4 x the largest input tensor");
constexpr int CW_BAR = 4096;
constexpr int CW_CONV = 64;

constexpr int RING_BYTES = 131072;
constexpr int LDS_BYTES = 159744;
constexpr int MISC_OFF = LDS_BYTES - 512;

#ifndef GAS
#define GAS __attribute__((address_space(1)))
#endif
#define LAS __attribute__((address_space(3)))
typedef unsigned short bf16;
typedef unsigned v4u __attribute__((ext_vector_type(4)));
typedef unsigned v2u __attribute__((ext_vector_type(2)));
typedef float f32x4 __attribute__((ext_vector_type(4)));
typedef short bf16x8 __attribute__((ext_vector_type(8)));
typedef GAS unsigned gu32;
#define LDS_WAIT() asm volatile("s_waitcnt lgkmcnt(0)" ::: "memory")
#define VM_WAIT() asm volatile("s_waitcnt vmcnt(0)" ::: "memory")
__device__ __forceinline__ unsigned pk2(float lo, float hi) { return pg8::cvt_pk_bf16(lo, hi); }
__device__ __forceinline__ unsigned f2bf_sw(float x) { const unsigned u = __float_as_uint(x); return (u + 0x7fffu + ((u >> 16) & 1u)) >> 16; }
__device__ __forceinline__ unsigned pk2_sw(float lo, float hi) { return f2bf_sw(lo) | (f2bf_sw(hi) << 16); }
__device__ __forceinline__ float bflo(unsigned w) { return __uint_as_float(w << 16); }
__device__ __forceinline__ float bfhi(unsigned w) { return __uint_as_float(w & 0xffff0000u); }
__device__ __forceinline__ float bf1(bf16 b) { return __uint_as_float(((unsigned)b) << 16); }
__device__ __forceinline__ void unpack8(const v4u w, float (&f)[8]) { f[0] = bflo(w.x); f[1] = bfhi(w.x); f[2] = bflo(w.y); f[3] = bfhi(w.y); f[4] = bflo(w.z); f[5] = bfhi(w.z); f[6] = bflo(w.w); f[7] = bfhi(w.w); }
__device__ __forceinline__ v4u pack8(const float (&f)[8]) { v4u w; w.x = pk2(f[0], f[1]); w.y = pk2(f[2], f[3]); w.z = pk2(f[4], f[5]); w.w = pk2(f[6], f[7]); return w; }
__device__ __forceinline__ float shx(float v, int m, int lane) { return __int_as_float(__builtin_amdgcn_ds_bpermute((lane ^ m) << 2, __float_as_int(v))); }
__device__ __forceinline__ float wave_sum(float v, int lane) {
#pragma unroll
    for (int o = 1; o < 64; o <<= 1) v += shx(v, o, lane);
    return v;
}
#ifndef FP8_EMU
#define FP8_EMU 0
#endif
#ifndef FP8_GATES
#define FP8_GATES 1
#endif
__device__ __forceinline__ float q8_e4m3(float v) {
    const float a = fminf(fabsf(v), 448.f); float r;
    if (a < 0.015625f) r = rintf(a * 512.f) * (1.f / 512.f);
    else { unsigned u = __float_as_uint(a); u = (u + 0x7FFFFu + ((u >> 20) & 1u)) & 0xFFF00000u; r = fminf(__uint_as_float(u), 448.f); }
    return copysignf(r, v);
}
__device__ __forceinline__ unsigned cvt4_fp8(float a, float b, float c, float d) { int w = __builtin_amdgcn_cvt_pk_fp8_f32(a, b, 0, false); w = __builtin_amdgcn_cvt_pk_fp8_f32(c, d, w, true); return (unsigned)w; }
__device__ __forceinline__ f32x4 mfma16(bf16x8 a, bf16x8 b, f32x4 c) { return __builtin_amdgcn_mfma_f32_16x16x32_bf16(a, b, c, 0, 0, 0); }

#define XB_TMO      128
#define XB_XCNT(j)  (256  + 64 * (j))
#define XB_XSUB(j)  (1280 + 64 * (j))
#define XB_XGEN(j)  (2304 + 64 * (j))
#define XB_TOP      3328
#define XB_TOPGEN   3392
#define XCD_BAR_WORDS 3456
#define XB_SPIN_CAP (1u << 18)

__device__ __forceinline__ unsigned xb_ld(unsigned* p)              { return __hip_atomic_load(p, __ATOMIC_RELAXED, __HIP_MEMORY_SCOPE_AGENT); }
__device__ __forceinline__ unsigned xb_add(unsigned* p, unsigned v) { return __hip_atomic_fetch_add(p, v, __ATOMIC_RELAXED, __HIP_MEMORY_SCOPE_AGENT); }
__device__ __forceinline__ unsigned xb_xcc_id() { return (unsigned)__builtin_amdgcn_s_getreg((3 << 11) | 20) & 0xFu; }
#define XB_SPIN(cond, bar) do { unsigned _sp = 0; while (cond) { __builtin_amdgcn_s_sleep(1); \
    if ((++_sp & 255u) == 0u) { if (xb_ld(&(bar)[XB_TMO])) break; if (_sp > XB_SPIN_CAP) { atomicAdd(&(bar)[XB_TMO], 1u); break; } } } } while (0)

__device__ __forceinline__ unsigned xb_lane_id() { unsigned t; asm volatile("v_mbcnt_lo_u32_b32 %0, -1, 0\n\tv_mbcnt_hi_u32_b32 %0, -1, %0" : "=v"(t)); return t; }
struct XcdBarrier {
    unsigned wv;
    unsigned G;
    unsigned* bar; unsigned x;
    volatile LAS unsigned* st;
};

__device__ __forceinline__ XcdBarrier xcd_barrier_post(unsigned* bar, volatile LAS unsigned* st) {
    XcdBarrier b; b.wv = 0u; b.G = 0u; b.bar = bar; b.x = xb_xcc_id(); b.st = st;
    if (threadIdx.x == 0) (void)xb_add(&bar[XB_XCNT(b.x)], 1u);
    return b;
}
__device__ __forceinline__ void xcd_barrier_complete(unsigned* bar, unsigned x, const unsigned G, unsigned& nloc, unsigned& nx) {
    unsigned sum, cnt, mine, sp = 0u;
    for (;;) {
        sum = 0u; cnt = 0u; mine = 0u;
#pragma unroll
        for (unsigned j = 0; j < 16; ++j) { const unsigned c = xb_ld(&bar[XB_XCNT(j)]); sum += c; cnt += (c > 0u) ? 1u : 0u; mine = (j == x) ? c : mine; }
        if (sum == G) break;
        __builtin_amdgcn_s_sleep(1);
        if ((++sp & 255u) == 0u) { if (xb_ld(&bar[XB_TMO])) break; if (sp > XB_SPIN_CAP) { atomicAdd(&bar[XB_TMO], 1u); break; } }
    }
    nloc = mine > 0u ? mine : 1u; nx = cnt > 0u ? cnt : 1u;
}

__device__ __forceinline__ void xcd_barrier(const XcdBarrier& b) {
    asm volatile("s_waitcnt vmcnt(0)" ::: "memory");
    __syncthreads();
    if (b.wv == 0u && xb_lane_id() == 0u) {
        unsigned* bar = b.bar;
        __builtin_amdgcn_s_waitcnt(0);
        unsigned nloc = b.st[0], nx = b.st[1];
        if (nloc == 0u) { xcd_barrier_complete(bar, b.x, b.G, nloc, nx); b.st[0] = nloc; b.st[1] = nx; }
        const unsigned old = xb_add(&bar[XB_XSUB(b.x)], 1u);
        const unsigned gen = old / nloc;
        if (old + 1u == (gen + 1u) * nloc) {
            __builtin_amdgcn_fence(__ATOMIC_RELEASE, "agent");
            asm volatile("s_waitcnt vmcnt(0)" ::: "memory");
            const unsigned og = xb_add(&bar[XB_TOP], 1u);
            const unsigned tg = og / nx;
            if (og + 1u == (tg + 1u) * nx) xb_add(&bar[XB_TOPGEN], 1u);
            else XB_SPIN(xb_ld(&bar[XB_TOPGEN]) == tg, bar);
            __builtin_amdgcn_fence(__ATOMIC_ACQUIRE, "agent");
            xb_add(&bar[XB_XGEN(b.x)], 1u);
            asm volatile("s_waitcnt vmcnt(0)" ::: "memory");
        } else {
            XB_SPIN(xb_ld(&bar[XB_XGEN(b.x)]) == gen, bar);
            __builtin_amdgcn_fence(__ATOMIC_ACQUIRE, "agent");
            asm volatile("s_waitcnt vmcnt(0)" ::: "memory");
        }
    }
    __syncthreads();
}

struct Frame { LAS unsigned char* lds; int wv, grp, gb; };
struct Ids { int tid, lane, wave, G, gw, NGW, bi; };
__device__ __forceinline__ Ids phase_ids(const int wv) { Ids I; int t; asm volatile("v_mbcnt_lo_u32_b32 %0, -1, 0\n\tv_mbcnt_hi_u32_b32 %0, -1, %0" : "=v"(t)); t += wv * 64; asm volatile("" : "+v"(t)); I.tid = t; I.lane = t & 63; I.wave = __builtin_amdgcn_readfirstlane(t >> 6);
    int g = gridDim.x; asm volatile("" : "+s"(g)); I.G = g; I.bi = blockIdx.x; I.gw = blockIdx.x * NWAVES + I.wave; I.NGW = g * NWAVES; return I; }
__device__ __forceinline__ Ids group_ids(const Frame& F) { Ids I = phase_ids(F.wv); int gb = F.gb; asm volatile("" : "+s"(gb)); I.G = 64; I.bi = gb; I.gw = gb * NWAVES + I.wave; I.NGW = 64 * NWAVES; return I; }
#define WSP(T, off) ((T*)(GAS T*)(kargs()->ws + (off)))
#define WSB(T, off) ((T*)(GAS T*)(kargs()->ws + WS_ARENA + (size_t)F.grp * ARENA + (off)))


__device__ __forceinline__ int win_src(int r) {
    if (r < 8192) { const int nb = r >> 6, T = nb >> 2, q = nb & 3, second = (r >> 5) & 1, ch0 = 64 * T + 32 * (q & 1);
        return (q < 2 ? (second ? 2048 : 0) : (second ? 16384 : 4096)) + ch0; }
    if (r < 10240) return 12288 + (r - 8192);
    if (r < 10496) return r == 10240 ? 18432 : -1;
    if (r < 14592) return 6144 + (r - 10496);
    if (r < 26880) return 18464 + (r - 14592);
    if (r < 28928) return 14336 + (r - 26880);
    return 10240 + (r - 28928);
}
__device__ __forceinline__ void tr_item(const float* W, size_t ldw, int K, int k0, int srcA, int srcB, bf16* WT, int n0, LAS float* scr, int lane, float qs = 0.f, bool f8 = false, bool cperm = false) {
    const int src = lane < 32 ? srcA : srcB; const int cl = lane & 31;
    if (src >= 0) { const float* p = W + (size_t)k0 * ldw + src + cl;
#pragma unroll 32
        for (int kk = 0; kk < 64; ++kk) { float v = __builtin_nontemporal_load(&p[(size_t)kk * ldw]); if (qs != 0.f) v = q8_e4m3(v * qs) / qs; scr[kk * 65 + lane] = v; }
    } else {
#pragma unroll 32
        for (int kk = 0; kk < 64; ++kk) scr[kk * 65 + lane] = 0.f;
    }
    LDS_WAIT(); asm volatile("" ::: "memory");
    const int c = lane & 7;
    if (f8) {
        unsigned char* W8 = (unsigned char*)WT;
#pragma unroll
        for (int j = 0; j < 8; ++j) { const int n = (lane >> 3) + 8 * j; const LAS float* s = scr + (8 * c) * 65 + n;
            v2u o; o.x = cvt4_fp8(s[0 * 65] * 64.f, s[1 * 65] * 64.f, s[2 * 65] * 64.f, s[3 * 65] * 64.f); o.y = cvt4_fp8(s[4 * 65] * 64.f, s[5 * 65] * 64.f, s[6 * 65] * 64.f, s[7 * 65] * 64.f);
            __builtin_nontemporal_store(o, (v2u*)(W8 + (size_t)(n0 + n) * K + k0 + 8 * c)); }
    } else {
#pragma unroll
    for (int j = 0; j < 8; ++j) { const int n = (lane >> 3) + 8 * j; const LAS float* s = scr + (8 * c) * 65 + n;
        v4u o; o.x = pk2(s[0 * 65], s[1 * 65]); o.y = pk2(s[2 * 65], s[3 * 65]); o.z = pk2(s[4 * 65], s[5 * 65]); o.w = pk2(s[6 * 65], s[7 * 65]);
        const int nr = cperm ? 32 * ((n >> 4) & 1) + 8 * ((n >> 2) & 3) + 4 * (n >> 5) + (n & 3) : n;
        __builtin_nontemporal_store(o, (v4u*)(WT + (size_t)(n0 + nr) * K + k0 + 8 * c)); }
    }
    LDS_WAIT(); asm volatile("" ::: "memory");
}
__device__ __forceinline__ void tr_item4(const float* W, size_t ldw, int K, int kbase, int srcA, int srcB, bf16* WT, int n0, LAS float* scr, int lane, bool f8, bool cperm) {
    const int src = lane < 32 ? srcA : srcB; const int cl = lane & 31;
    const bool live = src >= 0;
    const float* p = W + (size_t)kbase * ldw + (live ? src + cl : 0);
    const int c = lane & 7;
    auto emit = [&](int k0) {
        LDS_WAIT(); asm volatile("" ::: "memory");
        if (f8) {
            unsigned char* W8 = (unsigned char*)WT;
#pragma unroll
            for (int j = 0; j < 8; ++j) { const int n = (lane >> 3) + 8 * j; const LAS float* s = scr + (8 * c) * 65 + n;
                v2u o; o.x = cvt4_fp8(s[0 * 65] * 64.f, s[1 * 65] * 64.f, s[2 * 65] * 64.f, s[3 * 65] * 64.f); o.y = cvt4_fp8(s[4 * 65] * 64.f, s[5 * 65] * 64.f, s[6 * 65] * 64.f, s[7 * 65] * 64.f);
                __builtin_nontemporal_store(o, (v2u*)(W8 + (size_t)(n0 + n) * K + k0 + 8 * c)); }
        } else {
#pragma unroll
            for (int j = 0; j < 8; ++j) { const int n = (lane >> 3) + 8 * j; const LAS float* s = scr + (8 * c) * 65 + n;
                v4u o; o.x = pk2(s[0 * 65], s[1 * 65]); o.y = pk2(s[2 * 65], s[3 * 65]); o.z = pk2(s[4 * 65], s[5 * 65]); o.w = pk2(s[6 * 65], s[7 * 65]);
                const int nr = cperm ? 32 * ((n >> 4) & 1) + 8 * ((n >> 2) & 3) + 4 * (n >> 5) + (n & 3) : n;
                __builtin_nontemporal_store(o, (v4u*)(WT + (size_t)(n0 + nr) * K + k0 + 8 * c)); }
        }
        LDS_WAIT(); asm volatile("" ::: "memory");
    };
    float a[32], b[32];
#pragma unroll
    for (int kk = 0; kk < 32; ++kk) a[kk] = __builtin_nontemporal_load(&p[(size_t)kk * ldw]);
#pragma unroll 1
    for (int kq = 0; kq < 3; ++kq) {
        const float* pq = p + (size_t)(64 * kq) * ldw;
#pragma unroll
        for (int kk = 0; kk < 32; ++kk) b[kk] = __builtin_nontemporal_load(&pq[(size_t)(32 + kk) * ldw]);
        asm volatile("" ::: "memory");
#pragma unroll
        for (int kk = 0; kk < 32; ++kk) scr[kk * 65 + lane] = live ? a[kk] : 0.f;
        asm volatile("" ::: "memory");
#pragma unroll
        for (int kk = 0; kk < 32; ++kk) a[kk] = __builtin_nontemporal_load(&pq[(size_t)(64 + kk) * ldw]);
        asm volatile("" ::: "memory");
#pragma unroll
        for (int kk = 0; kk < 32; ++kk) scr[(32 + kk) * 65 + lane] = live ? b[kk] : 0.f;
        emit(kbase + 64 * kq);
    }
    { const float* pq = p + (size_t)(64 * 3) * ldw;
#pragma unroll
      for (int kk = 0; kk < 32; ++kk) b[kk] = __builtin_nontemporal_load(&pq[(size_t)(32 + kk) * ldw]);
      asm volatile("" ::: "memory");
#pragma unroll
      for (int kk = 0; kk < 32; ++kk) scr[kk * 65 + lane] = live ? a[kk] : 0.f;
#pragma unroll
      for (int kk = 0; kk < 32; ++kk) scr[(32 + kk) * 65 + lane] = live ? b[kk] : 0.f;
      emit(kbase + 64 * 3); }
}
__device__ __forceinline__ void tr_matrix(const Ids& I, const float* W, int K, int N, bf16* WT, LAS float* scr, bool f8 = false) {
    const int nnb = N / 64, items = (K / 256) * nnb;
    for (int it = I.gw; it < items; it += I.NGW) { const int kg = it / nnb, nb = it % nnb;
        tr_item4(W, (size_t)N, K, kg * 256, nb * 64, nb * 64 + 32, WT, nb * 64, scr, I.lane, f8, false); }
}
__device__ __forceinline__ void tr_win(const Ids& I, int gw, int NGW, int l, LAS float* scr) {
    unsigned char* wl = (unsigned char*)(kargs()->ws + WS_W + (size_t)l * SZ_WL);
    const float* W = INP(1) + (size_t)l * D * IN_WIDTH; unsigned char* WB = wl + OFF_WIN;
    const int nnb = NIN_PAD / 64, items = (D / 256) * nnb;
    for (int it = gw; it < items; it += NGW) { const int kg = it / nnb, nb = it % nnb, r = nb * 64; const int sa = win_src(r), sb = win_src(r + 32);
        bf16* dst; int drow; bool f8;
        if (r < N16A) { dst = (bf16*)(WB + WIN_16A); drow = r; f8 = false; }
        else if (r < N16A + N8A) { dst = (bf16*)(WB + WIN_8A); drow = r - N16A; f8 = true; }
        else if (r < N16A + N8A + N16V) { dst = (bf16*)(WB + WIN_16V); drow = r - (N16A + N8A); f8 = false; }
        else { dst = (bf16*)(WB + WIN_8V); drow = r - (N16A + N8A + N16V); f8 = true; }
        tr_item4(W, (size_t)IN_WIDTH, D, kg * 256, sa, sb, dst, drow, scr, I.lane, f8, r < 8192); }
}
__device__ __forceinline__ void tr_bro(Ids I, int gw, int NGW, int l, LAS float* scr) {
    unsigned char* wl = (unsigned char*)(kargs()->ws + WS_W + (size_t)l * SZ_WL);
    I.gw = gw; I.NGW = NGW;
    for (int i = 0; i < 3; ++i) tr_matrix(I, INP(8) + ((size_t)l * 3 + i) * BW * D, BW, D, (bf16*)(wl + OFF_WBR) + (size_t)i * D * BW, scr, i == 1);
    tr_matrix(I, INP(9) + (size_t)l * D * D, D, D, (bf16*)(wl + OFF_WO), scr);
}
__device__ __forceinline__ void tr_ffn(Ids I, int gw, int NGW, int l, LAS float* scr) {
    unsigned char* wl = (unsigned char*)(kargs()->ws + WS_W + (size_t)l * SZ_WL);
    I.gw = gw; I.NGW = NGW;
    { const float* W = INP(12) + (size_t)l * D * 2 * FF; bf16* WT = (bf16*)(wl + OFF_WFI);
      const int nnb = 2 * FF / 64, items = (D / 256) * nnb;
      for (int it = I.gw; it < items; it += I.NGW) { const int kg = it / nnb, nb = it % nnb, t = nb >> 2, q = nb & 3, src = q < 2 ? 128 * t + 64 * q : FF + 128 * t + 64 * (q - 2);
          tr_item4(W, (size_t)(2 * FF), D, kg * 256, src, src + 32, WT, nb * 64, scr, I.lane, false, false); } }
    tr_matrix(I, INP(15) + (size_t)l * FF * D, FF, D, (bf16*)(wl + OFF_WFO), scr);
}
__device__ __forceinline__ void p0_prologue_a(Frame& F) {
    const Ids I = phase_ids(F.wv);
    LAS float* scr = (LAS float*)(F.lds + I.wave * 16640);
    tr_win(I, I.gw, I.NGW, 0, scr);
    { const f32x4* x4 = (const f32x4*)INP(0); const size_t n8 = (size_t)M * D / 8, nb8 = (size_t)MB * D / 8, stride = (size_t)I.G * 512;
      for (size_t i = (size_t)blockIdx.x * 512 + I.tid; i < n8; i += stride) { const f32x4 a = x4[2 * i], b = x4[2 * i + 1]; v4u w; w.x = pk2(a[0], a[1]); w.y = pk2(a[2], a[3]); w.z = pk2(b[0], b[1]); w.w = pk2(b[2], b[3]);
          unsigned char* ar = (unsigned char*)(kargs()->ws + WS_ARENA + (i / nb8) * ARENA); const size_t li = i % nb8;
          ((v4u*)(ar + A_XB))[li] = w;
          v2u q; q.x = cvt4_fp8(a[0], a[1], a[2], a[3]); q.y = cvt4_fp8(b[0], b[1], b[2], b[3]); ((v2u*)(ar + A_XB8))[li] = q; } }
}
__device__ __forceinline__ void p0_prologue_full(Frame& F) {
    const Ids I = phase_ids(F.wv);
    LAS float* scr = (LAS float*)(F.lds + I.wave * 16640);
    p0_prologue_a(F);
#if defined(PROBE_HALF_CONV)
    if (blockIdx.x & 1) return;
    { const int g2 = (blockIdx.x >> 1) * NWAVES + I.wave, n2 = (I.G >> 1) * NWAVES;
      tr_bro(I, g2, n2, 0, scr); tr_ffn(I, g2, n2, 0, scr); tr_win(I, g2, n2, 1, scr); tr_bro(I, g2, n2, 1, scr); tr_ffn(I, g2, n2, 1, scr); }
#else
    tr_bro(I, I.gw, I.NGW, 0, scr); tr_ffn(I, I.gw, I.NGW, 0, scr);
    tr_win(I, I.gw, I.NGW, 1, scr); tr_bro(I, I.gw, I.NGW, 1, scr); tr_ffn(I, I.gw, I.NGW, 1, scr);
#endif
}
__device__ __forceinline__ void p0_prologue_b(Frame& F) {
    const Ids I = phase_ids(F.wv);
    LAS float* scr = (LAS float*)(F.lds + I.wave * 16640);
    const int gwv = F.gb * NWAVES + I.wave;
    if (F.grp == 1) { tr_bro(I, gwv, 512, 0, scr); tr_bro(I, gwv, 512, 1, scr); }
    else if (F.grp == 2) { tr_ffn(I, gwv, 512, 0, scr); }
    else if (F.grp == 3) { tr_win(I, gwv, 512, 1, scr); tr_ffn(I, gwv, 512, 1, scr); }
    asm volatile("s_waitcnt vmcnt(0)" ::: "memory"); __syncthreads();
    if (I.tid == 0) { __builtin_amdgcn_fence(__ATOMIC_RELEASE, "agent"); asm volatile("s_waitcnt vmcnt(0)" ::: "memory");
        __hip_atomic_fetch_add((unsigned*)(GAS unsigned*)(kargs()->ws + WS_CTL) + CW_CONV, 1u, __ATOMIC_RELAXED, __HIP_MEMORY_SCOPE_AGENT); }
}
__device__ __forceinline__ void wait_weights(Frame& F) {
    const Ids I = phase_ids(F.wv);
    if (I.tid == 0) { unsigned* c = (unsigned*)(GAS unsigned*)(kargs()->ws + WS_CTL) + CW_CONV; unsigned sp = 0;
        while (__hip_atomic_load(c, __ATOMIC_RELAXED, __HIP_MEMORY_SCOPE_AGENT) < 192u) { __builtin_amdgcn_s_sleep(8); if (++sp > (1u << 22)) break; }
        __builtin_amdgcn_fence(__ATOMIC_ACQUIRE, "agent"); asm volatile("s_waitcnt vmcnt(0)" ::: "memory"); }
    __syncthreads();
}

__device__ __forceinline__ void conv_fix_phase(Frame& F, int layer) {
    const Ids I = group_ids(F);
    const float* HALO = WSB(const float, A_HALOC); bf16* YC = WSB(bf16, A_YC);
    const float* wc = INP(3) + (size_t)layer * 3 * BW;
    constexpr int J = BW / 8, NIT = 15 * 2 * J;
    for (int it = I.gw * 64 + I.lane; it < NIT; it += I.NGW * 64) {
        const int c8 = (it % J) * 8, bs = it / J, side = bs & 1, t = 1 + (bs >> 1);
        const int tile = side ? t : t - 1, s_own = side ? 0 : 1, tile_nb = side ? t - 1 : t, s_nb = side ? 1 : 0, row = side ? 256 * t : 256 * t - 1;
        const float* own = HALO + ((size_t)(tile * 2 + s_own) * 3) * BW + c8; const float* nb = HALO + ((size_t)(tile_nb * 2 + s_nb) * 3) * BW + c8;
        const float* wt = wc + (side ? 0 : 2) * BW + c8;
        float o[8];
#pragma unroll
        for (int h = 0; h < 2; ++h) { const f32x4 part = *(const f32x4*)(own + BW + 4 * h), pn = *(const f32x4*)(nb + 4 * h), w4 = *(const f32x4*)(wt + 4 * h), b4 = *(const f32x4*)(own + 2 * BW + 4 * h);
            const f32x4 v = b4 * (part + w4 * pn); o[4 * h] = v[0]; o[4 * h + 1] = v[1]; o[4 * h + 2] = v[2]; o[4 * h + 3] = v[3]; }
        *(v4u*)(YC + (size_t)row * BW + c8) = pack8(o);
    }
}
__device__ __forceinline__ void ln_phase(Frame& F, const float* V, const float* g, const float* b, float* XF, bf16* XBo, bf16* XB8o = nullptr, float* st = nullptr) {
    const Ids I = group_ids(F);
    LAS f32x4* gl = (LAS f32x4*)F.lds; LAS f32x4* bl = gl + D / 4;
    __syncthreads();
    for (int i = I.tid; i < D / 4; i += NWAVES * 64) { gl[i] = ((const f32x4*)g)[i]; bl[i] = ((const f32x4*)b)[i]; }
    __syncthreads();
    f32x4 v[16], vn[16];
    if (I.gw < MB) { const f32x4* vr = (const f32x4*)(V + (size_t)I.gw * D) + I.lane;
#pragma unroll
        for (int j = 0; j < 16; ++j) vn[j] = __builtin_nontemporal_load(&vr[64 * j]); }
    for (int m = I.gw; m < MB; m += I.NGW) {
#pragma unroll
        for (int j = 0; j < 16; ++j) v[j] = vn[j];
        if (m + I.NGW < MB) { const f32x4* vr = (const f32x4*)(V + (size_t)(m + I.NGW) * D) + I.lane;
#pragma unroll
            for (int j = 0; j < 16; ++j) vn[j] = __builtin_nontemporal_load(&vr[64 * j]); }
        float s = 0.f;
#pragma unroll
        for (int j = 0; j < 16; ++j) s += (v[j][0] + v[j][1]) + (v[j][2] + v[j][3]);
        const float mean = wave_sum(s, I.lane) * (1.f / D); float s2 = 0.f;
#pragma unroll
        for (int j = 0; j < 16; ++j) { v[j] = v[j] - mean; s2 += (v[j][0] * v[j][0] + v[j][1] * v[j][1]) + (v[j][2] * v[j][2] + v[j][3] * v[j][3]); }
        const float rstd = 1.f / sqrtf(wave_sum(s2, I.lane) * (1.f / D) + LN_EPS);
        if (st && I.lane == 0) { st[2 * (size_t)m] = mean; st[2 * (size_t)m + 1] = rstd; }
        f32x4* xo = (f32x4*)(XF + (size_t)m * D) + I.lane; v2u* bo = (v2u*)(XBo + (size_t)m * D) + I.lane;
#pragma unroll
        for (int j = 0; j < 16; ++j) { const f32x4 gg = gl[I.lane + 64 * j], bb = bl[I.lane + 64 * j];
            const f32x4 o = v[j] * rstd * gg + bb; if (XF) __builtin_nontemporal_store(o, &xo[64 * j]); if (XBo) { v2u w; w.x = pk2(o[0], o[1]); w.y = pk2(o[2], o[3]); __builtin_nontemporal_store(w, &bo[64 * j]); }
            if (FP8_EMU && XB8o) { v2u q; q.x = pk2(q8_e4m3(o[0]), q8_e4m3(o[1])); q.y = pk2(q8_e4m3(o[2]), q8_e4m3(o[3])); ((v2u*)(XB8o + (size_t)m * D) + I.lane)[64 * j] = q; }
            if (FP8_GATES && XB8o) ((unsigned*)((unsigned char*)XB8o + (size_t)m * D) + I.lane)[64 * j] = cvt4_fp8(o[0], o[1], o[2], o[3]); }
    }
}
__device__ __forceinline__ void convglu_fix_phase(Frame& F, int layer) {
    const Ids I = group_ids(F);
    const float* HALO = WSB(const float, A_HALO); bf16* G = WSB(bf16, A_G);
    const float* wc = INP(13) + (size_t)layer * 3 * FF;
    constexpr int J = FF / 8, NIT = 15 * 2 * J;
    for (int it = I.gw * 64 + I.lane; it < NIT; it += I.NGW * 64) {
        const int c8 = (it % J) * 8, bs = it / J, side = bs & 1, t = 1 + (bs >> 1);
        const int tile = side ? t : t - 1, s_own = side ? 0 : 1, tile_nb = side ? t - 1 : t, s_nb = side ? 1 : 0, row = side ? 256 * t : 256 * t - 1;
        const float* own = HALO + ((size_t)(tile * 2 + s_own) * 3) * FF + c8; const float* nb = HALO + ((size_t)(tile_nb * 2 + s_nb) * 3) * FF + c8;
        const float* wt = wc + (side ? 0 : 2) * FF + c8;
        float o[8];
#pragma unroll
        for (int h = 0; h < 2; ++h) { const f32x4 pre = *(const f32x4*)(own + FF + 4 * h), an = *(const f32x4*)(nb + 4 * h), w4 = *(const f32x4*)(wt + 4 * h), u4 = *(const f32x4*)(own + 2 * FF + 4 * h);
            const f32x4 v = pre + w4 * an;
            const pg8::f32x2 g0 = pg8::gelu_pk((pg8::f32x2){v[0], v[1]}), g1 = pg8::gelu_pk((pg8::f32x2){v[2], v[3]});
            o[4 * h] = g0.x * u4[0]; o[4 * h + 1] = g0.y * u4[1]; o[4 * h + 2] = g1.x * u4[2]; o[4 * h + 3] = g1.y * u4[3]; }
        *(v4u*)(G + (size_t)row * FF + c8) = pack8(o);
    }
}
__device__ __forceinline__ void gla_combine_phase(Frame& F, int layer) {
    const Ids I = group_ids(F);
    const bf16* O0 = WSB(const bf16, A_O); const bf16* O1 = O0 + (size_t)MB * 2048; const bf16* HB = WSB(const bf16, A_HB); bf16* YG = WSB(bf16, A_YG);
    const float* ng = INP(7) + (size_t)layer * 2048;
    for (int idx = I.gw; idx < MB * 4; idx += 2 * I.NGW) {
        v4u a[2], bq[2], rr[2]; f32x4 g0[2], g1[2]; size_t off[2];
        asm volatile("" ::: "memory");
#pragma unroll
        for (int k = 0; k < 2; ++k) { const int id = min(idx + k * I.NGW, MB * 4 - 1), m = id >> 2, h = id & 3; off[k] = (size_t)m * 2048 + h * 512 + 8 * I.lane;
            a[k] = *(const v4u*)(O0 + off[k]); bq[k] = *(const v4u*)(O1 + off[k]); rr[k] = *(const v4u*)(HB + (size_t)m * LDH + H_GR + h * 512 + 8 * I.lane);
            g0[k] = *(const f32x4*)(ng + h * 512 + 8 * I.lane); g1[k] = *(const f32x4*)(ng + h * 512 + 8 * I.lane + 4); }
        asm volatile("" : "+v"(a[0]), "+v"(a[1]), "+v"(bq[0]), "+v"(bq[1]), "+v"(rr[0]), "+v"(rr[1]), "+v"(g0[0]), "+v"(g0[1]), "+v"(g1[0]), "+v"(g1[1]));
#pragma unroll
        for (int k = 0; k < 2; ++k) {
            float o[8], ob_[8]; unpack8(a[k], o); unpack8(bq[k], ob_);
#pragma unroll
            for (int e = 0; e < 8; ++e) o[e] += ob_[e];
            float ss = 0.f;
#pragma unroll
            for (int e = 0; e < 8; ++e) ss += o[e] * o[e];
            const float rs = 1.f / sqrtf(wave_sum(ss, I.lane) * (1.f / 512.f) + RMS_EPS);
            float r[8]; unpack8(rr[k], r);
            const float gg[8] = {g0[k][0], g0[k][1], g0[k][2], g0[k][3], g1[k][0], g1[k][1], g1[k][2], g1[k][3]};
#pragma unroll
            for (int e = 0; e < 8; ++e) o[e] = o[e] * rs * gg[e] * (r[e] / (1.f + __expf(-r[e])));
            if (idx + k * I.NGW < MB * 4) *(v4u*)(YG + off[k]) = pack8(o);
        }
    }
}

constexpr int NA_RPB_OFF = 15 * 8192;
__device__ __forceinline__ void na_phase(Frame& F, int layer) {
    const Ids I = group_ids(F);
    const bf16* HB = WSB(const bf16, A_HB); const bf16* VT = WSB(const bf16, A_VT); bf16* YN = WSB(bf16, A_YN);
    const float* rpb = INP(4) + (size_t)layer * 16 * 465;
    LAS float* rpbs = (LAS float*)(F.lds + NA_RPB_OFF);
    const int fr = I.lane & 15, q4 = I.lane >> 4;
    const int sb_ = I.lane * 16, swz = sb_ ^ (((sb_ >> 9) & 1) << 5), rl = swz >> 6, cl = (swz & 63) >> 1;
    const int ob = fr * 64 + 16 * q4, lo = ob ^ (((ob >> 9) & 1) << 5);
    for (int it = I.bi; it < 512; it += I.G) {
        const int rblk = it & 7, cblk = (it >> 3) & 3, h = (it >> 5) & 15, b = 0;
        const int r = rblk * 8 + I.wave, c0 = cblk * 16;
        const int krs = min(max(rblk * 8 - 4, 0), 49), rs = min(max(r - 4, 0), 56), cs = min(max(c0 - 8, 0), 32), koff = rs - krs;
        const int mq = b * SEQ + r * 64 + c0 + fr;
        asm volatile("s_waitcnt lgkmcnt(0)" ::: "memory"); __builtin_amdgcn_s_barrier(); asm volatile("" ::: "memory");
#pragma unroll
        for (int i = 0; i < 15; ++i) { const int q = I.wave * 15 + i, kr = q >> 3, pc = q & 7, slab = pc >> 2, j = pc & 3;
            const int key = pg8::perm32((j >> 1) * 16 + rl), col = slab * 64 + (j & 1) * 32 + cl;
            __builtin_amdgcn_global_load_lds((const GAS unsigned*)(HB + (size_t)(b * SEQ + (krs + kr) * 64 + cs + key) * LDH + H_NK + h * 128 + col), (LAS unsigned*)(F.lds + kr * 8192 + pc * 1024), 16, 0, 0); }
        v4u vr[15];
#pragma unroll
        for (int i = 0; i < 15; ++i) { const int q = I.wave * 15 + i, kr = q >> 3, dt = q & 7;
            vr[i] = *(const v4u*)(VT + (size_t)(h * 128 + 16 * dt + rl) * MB + b * SEQ + (krs + kr) * 64 + cs + cl); }
        for (int i = I.tid; i < 465; i += 512) rpbs[i] = rpb[h * 465 + i];
        const bf16* qp = HB + (size_t)mq * LDH + H_NQ + h * 128 + 8 * q4;
        bf16x8 qf[4];
#pragma unroll
        for (int s = 0; s < 4; ++s) qf[s] = *(const bf16x8*)(qp + 32 * s);
        asm volatile("s_waitcnt vmcnt(0) lgkmcnt(0)" ::: "memory"); __builtin_amdgcn_s_barrier(); asm volatile("" ::: "memory");
        const int cq = c0 + fr, ws = min(max(cq - 8, 0), 48);
        f32x4 sc[8][2];
        float mx = -1e30f;
        auto ldk = [&](bf16x8 (&f)[8], float (&bs)[8], int sp) {
            const LAS unsigned char* kb = F.lds + (koff + sp) * 8192 + lo; const int brow = (rs + sp - r + 7) * 31;
#pragma unroll
            for (int u = 0; u < 2; ++u)
#pragma unroll
                for (int s = 0; s < 4; ++s) f[4 * u + s] = *(const LAS bf16x8*)(kb + (s >> 1) * 4096 + (2 * u + (s & 1)) * 1024);
#pragma unroll
            for (int u = 0; u < 2; ++u)
#pragma unroll
                for (int j = 0; j < 4; ++j) { const int kc = cs + 8 * q4 + 4 * u + j; bs[4 * u + j] = rpbs[brow + min(max(kc - cq + 15, 0), 30)]; } };
        auto qk = [&](bf16x8 (&f)[8], float (&bs)[8], int sp) {
            asm volatile("" : "+v"(f[0]), "+v"(f[1]), "+v"(f[2]), "+v"(f[3]), "+v"(f[4]), "+v"(f[5]), "+v"(f[6]), "+v"(f[7]), "+v"(bs[0]), "+v"(bs[1]), "+v"(bs[2]), "+v"(bs[3]), "+v"(bs[4]), "+v"(bs[5]), "+v"(bs[6]), "+v"(bs[7]));
#pragma unroll
            for (int u = 0; u < 2; ++u) { f32x4 d = (f32x4){0.f, 0.f, 0.f, 0.f};
#pragma unroll
                for (int s = 0; s < 4; ++s) d = mfma16(f[4 * u + s], qf[s], d);
#pragma unroll
                for (int j = 0; j < 4; ++j) { const int kc = cs + 8 * q4 + 4 * u + j; const bool valid = (kc >= ws) && (kc < ws + 16);
                    const float v = valid ? d[j] * 0.08838834764831845f + bs[4 * u + j] : -1e30f;
                    sc[sp][u][j] = v; mx = fmaxf(mx, v); } } };
        { bf16x8 fa[8]; float ba[8];
#pragma unroll
          for (int sp = 0; sp < 8; ++sp) { ldk(fa, ba, sp); qk(fa, ba, sp); } }
        mx = fmaxf(mx, shx(mx, 16, I.lane)); mx = fmaxf(mx, shx(mx, 32, I.lane));
        float sum = 0.f;
        bf16x8 pf[8];
#pragma unroll
        for (int sp = 0; sp < 8; ++sp) { float p[8];
#pragma unroll
            for (int u = 0; u < 2; ++u)
#pragma unroll
                for (int j = 0; j < 4; ++j) { const float e = __builtin_amdgcn_exp2f((sc[sp][u][j] - mx) * 1.44269504f); p[4 * u + j] = e; sum += e; }
            const v4u w = pack8(p); pf[sp] = __builtin_bit_cast(bf16x8, w); }
        sum += shx(sum, 16, I.lane); sum += shx(sum, 32, I.lane);
        const float inv = 1.f / sum;
        asm volatile("s_waitcnt lgkmcnt(0)" ::: "memory"); __builtin_amdgcn_s_barrier(); asm volatile("" ::: "memory");
#pragma unroll
        for (int i = 0; i < 15; ++i) { const int q = I.wave * 15 + i, kr = q >> 3, dt = q & 7;
            *(LAS v4u*)(F.lds + kr * 8192 + dt * 1024 + I.lane * 16) = vr[i]; }
        asm volatile("s_waitcnt lgkmcnt(0)" ::: "memory"); __builtin_amdgcn_s_barrier(); asm volatile("" ::: "memory");
        { const float i16 = inv * 16.f;
          auto ldv = [&](bf16x8 (&f)[8], int dt) {
#pragma unroll
              for (int sp = 0; sp < 8; ++sp) f[sp] = *(const LAS bf16x8*)(F.lds + (koff + sp) * 8192 + dt * 1024 + lo); };
          auto pv = [&](bf16x8 (&f)[8], int dt) {
              asm volatile("" : "+v"(f[0]), "+v"(f[1]), "+v"(f[2]), "+v"(f[3]), "+v"(f[4]), "+v"(f[5]), "+v"(f[6]), "+v"(f[7]));
              f32x4 o = (f32x4){0.f, 0.f, 0.f, 0.f};
#pragma unroll
              for (int sp = 0; sp < 8; ++sp) o = mfma16(f[sp], pf[sp], o);
              *(unsigned*)((unsigned char*)YN + (size_t)mq * BW + h * 128 + 16 * dt + 4 * q4) = cvt4_fp8(o[0] * i16, o[1] * i16, o[2] * i16, o[3] * i16); };
          bf16x8 va[8], vb[8];
          ldv(va, 0);
#pragma unroll
          for (int dt = 0; dt < 8; dt += 2) {
              ldv(vb, dt + 1); pv(va, dt);
              if (dt + 2 < 8) ldv(va, dt + 2);
              pv(vb, dt + 1); } }
    }
}

__device__ __forceinline__ float logsigmoid16(float z) { const float e = __builtin_amdgcn_exp2f(-1.44269504f * fabsf(z)); return (fminf(z, 0.f) - 0.69314718f * __builtin_amdgcn_logf(1.0f + e)) * 0.0625f; }
__device__ __forceinline__ void gla_prep_phase(Frame& F, int layer) {
    const Ids I = group_ids(F);
    constexpr int RS = 264;
    LAS bf16* qs = (LAS bf16*)F.lds; LAS bf16* ks = qs + 2 * 64 * RS; LAS float* gas = (LAS float*)(ks + 2 * 64 * RS);
    const bf16* HB = WSB(const bf16, A_HB); const bf16* XBp = WSB(const bf16, A_XB);
    const bf16* WGA = (const bf16*)(kargs()->ws + WS_W + (size_t)layer * SZ_WL + OFF_WIN + WIN_16A) + (size_t)10240 * D;
    bf16* QIN = WSB(bf16, A_QIN); bf16* KOT = WSB(bf16, A_KOT); bf16* ATT = WSB(bf16, A_ATT); float* DEC = WSB(float, A_DEC);
    const float* wdec = INP(5) + (size_t)layer * 2 * 16 * 1024; const float* bdec = INP(6) + (size_t)layer * 2 * 1024;
    const int dir = I.tid >> 8, c = I.tid & 255, fr = I.lane & 15, q4 = I.lane >> 4;
    for (int it2 = I.bi; it2 < 64; it2 += I.G) {
      const int chunk = it2, m0 = chunk * 64;
      __syncthreads();
      { f32x4 ga_acc[4][2];
#pragma unroll
        for (int mt = 0; mt < 4; ++mt)
#pragma unroll
            for (int nt = 0; nt < 2; ++nt) ga_acc[mt][nt] = (f32x4){0.f, 0.f, 0.f, 0.f};
        const bf16* xa = XBp + (size_t)(m0 + fr) * D + I.wave * 512 + 8 * q4; const bf16* wb = WGA + (size_t)fr * D + I.wave * 512 + 8 * q4;
#pragma unroll 1
        for (int kb = 0; kb < 4; ++kb) { bf16x8 af[4][4], bfr[4][2];
#pragma unroll
            for (int kk = 0; kk < 4; ++kk) {
#pragma unroll
                for (int mt = 0; mt < 4; ++mt) af[kk][mt] = *(const bf16x8*)(xa + (size_t)(16 * mt) * D + 32 * (4 * kb + kk));
#pragma unroll
                for (int nt = 0; nt < 2; ++nt) bfr[kk][nt] = *(const bf16x8*)(wb + (size_t)(16 * nt) * D + 32 * (4 * kb + kk)); }
            asm volatile("" : "+v"(af[0][0]), "+v"(af[0][1]), "+v"(af[0][2]), "+v"(af[0][3]), "+v"(af[1][0]), "+v"(af[1][1]), "+v"(af[1][2]), "+v"(af[1][3]),
                              "+v"(af[2][0]), "+v"(af[2][1]), "+v"(af[2][2]), "+v"(af[2][3]), "+v"(af[3][0]), "+v"(af[3][1]), "+v"(af[3][2]), "+v"(af[3][3]),
                              "+v"(bfr[0][0]), "+v"(bfr[0][1]), "+v"(bfr[1][0]), "+v"(bfr[1][1]), "+v"(bfr[2][0]), "+v"(bfr[2][1]), "+v"(bfr[3][0]), "+v"(bfr[3][1]));
#pragma unroll
            for (int kk = 0; kk < 4; ++kk)
#pragma unroll
                for (int mt = 0; mt < 4; ++mt)
#pragma unroll
                    for (int nt = 0; nt < 2; ++nt) ga_acc[mt][nt] = mfma16(af[kk][mt], bfr[kk][nt], ga_acc[mt][nt]); }
        LAS float* part = (LAS float*)F.lds + I.wave * 2048;
#pragma unroll
        for (int mt = 0; mt < 4; ++mt)
#pragma unroll
            for (int nt = 0; nt < 2; ++nt)
#pragma unroll
                for (int j = 0; j < 4; ++j) part[(16 * mt + 4 * q4 + j) * 32 + 16 * nt + fr] = ga_acc[mt][nt][j];
        __syncthreads();
        f32x4 s4 = ((const LAS f32x4*)F.lds)[I.tid];
#pragma unroll
        for (int w8 = 1; w8 < 8; ++w8) s4 += ((const LAS f32x4*)F.lds)[w8 * 512 + I.tid];
        ((LAS f32x4*)gas)[I.tid] = s4; }
      for (int h = 0; h < 4; ++h) {
        const int ch = h * 256 + c;
        __syncthreads();
        float w[16];
#pragma unroll
        for (int r = 0; r < 16; ++r) w[r] = wdec[(dir * 16 + r) * 1024 + ch];
        const float bd = bdec[dir * 1024 + ch];
        __syncthreads();
        const LAS float* ga = gas + dir * 16;
        const bf16* qg = HB + (size_t)m0 * LDH + H_GQ + ch; const bf16* kg = HB + (size_t)m0 * LDH + H_GK + ch;
        float pre[64]; float run = 0.f;
#pragma unroll
        for (int t = 0; t < 64; ++t) { float z = bd;
#pragma unroll
            for (int r = 0; r < 16; ++r) z += ga[t * 32 + r] * w[r];
            run += logsigmoid16(z); pre[t] = run; }
        const float tot = run, dec = __builtin_amdgcn_exp2f(tot * 1.44269504f);
        unsigned ko[32];
        bf16* qo = QIN + ((size_t)dir * MB + m0) * 1024 + ch;
#pragma unroll
        for (int tb = 0; tb < 8; ++tb) { unsigned qr[8], kr[8];
            asm volatile("" ::: "memory");
#pragma unroll
            for (int e = 0; e < 8; ++e) { qr[e] = qg[(size_t)(8 * tb + e) * LDH]; kr[e] = kg[(size_t)(8 * tb + e) * LDH]; }
            asm volatile("" : "+v"(qr[0]), "+v"(qr[1]), "+v"(qr[2]), "+v"(qr[3]), "+v"(qr[4]), "+v"(qr[5]), "+v"(qr[6]), "+v"(qr[7]),
                              "+v"(kr[0]), "+v"(kr[1]), "+v"(kr[2]), "+v"(kr[3]), "+v"(kr[4]), "+v"(kr[5]), "+v"(kr[6]), "+v"(kr[7]));
#pragma unroll
            for (int e2 = 0; e2 < 4; ++e2) { float kov[2];
#pragma unroll
                for (int e = 0; e < 2; ++e) { const int t = 8 * tb + 2 * e2 + e;
                    const float cum = dir == 0 ? pre[t] : tot - (t > 0 ? pre[t > 0 ? t - 1 : 0] : 0.f);
                    const float e1 = __builtin_amdgcn_exp2f(cum * 1.44269504f), einv = __builtin_amdgcn_rcpf(e1);
                    const float qv = __uint_as_float(qr[2 * e2 + e] << 16), kv = __uint_as_float(kr[2 * e2 + e] << 16);
                    const float q_in = qv * 0.0625f * e1, k_in = kv * einv; kov[e] = k_in * dec;
                    const unsigned qb = pk2(q_in, 0.f) & 0xffffu, kb = pk2(k_in, 0.f) & 0xffffu;
                    qs[(dir * 64 + t) * RS + c] = (bf16)qb; ks[(dir * 64 + t) * RS + c] = (bf16)kb; qo[(size_t)t * 1024] = (bf16)qb; }
                ko[4 * tb + e2] = pk2(kov[0], kov[1]); } }
        { v4u* kd = (v4u*)(KOT + ((size_t)dir * 1024 + ch) * MB + m0);
#pragma unroll
            for (int i = 0; i < 8; ++i) { v4u w4; w4.x = ko[4 * i]; w4.y = ko[4 * i + 1]; w4.z = ko[4 * i + 2]; w4.w = ko[4 * i + 3]; kd[i] = w4; } }
        DEC[((size_t)dir * 64 + chunk) * 1024 + ch] = dec;
        __syncthreads();
        { const int adir = I.wave >> 2, mt = I.wave & 3, i = 16 * mt + fr;
          const LAS bf16* qrow = qs + (adir * 64 + i) * RS + 8 * q4;
          bf16* arow = ATT + ((((size_t)adir * 4 + h) * 64 + chunk) * 64 + i) * 64;
#pragma unroll
          for (int nt = 0; nt < 4; ++nt) { const LAS bf16* krow = ks + (adir * 64 + 16 * nt + fr) * RS + 8 * q4;
              f32x4 d = (f32x4){0.f, 0.f, 0.f, 0.f};
#pragma unroll
              for (int s = 0; s < 8; ++s) d = mfma16(*(const LAS bf16x8*)(krow + 32 * s), *(const LAS bf16x8*)(qrow + 32 * s), d);
              const int j0 = 16 * nt + 4 * q4; float v[4];
#pragma unroll
              for (int jj = 0; jj < 4; ++jj) { const bool keep = adir == 0 ? (j0 + jj <= i) : (j0 + jj >= i); v[jj] = keep ? d[jj] : 0.f; }
              v2u w2; w2.x = pk2(v[0], v[1]); w2.y = pk2(v[2], v[3]); *(v2u*)(arow + j0) = w2; } }
      }
    }
}
constexpr int SCAN_Q = 0, SCAN_K = 32768, SCAN_A = 65536, SCAN_D = 73728, SCAN_BUF = 74752;
__device__ __forceinline__ void scan_stage(const bf16* QIN, const bf16* KOT, const bf16* ATT, const float* DEC, LAS unsigned char* buf, int lw, int lane, int dir, int h, int c) {
    const int m0 = c * 64;
    const int sb_ = lane * 16, swz = sb_ ^ (((sb_ >> 9) & 1) << 5), rl = swz >> 6, cl = (swz & 63) >> 1;
#pragma unroll
    for (int i = 0; i < 8; ++i) { const int q = lw * 8 + i, sl = q >> 3, j = q & 7, R = (j >> 1) * 16 + rl, C = (j & 1) * 32 + cl;
        __builtin_amdgcn_global_load_lds((const GAS unsigned*)(QIN + ((size_t)dir * MB + m0 + R) * 1024 + h * 256 + sl * 64 + C), (LAS unsigned*)(buf + SCAN_Q + sl * 8192 + j * 1024), 16, 0, 0); }
#pragma unroll
    for (int i = 0; i < 8; ++i) { const int k = lw * 8 + i, hh = k >> 4, j = k & 15, Rg = 128 * hh + (j >> 1) * 16 + rl, C = (j & 1) * 32 + cl, Rb = (Rg & ~31) + pg8::perm32(Rg & 31);
        __builtin_amdgcn_global_load_lds((const GAS unsigned*)(KOT + ((size_t)dir * 1024 + h * 256 + Rb) * MB + m0 + C), (LAS unsigned*)(buf + SCAN_K + hh * 16384 + j * 1024), 16, 0, 0); }
    const bf16* ab = ATT + (((size_t)dir * 4 + h) * 64 + c) * 4096;
#pragma unroll
    for (int i = 0; i < 2; ++i) { const int j = lw * 2 + i, R = (j >> 1) * 16 + rl, C = (j & 1) * 32 + cl;
        __builtin_amdgcn_global_load_lds((const GAS unsigned*)(ab + R * 64 + C), (LAS unsigned*)(buf + SCAN_A + j * 1024), 16, 0, 0); }
    if (lw == 0) __builtin_amdgcn_global_load_lds((const GAS unsigned*)(DEC + ((size_t)dir * 64 + c) * 1024 + h * 256 + lane * 4), (LAS unsigned*)(buf + SCAN_D), 16, 0, 0);
}
__device__ __forceinline__ void scan_load(v4u (&R)[19], const bf16* QIN, const bf16* KOT, const bf16* ATT, const float* DEC, int lw, int lane, int dir, int h, int c) {
    const int m0 = c * 64;
    const int sb_ = lane * 16, swz = sb_ ^ (((sb_ >> 9) & 1) << 5), rl = swz >> 6, cl = (swz & 63) >> 1;
#pragma unroll
    for (int i = 0; i < 8; ++i) { const int q = lw * 8 + i, sl = q >> 3, j = q & 7, Rr = (j >> 1) * 16 + rl, C = (j & 1) * 32 + cl;
        R[i] = *(const v4u*)(QIN + ((size_t)dir * MB + m0 + Rr) * 1024 + h * 256 + sl * 64 + C); }
#pragma unroll
    for (int i = 0; i < 8; ++i) { const int k = lw * 8 + i, hh = k >> 4, j = k & 15, Rg = 128 * hh + (j >> 1) * 16 + rl, C = (j & 1) * 32 + cl, Rb = (Rg & ~31) + pg8::perm32(Rg & 31);
        R[8 + i] = *(const v4u*)(KOT + ((size_t)dir * 1024 + h * 256 + Rb) * MB + m0 + C); }
    const bf16* ab = ATT + (((size_t)dir * 4 + h) * 64 + c) * 4096;
#pragma unroll
    for (int i = 0; i < 2; ++i) { const int j = lw * 2 + i, Rr = (j >> 1) * 16 + rl, C = (j & 1) * 32 + cl; R[16 + i] = *(const v4u*)(ab + Rr * 64 + C); }
    R[18] = *(const v4u*)(DEC + ((size_t)dir * 64 + c) * 1024 + h * 256 + lane * 4);
}
__device__ __forceinline__ void scan_write(const v4u (&R)[19], LAS unsigned char* buf, int lw, int lane) {
#pragma unroll
    for (int i = 0; i < 8; ++i) { const int q = lw * 8 + i, sl = q >> 3, j = q & 7; *(LAS v4u*)(buf + SCAN_Q + sl * 8192 + j * 1024 + lane * 16) = R[i]; }
#pragma unroll
    for (int i = 0; i < 8; ++i) { const int k = lw * 8 + i, hh = k >> 4, j = k & 15; *(LAS v4u*)(buf + SCAN_K + hh * 16384 + j * 1024 + lane * 16) = R[8 + i]; }
#pragma unroll
    for (int i = 0; i < 2; ++i) { const int j = lw * 2 + i; *(LAS v4u*)(buf + SCAN_A + j * 1024 + lane * 16) = R[16 + i]; }
    if (lw == 0) *(LAS v4u*)(buf + SCAN_D + lane * 16) = R[18];
}
__device__ __forceinline__ void gla_scan_phase(Frame& F) {
    const Ids I = group_ids(F);
    const bf16* VT = WSB(const bf16, A_VT); const bf16* QIN = WSB(const bf16, A_QIN); const bf16* KOT = WSB(const bf16, A_KOT); const bf16* ATT = WSB(const bf16, A_ATT);
    const float* DEC = WSB(const float, A_DEC); bf16* O = WSB(bf16, A_O);
    const int fr = I.lane & 15, q4 = I.lane >> 4;
    for (int bt = I.bi; bt < 64; bt += I.G) {
        const int x = bt & 1, y = bt >> 1, sc = x * 4 + (y >> 3), eq = y & 7;
        const int dir = sc & 1, h = sc >> 1;
        asm volatile("s_waitcnt vmcnt(0) lgkmcnt(0)" ::: "memory"); __builtin_amdgcn_s_barrier(); asm volatile("" ::: "memory");
        if (I.wave >= 4) {
            const int lw = I.wave - 4;
            v4u R[19];
            scan_stage(QIN, KOT, ATT, DEC, F.lds, lw, I.lane, dir, h, dir ? 63 : 0);
            asm volatile("s_waitcnt vmcnt(0)" ::: "memory");
            scan_load(R, QIN, KOT, ATT, DEC, lw, I.lane, dir, h, dir ? 62 : 1);
            __builtin_amdgcn_s_barrier(); asm volatile("" ::: "memory");
#pragma unroll 1
            for (int step = 0; step < 64; ++step) {
                if (step + 1 < 64) scan_write(R, F.lds + ((step + 1) & 1) * SCAN_BUF, lw, I.lane);
                asm volatile("" ::: "memory");
                if (step + 2 < 64) scan_load(R, QIN, KOT, ATT, DEC, lw, I.lane, dir, h, dir ? 61 - step : step + 2);
                asm volatile("s_waitcnt lgkmcnt(0)" ::: "memory"); __builtin_amdgcn_s_barrier(); asm volatile("" ::: "memory");
            }
        } else {
            const int es = eq * 4 + I.wave;
            f32x4 st[16];
#pragma unroll
            for (int t = 0; t < 16; ++t) st[t] = (f32x4){0.f, 0.f, 0.f, 0.f};
            const bf16* vrow = VT + (size_t)(2048 + h * 512 + es * 16 + fr) * MB + 8 * q4;
            const int ob = fr * 64 + 16 * q4, lo = ob ^ (((ob >> 9) & 1) << 5);
            bf16x8 vf[2];
            { const int c0 = dir ? 63 : 0;
#pragma unroll
              for (int sp = 0; sp < 2; ++sp) vf[sp] = *(const bf16x8*)(vrow + c0 * 64 + 32 * sp); }
            asm volatile("" ::: "memory"); __builtin_amdgcn_s_barrier(); asm volatile("" ::: "memory");
            for (int step = 0; step < 64; ++step) {
                const int c = dir ? 63 - step : step, m0 = c * 64;
                const LAS unsigned char* bb = F.lds + (step & 1) * SCAN_BUF + lo;
                bf16x8 vn[2];
                { const int cn = step + 1 < 64 ? (dir ? 62 - step : step + 1) : c;
#pragma unroll
                  for (int sp = 0; sp < 2; ++sp) vn[sp] = *(const bf16x8*)(vrow + cn * 64 + 32 * sp); }
                bf16x8 sb[8];
#pragma unroll
                for (int s = 0; s < 8; ++s) { v4u w; w.x = pk2(st[2 * s][0], st[2 * s][1]); w.y = pk2(st[2 * s][2], st[2 * s][3]); w.z = pk2(st[2 * s + 1][0], st[2 * s + 1][1]); w.w = pk2(st[2 * s + 1][2], st[2 * s + 1][3]); sb[s] = __builtin_bit_cast(bf16x8, w); }
                const LAS unsigned char* dbase = F.lds + (step & 1) * SCAN_BUF + SCAN_D + 32 * q4;
                auto ldq = [&](bf16x8 (&f)[10], int mt) {
#pragma unroll
                    for (int s = 0; s < 8; ++s) f[s] = *(const LAS bf16x8*)(bb + SCAN_Q + (s >> 1) * 8192 + (2 * mt + (s & 1)) * 1024);
#pragma unroll
                    for (int sp = 0; sp < 2; ++sp) f[8 + sp] = *(const LAS bf16x8*)(bb + SCAN_A + (2 * mt + sp) * 1024); };
                auto doq = [&](bf16x8 (&f)[10], int mt) {
                    asm volatile("" : "+v"(f[0]), "+v"(f[1]), "+v"(f[2]), "+v"(f[3]), "+v"(f[4]), "+v"(f[5]), "+v"(f[6]), "+v"(f[7]), "+v"(f[8]), "+v"(f[9]));
                    f32x4 o = (f32x4){0.f, 0.f, 0.f, 0.f};
#pragma unroll
                    for (int s = 0; s < 8; ++s) o = mfma16(sb[s], f[s], o);
#pragma unroll
                    for (int sp = 0; sp < 2; ++sp) o = mfma16(vf[sp], f[8 + sp], o);
                    { v2u w; w.x = pk2_sw(o[0], o[1]); w.y = pk2_sw(o[2], o[3]); *(v2u*)(O + ((size_t)dir * MB + m0 + 16 * mt + fr) * 2048 + h * 512 + es * 16 + 4 * q4) = w; } };
                auto ldk = [&](bf16x8 (&f)[4], f32x4 (&d)[2], int g) {
#pragma unroll
                    for (int i = 0; i < 2; ++i) { const int t = 2 * g + i, s = t >> 1, u = t & 1;
                        d[i] = *(const LAS f32x4*)(dbase + (32 * s + 4 * u) * 4);
#pragma unroll
                        for (int sp = 0; sp < 2; ++sp) f[2 * i + sp] = *(const LAS bf16x8*)(bb + SCAN_K + (s >> 2) * 16384 + ((2 * (s & 3) + u) * 2 + sp) * 1024); } };
                auto dok = [&](bf16x8 (&f)[4], f32x4 (&d)[2], int g) {
                    asm volatile("" : "+v"(f[0]), "+v"(f[1]), "+v"(f[2]), "+v"(f[3]), "+v"(d[0]), "+v"(d[1]));
#pragma unroll
                    for (int i = 0; i < 2; ++i) { const int t = 2 * g + i; f32x4 a = st[t] * d[i];
#pragma unroll
                        for (int sp = 0; sp < 2; ++sp) a = mfma16(f[2 * i + sp], vf[sp], a);
                        st[t] = a; } };
                { bf16x8 qa[10], qb[10], ka[4], kb[4]; f32x4 da[2], db[2];
                  ldq(qa, 0);
                  ldq(qb, 1); doq(qa, 0);
                  ldq(qa, 2); doq(qb, 1);
                  ldq(qb, 3); doq(qa, 2);
                  ldk(ka, da, 0); doq(qb, 3);
#pragma unroll
                  for (int g = 0; g < 8; g += 2) { ldk(kb, db, g + 1); dok(ka, da, g); if (g + 2 < 8) ldk(ka, da, g + 2); dok(kb, db, g + 1); } }
                vf[0] = vn[0]; vf[1] = vn[1];
                asm volatile("s_waitcnt lgkmcnt(0)" ::: "memory"); __builtin_amdgcn_s_barrier(); asm volatile("" ::: "memory");
            }
        }
    }
}

#ifndef PG8_SP2
#define PG8_SP2 true
#endif
#ifndef PG8_ALIGN
#define PG8_ALIGN true
#endif
struct GroupOrder {
    int nA, nB, r, p, swapped;
    __device__ void init(int nB_, int gb, int swapped_) { nB = nB_; r = gb >> 1; p = gb & 1; swapped = swapped_; nA = 8; }
    __device__ bool next(int i, pg8::Unit& u) const {
        const int L = i * 32 + r;
        if (!swapped) { if (L >= 8 * nB) return false; u.pm = 8 * p + (L & 7); u.pn = L >> 3; return true; }
        if (L >= 64) return false; u.pn = 8 * p + (L & 7); u.pm = L >> 3; return true;
    }
    __device__ __forceinline__ void a_ready(const pg8::Unit&) const {}
    __device__ __forceinline__ void done(const pg8::Unit&) const {}
};
__global__ void __launch_bounds__(NWAVES * 64, 2) enc_fwd(Args args) {
    extern __shared__ __attribute__((aligned(16))) unsigned char lds[];
    Frame F;
    F.lds = (LAS unsigned char*)lds; F.wv = __builtin_amdgcn_readfirstlane(threadIdx.x >> 6);
    { const int bx = blockIdx.x; F.grp = (bx & 7) >> 1; F.gb = ((bx >> 3) << 1) | (bx & 1); }
    volatile LAS unsigned* MISC = (volatile LAS unsigned*)(F.lds + MISC_OFF);
    if (threadIdx.x < 128) MISC[threadIdx.x] = 0u;
    __syncthreads();
    { unsigned* ctl = (unsigned*)(GAS unsigned*)(args.ws + WS_CTL);
      (void)xcd_barrier_post(ctl + CW_BAR, MISC + 8);
      (void)xcd_barrier_post(ctl + CW_BAR + (1 + F.grp) * XCD_BAR_WORDS, MISC + 12); }
#define GRID_BAR() do { XcdBarrier bb; bb.wv = (unsigned)F.wv; bb.G = gridDim.x; bb.bar = (unsigned*)(GAS unsigned*)(kargs()->ws + WS_CTL) + CW_BAR; bb.x = (unsigned)__builtin_amdgcn_readfirstlane((int)xb_xcc_id()); bb.st = (volatile LAS unsigned*)(F.lds + MISC_OFF) + 8; xcd_barrier(bb); } while (0)
#define SEAM() do { XcdBarrier bb; bb.wv = (unsigned)F.wv; bb.G = 64u; bb.bar = (unsigned*)(GAS unsigned*)(kargs()->ws + WS_CTL) + CW_BAR + (1 + F.grp) * XCD_BAR_WORDS; bb.x = (unsigned)__builtin_amdgcn_readfirstlane((int)xb_xcc_id()); bb.st = (volatile LAS unsigned*)(F.lds + MISC_OFF) + 12; xcd_barrier(bb); } while (0)
    LAS unsigned char* ring = F.lds;

#ifndef GROUP_STAGGER
#define GROUP_STAGGER 0
#endif
#if GROUP_STAGGER
    p0_prologue_a(F);
    GRID_BAR();
    if (F.grp != 0) p0_prologue_b(F);
#else
    p0_prologue_full(F);
    GRID_BAR();
#ifndef GROUP_DELAY_TICKS
#define GROUP_DELAY_TICKS 0
#endif
    if (GROUP_DELAY_TICKS) { const unsigned long long t0 = __builtin_amdgcn_s_memrealtime(), dl = (unsigned long long)F.grp * GROUP_DELAY_TICKS;
        while (__builtin_amdgcn_s_memrealtime() - t0 < dl) __builtin_amdgcn_s_sleep(32); }
#endif

    for (int layer = 0; layer < DEPTH; ++layer) {
#define WL ((unsigned char*)(kargs()->ws + WS_W + (size_t)layer * SZ_WL))
        const pg8::bf16_t* XB = WSB(const pg8::bf16_t, A_XB);
        if (GROUP_STAGGER && layer == 1) wait_weights(F);
        { const unsigned char* WB = WL + OFF_WIN;
          { pg8::Gemm g{XB, (const pg8::bf16_t*)(WB + WIN_16A), MB, 10240, D}; GroupOrder S; S.init(40, F.gb, 0);
            pg8::EpiConvIn E{WSB(pg8::bf16_t, A_HB), LDH, WSB(pg8::bf16_t, A_YC), WSB(float, A_HALOC), INP(3) + (size_t)layer * 3 * BW, F.lds + RING_BYTES + 4096};
            pg8::gemm_phase<pg8::EpiConvIn, GroupOrder, PG8_ALIGN, PG8_SP2>(ring, g, S, E, F.wv); }
          { pg8::Gemm g{WSB(const pg8::bf16_t, A_XB8), (const pg8::bf16_t*)(WB + WIN_8A), MB, N8A, D / 2}; GroupOrder S; S.init(64, F.gb, 0);
            pg8::EpiF8 E{WSB(pg8::bf16_t, A_HB), LDH, WSB(pg8::bf16_t, A_GATES), INP(2) + (size_t)layer * 3 * D, 0.015625f};
            pg8::gemm_phase<pg8::EpiF8, GroupOrder, PG8_ALIGN, PG8_SP2, true>(ring, g, S, E, F.wv); }
          { pg8::Gemm g{(const pg8::bf16_t*)(WB + WIN_16V), XB, N16V, MB, D}; GroupOrder S; S.init(16, F.gb, 1);
            pg8::EpiBf16 E{WSB(pg8::bf16_t, A_VT) + (size_t)2048 * MB, MB, 1.f};
            pg8::gemm_phase<pg8::EpiBf16, GroupOrder, PG8_ALIGN, PG8_SP2>(ring, g, S, E, F.wv); }
          { pg8::Gemm g{(const pg8::bf16_t*)(WB + WIN_8V), WSB(const pg8::bf16_t, A_XB8), N8V, MB, D / 2}; GroupOrder S; S.init(16, F.gb, 1);
            pg8::EpiBf16 E{WSB(pg8::bf16_t, A_VT), MB, 0.015625f};
            pg8::gemm_phase<pg8::EpiBf16, GroupOrder, PG8_ALIGN, PG8_SP2, true>(ring, g, S, E, F.wv); } }
        SEAM();
        conv_fix_phase(F, layer); gla_prep_phase(F, layer); na_phase(F, layer); SEAM();
        gla_scan_phase(F); SEAM();
        gla_combine_phase(F, layer); SEAM();
        if (GROUP_STAGGER && layer == 0) wait_weights(F);
        { GroupOrder S; S.init(16, F.gb, 0);
          { pg8::Gemm g{WSB(const pg8::bf16_t, A_YC), (const pg8::bf16_t*)(WL + OFF_WBR), MB, D, BW};
            pg8::EpiBranch<0> E{WSB(pg8::bf16_t, A_MIXED), WSB(const pg8::bf16_t, A_GATES), 1.f}; pg8::gemm_phase<pg8::EpiBranch<0>, GroupOrder, PG8_ALIGN, PG8_SP2>(ring, g, S, E, F.wv); }
          { pg8::Gemm g{WSB(const pg8::bf16_t, A_YN), (const pg8::bf16_t*)(WL + OFF_WBR) + (size_t)D * BW, MB, D, BW / 2};
            pg8::EpiBranch<1> E{WSB(pg8::bf16_t, A_MIXED), WSB(const pg8::bf16_t, A_GATES), 1.f / 1024.f}; pg8::gemm_phase<pg8::EpiBranch<1>, GroupOrder, PG8_ALIGN, PG8_SP2, true>(ring, g, S, E, F.wv); }
          { pg8::Gemm g{WSB(const pg8::bf16_t, A_YG), (const pg8::bf16_t*)(WL + OFF_WBR) + (size_t)2 * D * BW, MB, D, BW};
            pg8::EpiBranch<2> E{WSB(pg8::bf16_t, A_MIXED), WSB(const pg8::bf16_t, A_GATES), 1.f}; pg8::gemm_phase<pg8::EpiBranch<2>, GroupOrder, PG8_ALIGN, PG8_SP2>(ring, g, S, E, F.wv); } }
        SEAM();
        { pg8::Gemm g{WSB(const pg8::bf16_t, A_MIXED), (const pg8::bf16_t*)(WL + OFF_WO), MB, D, D}; GroupOrder S; S.init(16, F.gb, 0);
          if (layer == 0) { pg8::EpiResid<false> E{WSB(float, A_XR), INP(0) + (size_t)F.grp * MB * D, D, ALPHA, 0, 0, 0u, 0ull}; pg8::gemm_phase<pg8::EpiResid<false>, GroupOrder, PG8_ALIGN, PG8_SP2>(ring, g, S, E, F.wv); }
          else { pg8::EpiResid<true> E{WSB(float, A_XR), WSB(const float, A_XR), D, ALPHA, 16, 17, (unsigned)((layer - 1) * D), (unsigned long long)(WS_ARENA + (size_t)F.grp * ARENA + A_ST)};
                 pg8::gemm_phase<pg8::EpiResid<true>, GroupOrder, PG8_ALIGN, PG8_SP2>(ring, g, S, E, F.wv); } }
        SEAM();
#ifndef REP_LN
#define REP_LN 1
#endif
        for (int rep_ = 0; rep_ < REP_LN; ++rep_) ln_phase(F, WSB(const float, A_XR), INP(10) + (size_t)layer * D, INP(11) + (size_t)layer * D, nullptr, WSB(bf16, A_XB), nullptr, WSB(float, A_ST)); SEAM();
        { pg8::Gemm g{XB, (const pg8::bf16_t*)(WL + OFF_WFI), MB, 2 * FF, D}; GroupOrder S; S.init(86, F.gb, 0);
          pg8::EpiGlu E{WSB(pg8::bf16_t, A_G), WSB(float, A_HALO), INP(13) + (size_t)layer * 3 * FF, INP(14) + (size_t)layer * FF, F.lds + RING_BYTES};
          pg8::gemm_phase<pg8::EpiGlu, GroupOrder, PG8_ALIGN, PG8_SP2>(ring, g, S, E, F.wv); }
        SEAM();
        convglu_fix_phase(F, layer); SEAM();
        { pg8::Gemm g{WSB(const pg8::bf16_t, A_G), (const pg8::bf16_t*)(WL + OFF_WFO), MB, D, FF}; GroupOrder S; S.init(16, F.gb, 0);
          pg8::EpiResid<true> E{WSB(float, A_XR), WSB(const float, A_XR), D, ALPHA, 10, 11, (unsigned)(layer * D), (unsigned long long)(WS_ARENA + (size_t)F.grp * ARENA + A_ST)};
          pg8::gemm_phase<pg8::EpiResid<true>, GroupOrder, PG8_ALIGN, PG8_SP2>(ring, g, S, E, F.wv); }
        SEAM();
        if (layer == DEPTH - 1) ln_phase(F, WSB(const float, A_XR), INP(16) + (size_t)layer * D, INP(17) + (size_t)layer * D, OUTP + (size_t)F.grp * MB * D, nullptr, nullptr, nullptr);
        else { ln_phase(F, WSB(const float, A_XR), INP(16) + (size_t)layer * D, INP(17) + (size_t)layer * D, nullptr, WSB(bf16, A_XB), WSB(bf16, A_XB8), WSB(float, A_ST)); SEAM(); }
    }
#undef SEAM
#undef GRID_BAR
}

extern "C" void kernel_launch(void* const* d_in, const int* in_sizes, int n_in, void* d_out, int out_size, void* d_ws, size_t ws_size, hipStream_t stream) {
    static int grid = 0;
    if (grid == 0) {
        if (n_in != 18 || in_sizes[0] != M * D || out_size != M * D || ws_size < WS_END) { fprintf(stderr, "kernel_launch: unexpected sizes: n_in %d in0 %d out %d ws %zu (need %zu); nothing launched\n", n_in, n_in > 0 ? in_sizes[0] : -1, out_size, ws_size, (size_t)WS_END); grid = -1; return; }
        int dev = 0, cus = 0, per_cu = 0;
        if (hipGetDevice(&dev) != hipSuccess || hipDeviceGetAttribute(&cus, hipDeviceAttributeMultiprocessorCount, dev) != hipSuccess) { grid = -1; return; }
        if (hipFuncSetAttribute((const void*)enc_fwd, hipFuncAttributeMaxDynamicSharedMemorySize, LDS_BYTES) != hipSuccess) { fprintf(stderr, "kernel_launch: hipFuncSetAttribute failed\n"); grid = -1; return; }
        if (hipOccupancyMaxActiveBlocksPerMultiprocessor(&per_cu, (const void*)enc_fwd, NWAVES * 64, LDS_BYTES) != hipSuccess || per_cu < 1) { fprintf(stderr, "kernel_launch: occupancy query reports %d workgroups per CU\n", per_cu); grid = -1; (void)hipGetLastError(); return; }
        (void)hipGetLastError();
        grid = cus;
        if (grid != 256) { fprintf(stderr, "kernel_launch: built for a 256-CU device (4 groups of 64 workgroups), found %d CUs; nothing launched\n", cus); grid = -1; return; }
    }
    if (grid < 0) return;
    if (hipMemsetAsync((char*)d_ws + WS_CTL, 0, CTL_ZERO_BYTES, stream) != hipSuccess) return;
    Args a{};
    for (int i = 0; i < 18; ++i) a.in[i] = (GAS const float*)d_in[i];
    a.out = (GAS float*)d_out; a.ws = (GAS unsigned char*)d_ws;
    a.ph_lo = 0; a.ph_hi = N_PHASES;
    hipLaunchKernelGGL(enc_fwd, dim3(grid), dim3(NWAVES * 64), LDS_BYTES, stream, a);
}
```

```cpp
#include <hip/hip_runtime.h>
#include <cstdio>
#include <cstdint>
#ifndef GAS
#define GAS __attribute__((address_space(1)))
#endif
struct Args { GAS const float* in[18]; GAS float* out; GAS unsigned char* ws; int ph_lo, ph_hi; };
typedef __attribute__((address_space(4))) const Args CArgs;
__device__ __forceinline__ CArgs* kargs() { CArgs* p = (CArgs*)__builtin_amdgcn_kernarg_segment_ptr(); asm volatile("" : "+s"(p)); return p; }
#define INP(i) ((const float*)kargs()->in[i])
#define OUTP ((float*)kargs()->out)

namespace pg8 {
#define PG8_LAS __attribute__((address_space(3)))
typedef unsigned short bf16_t;
typedef short bf16x8 __attribute__((ext_vector_type(8)));
typedef float f32x4 __attribute__((ext_vector_type(4)));
typedef unsigned u32x4 __attribute__((ext_vector_type(4)));
constexpr int BM = 256, BK = 64, HALF = 128, HTB = HALF * BK * 2  , STAGE_BYTES = 8 * HTB, NXCD = 8, WGM = 8;

__host__ __device__ __forceinline__ int lds_byte(int r, int c) { const int st = (r >> 4) * 2 + (c >> 5), rr = r & 15, cc = c & 31, ob = rr * 64 + cc * 2; return st * 1024 + (ob ^ (((ob >> 9) & 1) << 5)); }
__host__ __device__ __forceinline__ void stage_rc(int b, int& R, int& C) { const int st = b / 1024, sb = b % 1024, swz = sb ^ (((sb >> 9) & 1) << 5); R = (st >> 1) * 16 + swz / 64; C = (st & 1) * 32 + (swz % 64) / 2; }
__host__ __device__ __forceinline__ int perm32(int rho) { const int n = rho >> 4, i = rho & 15; return 8 * (i >> 2) + 4 * n + (i & 3); }

#ifndef PG8_ROT
#define PG8_ROT 0
#endif
struct Unit { int pm, pn; };
struct Gemm { const bf16_t* A; const bf16_t* Bt; int M, N, K; };

struct StaticOrder {
    int nM, nN, nwg, G, c;
    __host__ __device__ void init(int M, int N, int G_, int c_) { nM = M / BM; nN = N / BM; nwg = nM * nN; G = G_; c = c_; }
    __host__ __device__ bool next(int i, Unit& u) const {
        const long L = (long)i * G + c; if (L >= nwg) return false;
        int wgid = (int)L; { const int q = nwg / NXCD, r = nwg % NXCD, xcd = wgid % NXCD, off = wgid / NXCD; wgid = (xcd < r ? xcd * (q + 1) : r * (q + 1) + (xcd - r) * q) + off; }
        const int nig = WGM * nN, gid = wgid / nig, fm = gid * WGM, gsz = (nM - fm) < WGM ? (nM - fm) : WGM;
        u.pm = fm + ((wgid % nig) % gsz); u.pn = (wgid % nig) / gsz;
        if (PG8_ROT) { const int step = nN / NXCD > 0 ? nN / NXCD : 1; u.pn = (u.pn + step * gid) % nN; }
        return true;
    }
    __device__ __forceinline__ void a_ready(const Unit&) const {}
    __device__ __forceinline__ void done(const Unit&) const {}
};

__device__ __forceinline__ unsigned cvt_pk_bf16(float lo, float hi) { unsigned r; asm volatile("s_nop 1\n\tv_cvt_pk_bf16_f32 %0, %1, %2" : "=v"(r) : "v"(lo), "v"(hi)); return r; }
typedef float f32x2 __attribute__((ext_vector_type(2)));
__device__ __forceinline__ f32x2 gelu_pk(f32x2 v) {
    const f32x2 av = __builtin_elementwise_abs(v), d = av * 0.2316418882f + 1.0f;
    f32x2 t; t.x = __builtin_amdgcn_rcpf(d.x); t.y = __builtin_amdgcn_rcpf(d.y);
    f32x2 q = t * 0.5307027145f + (-0.7265760135f); q = q * t + 0.7107068705f; q = q * t + (-0.142248368f); q = q * t + 0.127414796f; q = q * t;
    const f32x2 s = (v * v) * (-0.72134752044f);
    f32x2 e; e.x = __builtin_amdgcn_exp2f(s.x); e.y = __builtin_amdgcn_exp2f(s.y);
    const f32x2 m = v * (q * e), r = v - m;
    f32x2 o; o.x = v.x < 0.f ? m.x : r.x; o.y = v.y < 0.f ? m.y : r.y; return o;
}

__device__ __forceinline__ float bf_lo(unsigned w) { return __uint_as_float(w << 16); }
__device__ __forceinline__ float bf_hi(unsigned w) { return __uint_as_float(w & 0xffff0000u); }
__device__ __forceinline__ float sigmoidf_fast(float v) { return __builtin_amdgcn_rcpf(1.0f + __builtin_amdgcn_exp2f(-1.44269504f * v)); }

template <bool NT = false> struct EpiBf16T {
    static constexpr bool PERM = true, AFTER_DRAIN = false;
    bf16_t* O; int ldc; float sc;
    __device__ __forceinline__ void operator()(const f32x4 (&acc)[2][2][4][2], const Unit& u, int wr, int wc, int fr, int fq) const {
        asm volatile("" : "+v"(fr), "+v"(fq));
        const int row0 = u.pm * BM + wr * 64 + fr, col0 = u.pn * BM + wc * 32 + 8 * fq;
#pragma unroll
        for (int ai = 0; ai < 2; ++ai)
#pragma unroll
            for (int m = 0; m < 4; ++m) { bf16_t* rowp = O + (size_t)(row0 + ai * HALF + m * 16) * ldc + col0;
#pragma unroll
                for (int bj = 0; bj < 2; ++bj) { const f32x4 v0 = acc[ai][bj][m][0] * sc, v1 = acc[ai][bj][m][1] * sc;
                    u32x4 w; w.x = cvt_pk_bf16(v0[0], v0[1]); w.y = cvt_pk_bf16(v0[2], v0[3]); w.z = cvt_pk_bf16(v1[0], v1[1]); w.w = cvt_pk_bf16(v1[2], v1[3]);
                    if (NT) __builtin_nontemporal_store(w, (u32x4*)(rowp + bj * HALF)); else *(u32x4*)(rowp + bj * HALF) = w; } }
    }
};
typedef EpiBf16T<false> EpiBf16;
template <int CTRL> __device__ __forceinline__ float dppf(float old, float src) { return __builtin_bit_cast(float, __builtin_amdgcn_update_dpp(__builtin_bit_cast(int, old), __builtin_bit_cast(int, src), CTRL, 0xf, 0xf, false)); }
typedef unsigned u32x2 __attribute__((ext_vector_type(2)));
struct EpiConvIn {
    static constexpr bool PERM = true, AFTER_DRAIN = false;
    bf16_t* HB; int ldh; bf16_t* YC; float* HALO; const float* wconv; PG8_LAS unsigned char* br;
    __device__ __forceinline__ void operator()(const f32x4 (&acc)[2][2][4][2], const Unit& u, int wr, int wc, int fr, int fq) const {
        asm volatile("" : "+v"(fr), "+v"(fq));
        const int row0 = u.pm * BM + wr * 64 + fr;
        if (u.pn >= 32) {
            const int col0 = 10240 + (u.pn - 32) * BM + wc * 32 + 8 * fq;
#pragma unroll
            for (int ai = 0; ai < 2; ++ai)
#pragma unroll
                for (int m = 0; m < 4; ++m) { bf16_t* rowp = HB + (size_t)(row0 + ai * HALF + m * 16) * ldh + col0;
#pragma unroll
                    for (int bj = 0; bj < 2; ++bj) { const f32x4 v0 = acc[ai][bj][m][0], v1 = acc[ai][bj][m][1];
                        u32x4 w; w.x = cvt_pk_bf16(v0[0], v0[1]); w.y = cvt_pk_bf16(v0[2], v0[3]); w.z = cvt_pk_bf16(v1[0], v1[1]); w.w = cvt_pk_bf16(v1[2], v1[3]);
                        *(u32x4*)(rowp + bj * HALF) = w; } }
            return;
        }
        const int chl = 16 * wc + 4 * fq, ch = u.pn * 64 + chl;
        PG8_LAS float* BR = (PG8_LAS float*)br;
        f32x4 p[2][4];
#pragma unroll
        for (int ai = 0; ai < 2; ++ai)
#pragma unroll
            for (int m = 0; m < 4; ++m) p[ai][m] = acc[ai][0][m][1] * acc[ai][1][m][0];
#pragma unroll
        for (int ai = 0; ai < 2; ++ai) { const int q = 2 * ai + wr;
            if (fr == 0) *(PG8_LAS f32x4*)(BR + (0 * 4 + q) * 64 + chl) = p[ai][0];
            if (fr == 15) *(PG8_LAS f32x4*)(BR + (1 * 4 + q) * 64 + chl) = p[ai][3]; }
        asm volatile("s_waitcnt lgkmcnt(0)" ::: "memory"); __builtin_amdgcn_s_barrier(); asm volatile("" ::: "memory");
        const f32x4 w0 = *(const f32x4*)(wconv + ch), w1 = *(const f32x4*)(wconv + 2048 + ch), w2 = *(const f32x4*)(wconv + 4096 + ch);
#pragma unroll
        for (int ai = 0; ai < 2; ++ai) { const int q = 2 * ai + wr;
            const f32x4 xup = q > 0 ? *(const PG8_LAS f32x4*)(BR + (1 * 4 + (q - 1)) * 64 + chl) : (f32x4){0.f, 0.f, 0.f, 0.f};
            const f32x4 xdn = q < 3 ? *(const PG8_LAS f32x4*)(BR + (0 * 4 + (q + 1)) * 64 + chl) : (f32x4){0.f, 0.f, 0.f, 0.f};
#pragma unroll
            for (int m = 0; m < 4; ++m) { const int r = 128 * ai + 64 * wr + 16 * m + fr; const size_t row = (size_t)u.pm * BM + r;
                f32x4 part;
#pragma unroll
                for (int j = 0; j < 4; ++j) { const float a = p[ai][m][j];
                    const float oup = m > 0 ? dppf<0x121>(0.f, p[ai][m > 0 ? m - 1 : 0][j]) : xup[j];
                    const float odn = m < 3 ? dppf<0x12f>(0.f, p[ai][m < 3 ? m + 1 : 3][j]) : xdn[j];
                    const float up = dppf<0x111>(oup, a), dn = dppf<0x101>(odn, a);
                    part[j] = w0[j] * up + w1[j] * a + w2[j] * dn; }
                const f32x4 bv = acc[ai][0][m][0], y = bv * part, gr = acc[ai][1][m][1];
                if (r == 0 || r == BM - 1) { float* hp = HALO + ((size_t)(u.pm * 2 + (r ? 1 : 0)) * 3) * 2048 + ch;
                    *(f32x4*)hp = p[ai][m]; *(f32x4*)(hp + 2048) = part; *(f32x4*)(hp + 4096) = bv; }
                u32x2 wy; wy.x = cvt_pk_bf16(y[0], y[1]); wy.y = cvt_pk_bf16(y[2], y[3]);
                *(u32x2*)(YC + row * 2048 + ch) = wy;
                u32x2 wg; wg.x = cvt_pk_bf16(gr[0], gr[1]); wg.y = cvt_pk_bf16(gr[2], gr[3]);
                *(u32x2*)(HB + row * ldh + 12288 + ch) = wg; } }
    }
};
struct EpiF8 {
    static constexpr bool PERM = true, AFTER_DRAIN = false;
    bf16_t* HB; int ldh; bf16_t* GATES; const float* bgate; float sc;
    __device__ __forceinline__ void operator()(const f32x4 (&acc)[2][2][4][2], const Unit& u, int wr, int wc, int fr, int fq) const {
        asm volatile("" : "+v"(fr), "+v"(fq));
        const int row0 = u.pm * BM + wr * 64 + fr;
        if (u.pn < 16) {
            const int col0 = 6144 + u.pn * BM + wc * 32 + 8 * fq;
#pragma unroll
            for (int ai = 0; ai < 2; ++ai)
#pragma unroll
                for (int m = 0; m < 4; ++m) { bf16_t* rowp = HB + (size_t)(row0 + ai * HALF + m * 16) * ldh + col0;
#pragma unroll
                    for (int bj = 0; bj < 2; ++bj) { const f32x4 v0 = acc[ai][bj][m][0] * sc, v1 = acc[ai][bj][m][1] * sc;
                        u32x4 w; w.x = cvt_pk_bf16(v0[0], v0[1]); w.y = cvt_pk_bf16(v0[2], v0[3]); w.z = cvt_pk_bf16(v1[0], v1[1]); w.w = cvt_pk_bf16(v1[2], v1[3]);
                        *(u32x4*)(rowp + bj * HALF) = w; } }
        } else {
            const int col0 = (u.pn - 16) * BM + wc * 32 + 8 * fq;
            f32x4 bv[2][2];
#pragma unroll
            for (int bj = 0; bj < 2; ++bj)
#pragma unroll
                for (int n = 0; n < 2; ++n) bv[bj][n] = *(const f32x4*)(bgate + col0 + bj * HALF + 4 * n);
#pragma unroll
            for (int ai = 0; ai < 2; ++ai)
#pragma unroll
                for (int m = 0; m < 4; ++m) { bf16_t* rowp = GATES + (size_t)(row0 + ai * HALF + m * 16) * 12288 + col0;
#pragma unroll
                    for (int bj = 0; bj < 2; ++bj) { const f32x4 v0 = acc[ai][bj][m][0] * sc + bv[bj][0], v1 = acc[ai][bj][m][1] * sc + bv[bj][1];
                        u32x4 w; w.x = cvt_pk_bf16(sigmoidf_fast(v0[0]), sigmoidf_fast(v0[1])); w.y = cvt_pk_bf16(sigmoidf_fast(v0[2]), sigmoidf_fast(v0[3]));
                        w.z = cvt_pk_bf16(sigmoidf_fast(v1[0]), sigmoidf_fast(v1[1])); w.w = cvt_pk_bf16(sigmoidf_fast(v1[2]), sigmoidf_fast(v1[3]));
                        *(u32x4*)(rowp + bj * HALF) = w; } }
        }
    }
};
struct EpiGates {
    static constexpr bool PERM = true, AFTER_DRAIN = false;
    bf16_t* GATES; const float* bgate; float sc;
    __device__ __forceinline__ void operator()(const f32x4 (&acc)[2][2][4][2], const Unit& u, int wr, int wc, int fr, int fq) const {
        asm volatile("" : "+v"(fr), "+v"(fq));
        const int row0 = u.pm * BM + wr * 64 + fr, col0 = u.pn * BM + wc * 32 + 8 * fq;
#pragma unroll
        for (int ai = 0; ai < 2; ++ai)
#pragma unroll
            for (int m = 0; m < 4; ++m) { bf16_t* rowp = GATES + (size_t)(row0 + ai * HALF + m * 16) * 12288 + col0;
                asm volatile("" ::: "memory");
#pragma unroll
                for (int bj = 0; bj < 2; ++bj) { const f32x4 v0 = acc[ai][bj][m][0] * sc + *(const f32x4*)(bgate + col0 + bj * HALF), v1 = acc[ai][bj][m][1] * sc + *(const f32x4*)(bgate + col0 + bj * HALF + 4);
                    u32x4 w; w.x = cvt_pk_bf16(sigmoidf_fast(v0[0]), sigmoidf_fast(v0[1])); w.y = cvt_pk_bf16(sigmoidf_fast(v0[2]), sigmoidf_fast(v0[3]));
                    w.z = cvt_pk_bf16(sigmoidf_fast(v1[0]), sigmoidf_fast(v1[1])); w.w = cvt_pk_bf16(sigmoidf_fast(v1[2]), sigmoidf_fast(v1[3]));
                    *(u32x4*)(rowp + bj * HALF) = w; } }
    }
};
template <int I> struct EpiBranch {
    static constexpr bool PERM = true, AFTER_DRAIN = false;
    bf16_t* MIXED; const bf16_t* GATES; float sc;
    __device__ __forceinline__ void operator()(const f32x4 (&acc)[2][2][4][2], const Unit& u, int wr, int wc, int fr, int fq) const {
        asm volatile("" : "+v"(fr), "+v"(fq));
        const int row0 = u.pm * BM + wr * 64 + fr, col0 = u.pn * BM + wc * 32 + 8 * fq;
#pragma unroll
        for (int ai = 0; ai < 2; ++ai) {
            u32x4 g[4][2], p[4][2];
            asm volatile("" ::: "memory");
#pragma unroll
            for (int m = 0; m < 4; ++m) { const size_t r = (size_t)(row0 + ai * HALF + m * 16);
#pragma unroll
                for (int bj = 0; bj < 2; ++bj) { g[m][bj] = *(const u32x4*)(GATES + r * 12288 + I * 4096 + col0 + bj * HALF);
                    if (I) p[m][bj] = *(const u32x4*)(MIXED + r * 4096 + col0 + bj * HALF); else p[m][bj] = (u32x4){0u, 0u, 0u, 0u}; } }
            if (I) asm volatile("" : "+v"(g[0][0]), "+v"(g[0][1]), "+v"(g[1][0]), "+v"(g[1][1]), "+v"(g[2][0]), "+v"(g[2][1]), "+v"(g[3][0]), "+v"(g[3][1]),
                                     "+v"(p[0][0]), "+v"(p[0][1]), "+v"(p[1][0]), "+v"(p[1][1]), "+v"(p[2][0]), "+v"(p[2][1]), "+v"(p[3][0]), "+v"(p[3][1]));
            else asm volatile("" : "+v"(g[0][0]), "+v"(g[0][1]), "+v"(g[1][0]), "+v"(g[1][1]), "+v"(g[2][0]), "+v"(g[2][1]), "+v"(g[3][0]), "+v"(g[3][1]));
#pragma unroll
            for (int m = 0; m < 4; ++m) { const size_t r = (size_t)(row0 + ai * HALF + m * 16);
#pragma unroll
                for (int bj = 0; bj < 2; ++bj) {
                    bf16_t* mp = MIXED + r * 4096 + col0 + bj * HALF;
                    const u32x4 gg = g[m][bj], pp = p[m][bj];
                    const f32x4 a0 = acc[ai][bj][m][0] * sc, a1 = acc[ai][bj][m][1] * sc;
                    u32x4 w;
                    w.x = cvt_pk_bf16(bf_lo(pp.x) + bf_lo(gg.x) * a0[0], bf_hi(pp.x) + bf_hi(gg.x) * a0[1]);
                    w.y = cvt_pk_bf16(bf_lo(pp.y) + bf_lo(gg.y) * a0[2], bf_hi(pp.y) + bf_hi(gg.y) * a0[3]);
                    w.z = cvt_pk_bf16(bf_lo(pp.z) + bf_lo(gg.z) * a1[0], bf_hi(pp.z) + bf_hi(gg.z) * a1[1]);
                    w.w = cvt_pk_bf16(bf_lo(pp.w) + bf_lo(gg.w) * a1[2], bf_hi(pp.w) + bf_hi(gg.w) * a1[3]);
                    *(u32x4*)mp = w; } }
        }
    }
};
struct EpiGlu {
    static constexpr bool PERM = true, AFTER_DRAIN = false;
    bf16_t* G; float* HALO; const float* wconv; const float* bconv; PG8_LAS unsigned char* br;
    static constexpr int FFN = 11008;
    __device__ __forceinline__ void operator()(const f32x4 (&acc)[2][2][4][2], const Unit& u, int wr, int wc, int fr, int fq) const {
        asm volatile("" : "+v"(fr), "+v"(fq));
        const int cl = wc * 32 + 8 * fq, cg = u.pn * 128 + cl;
        PG8_LAS float* BR = (PG8_LAS float*)br;
#pragma unroll
        for (int ai = 0; ai < 2; ++ai) { const int q = 2 * ai + wr;
            if (fr == 0) { *(PG8_LAS f32x4*)(BR + (0 * 4 + q) * 128 + cl) = acc[ai][0][0][0]; *(PG8_LAS f32x4*)(BR + (0 * 4 + q) * 128 + cl + 4) = acc[ai][0][0][1]; }
            if (fr == 15) { *(PG8_LAS f32x4*)(BR + (1 * 4 + q) * 128 + cl) = acc[ai][0][3][0]; *(PG8_LAS f32x4*)(BR + (1 * 4 + q) * 128 + cl + 4) = acc[ai][0][3][1]; } }
        asm volatile("s_waitcnt lgkmcnt(0)" ::: "memory"); __builtin_amdgcn_s_barrier(); asm volatile("" ::: "memory");
        f32x4 w0[2], w1[2], w2[2], bs[2];
#pragma unroll
        for (int n = 0; n < 2; ++n) { w0[n] = *(const f32x4*)(wconv + cg + 4 * n); w1[n] = *(const f32x4*)(wconv + FFN + cg + 4 * n); w2[n] = *(const f32x4*)(wconv + 2 * FFN + cg + 4 * n); bs[n] = *(const f32x4*)(bconv + cg + 4 * n); }
#pragma unroll
        for (int ai = 0; ai < 2; ++ai) { const int q = 2 * ai + wr;
            f32x4 xup[2], xdn[2];
#pragma unroll
            for (int n = 0; n < 2; ++n) { xup[n] = q > 0 ? *(const PG8_LAS f32x4*)(BR + (1 * 4 + (q - 1)) * 128 + cl + 4 * n) : (f32x4){0.f, 0.f, 0.f, 0.f};
                                          xdn[n] = q < 3 ? *(const PG8_LAS f32x4*)(BR + (0 * 4 + (q + 1)) * 128 + cl + 4 * n) : (f32x4){0.f, 0.f, 0.f, 0.f}; }
#pragma unroll
            for (int m = 0; m < 4; ++m) { const int r = 128 * ai + 64 * wr + 16 * m + fr; const size_t row = (size_t)u.pm * BM + r;
                f32x4 pre[2];
#pragma unroll
                for (int n = 0; n < 2; ++n)
#pragma unroll
                    for (int j = 0; j < 4; ++j) { const float a = acc[ai][0][m][n][j];
                        const float oup = m > 0 ? dppf<0x121>(0.f, acc[ai][0][m > 0 ? m - 1 : 0][n][j]) : xup[n][j];
                        const float odn = m < 3 ? dppf<0x12f>(0.f, acc[ai][0][m < 3 ? m + 1 : 3][n][j]) : xdn[n][j];
                        const float up = dppf<0x111>(oup, a), dn = dppf<0x101>(odn, a);
                        pre[n][j] = bs[n][j] + w0[n][j] * up + w1[n][j] * a + w2[n][j] * dn; }
                if (r == 0 || r == BM - 1) {
                    float* hp = HALO + ((size_t)(u.pm * 2 + (r ? 1 : 0)) * 3) * FFN + cg;
#pragma unroll
                    for (int n = 0; n < 2; ++n) { *(f32x4*)(hp + 4 * n) = acc[ai][0][m][n]; *(f32x4*)(hp + FFN + 4 * n) = pre[n]; *(f32x4*)(hp + 2 * FFN + 4 * n) = acc[ai][1][m][n]; } }
                u32x4 w;
                { const f32x2 g0 = gelu_pk((f32x2){pre[0][0], pre[0][1]}), g1 = gelu_pk((f32x2){pre[0][2], pre[0][3]}), g2 = gelu_pk((f32x2){pre[1][0], pre[1][1]}), g3 = gelu_pk((f32x2){pre[1][2], pre[1][3]});
                  const f32x4 u0 = acc[ai][1][m][0], u1 = acc[ai][1][m][1];
                  w.x = cvt_pk_bf16(g0.x * u0[0], g0.y * u0[1]); w.y = cvt_pk_bf16(g1.x * u0[2], g1.y * u0[3]); w.z = cvt_pk_bf16(g2.x * u1[0], g2.y * u1[1]); w.w = cvt_pk_bf16(g3.x * u1[2], g3.y * u1[3]); }
                *(u32x4*)(G + row * FFN + cg) = w; } }
    }
};
template <bool NORM> struct EpiResid {
    static constexpr bool PERM = false, AFTER_DRAIN = false;
    float* V; const float* xres; int ldc; float alpha; int gi, bi; unsigned goff; unsigned long long st_off;
    __device__ __forceinline__ void operator()(const f32x4 (&acc)[2][2][4][2], const Unit& u, int wr, int wc, int fr, int fq) const {
        asm volatile("" : "+v"(fr), "+v"(fq));
        const int row0 = u.pm * BM + wr * 64 + fr, col0 = u.pn * BM + wc * 32 + 4 * fq;
        const float* g = nullptr; const float* b = nullptr; const float* st = nullptr;
        if (NORM) { g = (const float*)kargs()->in[gi] + goff; b = (const float*)kargs()->in[bi] + goff; st = (const float*)(GAS const float*)(kargs()->ws + st_off); }
        f32x4 gv[2][2], bv[2][2];
        if (NORM) {
#pragma unroll
            for (int bj = 0; bj < 2; ++bj)
#pragma unroll
                for (int n = 0; n < 2; ++n) { gv[bj][n] = *(const f32x4*)(g + col0 + bj * HALF + n * 16); bv[bj][n] = *(const f32x4*)(b + col0 + bj * HALF + n * 16); }
        }
        constexpr int RG = NORM ? 2 : 4;
#pragma unroll
        for (int ai = 0; ai < 2; ++ai)
#pragma unroll
            for (int m0 = 0; m0 < 4; m0 += RG) {
                f32x4 xr[RG][2][2]; f32x2 s2[RG];
                asm volatile("" ::: "memory");
#pragma unroll
                for (int mm = 0; mm < RG; ++mm) { const int r = row0 + ai * HALF + (m0 + mm) * 16; const size_t off = (size_t)r * ldc + col0;
                    if (NORM) s2[mm] = *(const f32x2*)(st + 2 * (size_t)r); else s2[mm] = (f32x2){0.f, 1.f};
#pragma unroll
                    for (int bj = 0; bj < 2; ++bj)
#pragma unroll
                        for (int n = 0; n < 2; ++n) xr[mm][bj][n] = *(const f32x4*)(xres + off + bj * HALF + n * 16); }
                if constexpr (NORM) {
                    if (ai == 0 && m0 == 0) asm volatile("" : "+v"(gv[0][0]), "+v"(gv[0][1]), "+v"(gv[1][0]), "+v"(gv[1][1]), "+v"(bv[0][0]), "+v"(bv[0][1]), "+v"(bv[1][0]), "+v"(bv[1][1]));
                    asm volatile("" : "+v"(xr[0][0][0]), "+v"(xr[0][0][1]), "+v"(xr[0][1][0]), "+v"(xr[0][1][1]), "+v"(xr[1][0][0]), "+v"(xr[1][0][1]), "+v"(xr[1][1][0]), "+v"(xr[1][1][1]), "+v"(s2[0]), "+v"(s2[1]));
                } else {
                    asm volatile("" : "+v"(xr[0][0][0]), "+v"(xr[0][0][1]), "+v"(xr[0][1][0]), "+v"(xr[0][1][1]), "+v"(xr[1][0][0]), "+v"(xr[1][0][1]), "+v"(xr[1][1][0]), "+v"(xr[1][1][1]),
                                      "+v"(xr[RG - 2][0][0]), "+v"(xr[RG - 2][0][1]), "+v"(xr[RG - 2][1][0]), "+v"(xr[RG - 2][1][1]), "+v"(xr[RG - 1][0][0]), "+v"(xr[RG - 1][0][1]), "+v"(xr[RG - 1][1][0]), "+v"(xr[RG - 1][1][1]));
                }
#pragma unroll
                for (int mm = 0; mm < RG; ++mm) { const int r = row0 + ai * HALF + (m0 + mm) * 16; const size_t off = (size_t)r * ldc + col0;
#pragma unroll
                    for (int bj = 0; bj < 2; ++bj)
#pragma unroll
                        for (int n = 0; n < 2; ++n) { f32x4 x = xr[mm][bj][n];
                            if (NORM) x = (x - s2[mm].x) * s2[mm].y * gv[bj][n] + bv[bj][n];
                            *(f32x4*)(V + off + bj * HALF + n * 16) = x * alpha + acc[ai][bj][m0 + mm][n]; } }
            }
    }
};

typedef int pg8_v4i __attribute__((ext_vector_type(4)));
typedef int pg8_v8i __attribute__((ext_vector_type(8)));
__device__ __forceinline__ pg8_v8i pg8_cat(bf16x8 lo, bf16x8 hi) { return __builtin_shufflevector(__builtin_bit_cast(pg8_v4i, lo), __builtin_bit_cast(pg8_v4i, hi), 0, 1, 2, 3, 4, 5, 6, 7); }
template <class Epi, class Sched, bool ALIGN_EPI = false, bool SP2 = false, bool FP8 = false>
__device__ __forceinline__ void gemm_phase(PG8_LAS unsigned char* lds, const Gemm g, const Sched& S, const Epi& E, const int wv  ) {
    int tid_; asm volatile("v_mbcnt_lo_u32_b32 %0, -1, 0\n\tv_mbcnt_hi_u32_b32 %0, -1, %0" : "=v"(tid_)); tid_ += wv * 64; asm volatile("" : "+v"(tid_));
    const int tid = tid_, wid = __builtin_amdgcn_readfirstlane(tid >> 6), lane = tid & 63, wr = wid >> 2, wc = wid & 3, fr = lane & 15, fq = lane >> 4;
    const int K = g.K, nt = K / BK;
    unsigned voffA[2], voffB[2];
#pragma unroll
    for (int i = 0; i < 2; ++i) { int R, C; stage_rc(tid * 16 + i * 8192, R, C); const int Rb = Epi::PERM ? ((R & ~31) + perm32(R & 31)) : R;
        voffA[i] = (unsigned)(R * K + C) * 2u; voffB[i] = (unsigned)(Rb * K + C) * 2u; }
    const size_t kstep = (size_t)(BK * 2);
    const size_t hstep = (size_t)HALF * K * 2;
    const size_t tstep = 2 * hstep;
    const unsigned ldsw = (unsigned)wid * 1024u;
    const int aoff = lds_byte(wr * 64 + fr, fq * 8), boff = lds_byte(wc * 32 + fr, fq * 8);
#define PG8_SA(b, h) (((b) * 2 + (h)) * HTB)
#define PG8_SB(b, h) ((4 + (b) * 2 + (h)) * HTB)
#define PG8_STAGE(bufoff, gbase, voff) do { _Pragma("unroll") for (int _i = 0; _i < 2; ++_i) \
        __builtin_amdgcn_global_load_lds((const unsigned*)((const char*)(gbase) + (voff)[_i]), (PG8_LAS unsigned*)(lds + (bufoff) + ldsw + _i * 8192), 16, 0, 0); } while (0)
#define PG8_LD8(addr) __builtin_shufflevector(*(const PG8_LAS pg8_v4i*)(addr), *(const PG8_LAS pg8_v4i*)((addr) + 1024), 0, 1, 2, 3, 4, 5, 6, 7)
#define PG8_LDA(dst, b, h) do { if constexpr (FP8) { _Pragma("unroll") for (int m = 0; m < 4; ++m) dst##8[m] = PG8_LD8(lds + PG8_SA(b, h) + aoff + m * 2048); } \
        else { _Pragma("unroll") for (int m = 0; m < 4; ++m) _Pragma("unroll") for (int k = 0; k < 2; ++k) dst[m][k] = *(const PG8_LAS bf16x8*)(lds + PG8_SA(b, h) + aoff + m * 2048 + k * 1024); } } while (0)
#define PG8_LDB(dst, b, h) do { if constexpr (FP8) { _Pragma("unroll") for (int n = 0; n < 2; ++n) dst##8[n] = PG8_LD8(lds + PG8_SB(b, h) + boff + n * 2048); } \
        else { _Pragma("unroll") for (int n = 0; n < 2; ++n) _Pragma("unroll") for (int k = 0; k < 2; ++k) dst[n][k] = *(const PG8_LAS bf16x8*)(lds + PG8_SB(b, h) + boff + n * 2048 + k * 1024); } } while (0)
#define PG8_MMA(ai, bj, At, Bt) do { __builtin_amdgcn_s_setprio(1); if constexpr (FP8) { _Pragma("unroll") for (int m = 0; m < 4; ++m) _Pragma("unroll") for (int n = 0; n < 2; ++n) \
        asm volatile("v_mfma_f32_16x16x128_f8f6f4 %0, %1, %2, %0" : "+v"(acc[ai][bj][m][n]) : "v"(Bt##8[n]), "v"(At##8[m])); }     \
      else { _Pragma("unroll") for (int m = 0; m < 4; ++m) _Pragma("unroll") for (int n = 0; n < 2; ++n) _Pragma("unroll") for (int k = 0; k < 2; ++k) \
        acc[ai][bj][m][n] = __builtin_amdgcn_mfma_f32_16x16x32_bf16(Bt[n][k], At[m][k], acc[ai][bj][m][n], 0, 0, 0); } __builtin_amdgcn_s_setprio(0); } while (0)
#define PG8_WAIT_V(n) asm volatile("s_waitcnt vmcnt(" #n ")" ::: "memory")
#define PG8_WAIT_L(n) asm volatile("s_waitcnt lgkmcnt(" #n ")" ::: "memory")
#define PG8_BAR __builtin_amdgcn_s_barrier()
#define PG8_SCHED __builtin_amdgcn_sched_barrier(0)
    Unit cur, nxt; int ui = 0;
    if (!S.next(0, cur)) return;
    f32x4 acc[2][2][4][2];
#pragma unroll
    for (int a = 0; a < 2; ++a)
#pragma unroll
        for (int b = 0; b < 2; ++b)
#pragma unroll
            for (int m = 0; m < 4; ++m)
#pragma unroll
                for (int n = 0; n < 2; ++n) acc[a][b][m][n] = (f32x4){0.f, 0.f, 0.f, 0.f};
    bf16x8 At[4][2], B0[2][2], B1[2][2];
    pg8_v8i At8[4], B08[2], B18[2];
    const char* cA = (const char*)g.A + (size_t)cur.pm * tstep; const char* cB = (const char*)g.Bt + (size_t)cur.pn * tstep;
    S.a_ready(cur);
    if constexpr (SP2) {
        PG8_STAGE(PG8_SB(0, 0), cB, voffB); PG8_STAGE(PG8_SB(0, 1), cB + hstep, voffB); PG8_STAGE(PG8_SA(0, 0), cA, voffA); PG8_STAGE(PG8_SA(0, 1), cA + hstep, voffA);
        if (wr == 1) PG8_BAR;
        PG8_WAIT_V(2); PG8_BAR;
        PG8_STAGE(PG8_SB(1, 0), cB + kstep, voffB); PG8_STAGE(PG8_SA(1, 0), cA + kstep, voffA); PG8_STAGE(PG8_SB(1, 1), cB + hstep + kstep, voffB);
        PG8_WAIT_V(6); PG8_BAR;
    } else {
        PG8_STAGE(PG8_SB(0, 0), cB, voffB); PG8_STAGE(PG8_SA(0, 0), cA, voffA); PG8_STAGE(PG8_SB(0, 1), cB + hstep, voffB); PG8_STAGE(PG8_SA(0, 1), cA + hstep, voffA);
        if (wr == 1) PG8_BAR;
        PG8_WAIT_V(4); PG8_BAR;
        PG8_STAGE(PG8_SB(1, 0), cB + kstep, voffB); PG8_STAGE(PG8_SA(1, 0), cA + kstep, voffA); PG8_STAGE(PG8_SB(1, 1), cB + hstep + kstep, voffB);
        PG8_WAIT_V(6); PG8_BAR;
    }
    for (;;) {
        const bool has_next = S.next(ui + 1, nxt);
        const char* nA = has_next ? (const char*)g.A + (size_t)nxt.pm * tstep : cA; const char* nB = has_next ? (const char*)g.Bt + (size_t)nxt.pn * tstep : cB;
        for (int t = 0; t < nt; t += 2) {
            const bool last = (t == nt - 2);
            const char* a1 = cA + (size_t)(t + 1) * kstep;
            const char* a2 = last ? nA : cA + (size_t)(t + 2) * kstep; const char* b2 = last ? nB : cB + (size_t)(t + 2) * kstep;
            const char* a3 = a2 + kstep; const char* b3 = b2 + kstep;
            if (last && has_next) S.a_ready(nxt);
            if constexpr (SP2) {
            PG8_LDB(B0, 0, 0); PG8_LDB(B1, 0, 1); PG8_SCHED; PG8_LDA(At, 0, 0); PG8_STAGE(PG8_SA(1, 1), a1 + hstep, voffA);
            PG8_WAIT_V(8); PG8_WAIT_L(0); PG8_BAR; PG8_MMA(0, 0, At, B0); PG8_MMA(0, 1, At, B1); PG8_BAR; PG8_SCHED;
            PG8_LDA(At, 0, 1); PG8_STAGE(PG8_SB(0, 0), b2, voffB); PG8_STAGE(PG8_SB(0, 1), b2 + hstep, voffB); PG8_STAGE(PG8_SA(0, 0), a2, voffA);
            PG8_WAIT_V(8); PG8_WAIT_L(0); PG8_BAR; PG8_MMA(1, 0, At, B0); PG8_MMA(1, 1, At, B1); PG8_BAR; PG8_SCHED;
            PG8_LDB(B0, 1, 0); PG8_LDB(B1, 1, 1); PG8_SCHED; PG8_LDA(At, 1, 0); PG8_STAGE(PG8_SA(0, 1), a2 + hstep, voffA);
            PG8_WAIT_V(8); PG8_WAIT_L(0); PG8_BAR; PG8_MMA(0, 0, At, B0); PG8_MMA(0, 1, At, B1); PG8_BAR; PG8_SCHED;
            PG8_LDA(At, 1, 1); PG8_STAGE(PG8_SB(1, 0), b3, voffB); PG8_STAGE(PG8_SB(1, 1), b3 + hstep, voffB); PG8_STAGE(PG8_SA(1, 0), a3, voffA);
            PG8_WAIT_V(8); PG8_WAIT_L(0); PG8_BAR; PG8_MMA(1, 0, At, B0); PG8_MMA(1, 1, At, B1); PG8_BAR; PG8_SCHED;
            } else {
            PG8_LDB(B0, 0, 0); PG8_SCHED; PG8_LDA(At, 0, 0); PG8_STAGE(PG8_SA(1, 1), a1 + hstep, voffA);
            PG8_WAIT_L(8); PG8_BAR; PG8_WAIT_L(0); PG8_MMA(0, 0, At, B0); PG8_BAR; PG8_SCHED;
            PG8_LDB(B1, 0, 1); PG8_STAGE(PG8_SB(0, 0), b2, voffB);
            PG8_BAR; PG8_WAIT_L(0); PG8_MMA(0, 1, At, B1); PG8_BAR;
            PG8_LDA(At, 0, 1); PG8_STAGE(PG8_SA(0, 0), a2, voffA);
            PG8_BAR; PG8_WAIT_L(0); PG8_MMA(1, 0, At, B0); PG8_BAR; PG8_SCHED;
            PG8_STAGE(PG8_SB(0, 1), b2 + hstep, voffB);
            PG8_WAIT_V(6); PG8_BAR; PG8_MMA(1, 1, At, B1); PG8_BAR;
            PG8_LDB(B0, 1, 0); PG8_SCHED; PG8_LDA(At, 1, 0); PG8_STAGE(PG8_SA(0, 1), a2 + hstep, voffA);
            PG8_WAIT_L(8); PG8_BAR; PG8_WAIT_L(0); PG8_MMA(0, 0, At, B0); PG8_BAR; PG8_SCHED;
            PG8_LDB(B1, 1, 1); PG8_STAGE(PG8_SB(1, 0), b3, voffB);
            PG8_BAR; PG8_WAIT_L(0); PG8_MMA(0, 1, At, B1); PG8_BAR;
            PG8_LDA(At, 1, 1); PG8_STAGE(PG8_SA(1, 0), a3, voffA);
            PG8_BAR; PG8_WAIT_L(0); PG8_MMA(1, 0, At, B0); PG8_BAR; PG8_SCHED;
            PG8_STAGE(PG8_SB(1, 1), b3 + hstep, voffB);
            PG8_WAIT_V(6); PG8_BAR; PG8_MMA(1, 1, At, B1); PG8_BAR;
            }
        }
        if constexpr (FP8) {
            asm volatile("s_nop 15\n\ts_nop 15\n\ts_nop 15" ::: "memory");
#pragma unroll
            for (int a_ = 0; a_ < 2; ++a_)
#pragma unroll
                for (int b_ = 0; b_ < 2; ++b_)
                    asm volatile("" : "+v"(acc[a_][b_][0][0]), "+v"(acc[a_][b_][0][1]), "+v"(acc[a_][b_][1][0]), "+v"(acc[a_][b_][1][1]), "+v"(acc[a_][b_][2][0]), "+v"(acc[a_][b_][2][1]), "+v"(acc[a_][b_][3][0]), "+v"(acc[a_][b_][3][1]));
        }
        if constexpr (ALIGN_EPI) { if (wr == 0) PG8_BAR; }
        if constexpr (!Epi::AFTER_DRAIN) { E(acc, cur, wr, wc, fr, fq); S.done(cur); }
        if (!has_next) break;
#pragma unroll
        for (int a = 0; a < 2; ++a)
#pragma unroll
            for (int b = 0; b < 2; ++b)
#pragma unroll
                for (int m = 0; m < 4; ++m)
#pragma unroll
                    for (int n = 0; n < 2; ++n) acc[a][b][m][n] = (f32x4){0.f, 0.f, 0.f, 0.f};
        cur = nxt; cA = nA; cB = nB; ++ui;
        if constexpr (ALIGN_EPI) { if (wr == 1) PG8_BAR; }
    }
    PG8_WAIT_V(0);
    if constexpr (!ALIGN_EPI) { if (wr == 0) PG8_BAR; }
    PG8_BAR;
    if constexpr (Epi::AFTER_DRAIN) { E.fused(acc, cur, wr, wc, fr, fq, lds, wid, lane); S.done(cur); }
#undef PG8_SA
#undef PG8_SB
#undef PG8_STAGE
#undef PG8_LD8
#undef PG8_LDA
#undef PG8_LDB
#undef PG8_MMA
#undef PG8_WAIT_V
#undef PG8_WAIT_L
#undef PG8_BAR
#undef PG8_SCHED
}
}

constexpr int NWAVES = 8;
constexpr int NB = 4, SEQ = 4096, M = NB * SEQ, D = 4096, BW = 2048, FF = 11008, DEPTH = 2;
constexpr int IN_WIDTH = 30752;
constexpr int NIN_MAIN = 26880, NIN_PAD = 30976;
constexpr int N16A = 10496, N8A = 16384, N16V = 2048, N8V = 2048;
constexpr size_t WIN_16A = 0, WIN_8A = WIN_16A + (size_t)N16A * D * 2, WIN_16V = WIN_8A + (size_t)N8A * D, WIN_8V = WIN_16V + (size_t)N16V * D * 2;
constexpr int LDH = 14336;
constexpr int H_CB = 0, H_CC = 2048, H_CH = 4096, H_NQ = 6144, H_NK = 8192, H_GQ = 10240, H_GK = 11264, H_GR = 12288;
constexpr float LN_EPS = 1e-5f, RMS_EPS = 1e-6f, ALPHA = 1.41421356237f;
#ifndef MK_MULTI
#define MK_MULTI 0
#endif
constexpr int N_PHASES = 1 + 11 * DEPTH;

constexpr size_t MiB = 1u << 20;
constexpr size_t alm(size_t x) { return (x + MiB - 1) / MiB * MiB; }
constexpr size_t WS_CTL = 0, CTL_ZERO_BYTES = 1 * MiB;
constexpr size_t SZ_WIN = alm((size_t)NIN_PAD * D * 2), SZ_WBR = alm((size_t)3 * D * BW * 2), SZ_WO = alm((size_t)D * D * 2), SZ_WFI = alm((size_t)2 * FF * D * 2), SZ_WFO = alm((size_t)D * FF * 2);
constexpr size_t OFF_WIN = 0, OFF_WBR = OFF_WIN + SZ_WIN, OFF_WO = OFF_WBR + SZ_WBR, OFF_WFI = OFF_WO + SZ_WO, OFF_WFO = OFF_WFI + SZ_WFI, SZ_WL = OFF_WFO + SZ_WFO;
constexpr size_t WS_W = 1 * MiB;
constexpr int MB = SEQ;
constexpr size_t WS_ARENA = WS_W + DEPTH * SZ_WL;
constexpr size_t A_XB = 0;
constexpr size_t A_XB8 = A_XB + alm((size_t)MB * D * 2);
constexpr size_t A_XR = A_XB8 + alm((size_t)MB * D);
constexpr size_t A_ST = A_XR + alm((size_t)MB * D * 4);
constexpr size_t A_HALOC = A_ST + alm((size_t)MB * 2 * 4);
constexpr size_t A_U = A_HALOC + alm((size_t)16 * 2 * 3 * BW * 4);
constexpr size_t A_HB = A_U;
constexpr size_t A_GATES = A_HB + alm((size_t)MB * LDH * 2);
constexpr size_t A_VT = A_GATES + alm((size_t)MB * 12288 * 2);
constexpr size_t A_YC = A_VT + alm((size_t)4096 * MB * 2);
constexpr size_t A_YN = A_YC + alm((size_t)MB * BW * 2);
constexpr size_t A_YG = A_YN + alm((size_t)MB * BW * 2);
constexpr size_t A_QIN = A_YG + alm((size_t)MB * BW * 2);
constexpr size_t A_KOT = A_QIN + alm((size_t)2 * MB * 1024 * 2);
constexpr size_t A_ATT = A_KOT + alm((size_t)2 * 1024 * MB * 2);
constexpr size_t A_DEC = A_ATT + alm((size_t)2 * 4 * 64 * 64 * 64 * 2);
constexpr size_t A_O = A_DEC + alm((size_t)2 * 64 * 1024 * 4);
constexpr size_t A_MIXED = A_O + alm((size_t)2 * MB * 2048 * 2);
constexpr size_t ARENA = A_MIXED + alm((size_t)MB * D * 2);
constexpr size_t A_HALO = A_U;
constexpr size_t A_G = A_HALO + alm((size_t)16 * 2 * 3 * FF * 4);
static_assert(A_G + alm((size_t)MB * FF * 2) <= A_MIXED, "the FFN overlay must stay below MIXED");
constexpr size_t WS_END = WS_ARENA + NB * ARENA;
static_assert(WS_END <= (size_t)3844 * MiB, "d_ws budget: 4 x the largest input tensor");
constexpr int CW_BAR = 4096;
constexpr int CW_CONV = 64;

constexpr int RING_BYTES = 131072;
constexpr int LDS_BYTES = 159744;
constexpr int MISC_OFF = LDS_BYTES - 512;

#ifndef GAS
#define GAS __attribute__((address_space(1)))
#endif
#define LAS __attribute__((address_space(3)))
typedef unsigned short bf16;
typedef unsigned v4u __attribute__((ext_vector_type(4)));
typedef unsigned v2u __attribute__((ext_vector_type(2)));
typedef float f32x4 __attribute__((ext_vector_type(4)));
typedef short bf16x8 __attribute__((ext_vector_type(8)));
typedef GAS unsigned gu32;
#define LDS_WAIT() asm volatile("s_waitcnt lgkmcnt(0)" ::: "memory")
#define VM_WAIT() asm volatile("s_waitcnt vmcnt(0)" ::: "memory")
__device__ __forceinline__ unsigned pk2(float lo, float hi) { return pg8::cvt_pk_bf16(lo, hi); }
__device__ __forceinline__ unsigned f2bf_sw(float x) { const unsigned u = __float_as_uint(x); return (u + 0x7fffu + ((u >> 16) & 1u)) >> 16; }
__device__ __forceinline__ unsigned pk2_sw(float lo, float hi) { return f2bf_sw(lo) | (f2bf_sw(hi) << 16); }
__device__ __forceinline__ float bflo(unsigned w) { return __uint_as_float(w << 16); }
__device__ __forceinline__ float bfhi(unsigned w) { return __uint_as_float(w & 0xffff0000u); }
__device__ __forceinline__ float bf1(bf16 b) { return __uint_as_float(((unsigned)b) << 16); }
__device__ __forceinline__ void unpack8(const v4u w, float (&f)[8]) { f[0] = bflo(w.x); f[1] = bfhi(w.x); f[2] = bflo(w.y); f[3] = bfhi(w.y); f[4] = bflo(w.z); f[5] = bfhi(w.z); f[6] = bflo(w.w); f[7] = bfhi(w.w); }
__device__ __forceinline__ v4u pack8(const float (&f)[8]) { v4u w; w.x = pk2(f[0], f[1]); w.y = pk2(f[2], f[3]); w.z = pk2(f[4], f[5]); w.w = pk2(f[6], f[7]); return w; }
__device__ __forceinline__ float shx(float v, int m, int lane) { return __int_as_float(__builtin_amdgcn_ds_bpermute((lane ^ m) << 2, __float_as_int(v))); }
__device__ __forceinline__ float wave_sum(float v, int lane) {
#pragma unroll
    for (int o = 1; o < 64; o <<= 1) v += shx(v, o, lane);
    return v;
}
#ifndef FP8_EMU
#define FP8_EMU 0
#endif
#ifndef FP8_GATES
#define FP8_GATES 1
#endif
__device__ __forceinline__ float q8_e4m3(float v) {
    const float a = fminf(fabsf(v), 448.f); float r;
    if (a < 0.015625f) r = rintf(a * 512.f) * (1.f / 512.f);
    else { unsigned u = __float_as_uint(a); u = (u + 0x7FFFFu + ((u >> 20) & 1u)) & 0xFFF00000u; r = fminf(__uint_as_float(u), 448.f); }
    return copysignf(r, v);
}
__device__ __forceinline__ unsigned cvt4_fp8(float a, float b, float c, float d) { int w = __builtin_amdgcn_cvt_pk_fp8_f32(a, b, 0, false); w = __builtin_amdgcn_cvt_pk_fp8_f32(c, d, w, true); return (unsigned)w; }
__device__ __forceinline__ f32x4 mfma16(bf16x8 a, bf16x8 b, f32x4 c) { return __builtin_amdgcn_mfma_f32_16x16x32_bf16(a, b, c, 0, 0, 0); }

#define XB_TMO      128
#define XB_XCNT(j)  (256  + 64 * (j))
#define XB_XSUB(j)  (1280 + 64 * (j))
#define XB_XGEN(j)  (2304 + 64 * (j))
#define XB_TOP      3328
#define XB_TOPGEN   3392
#define XCD_BAR_WORDS 3456
#define XB_SPIN_CAP (1u << 18)

__device__ __forceinline__ unsigned xb_ld(unsigned* p)              { return __hip_atomic_load(p, __ATOMIC_RELAXED, __HIP_MEMORY_SCOPE_AGENT); }
__device__ __forceinline__ unsigned xb_add(unsigned* p, unsigned v) { return __hip_atomic_fetch_add(p, v, __ATOMIC_RELAXED, __HIP_MEMORY_SCOPE_AGENT); }
__device__ __forceinline__ unsigned xb_xcc_id() { return (unsigned)__builtin_amdgcn_s_getreg((3 << 11) | 20) & 0xFu; }
#define XB_SPIN(cond, bar) do { unsigned _sp = 0; while (cond) { __builtin_amdgcn_s_sleep(1); \
    if ((++_sp & 255u) == 0u) { if (xb_ld(&(bar)[XB_TMO])) break; if (_sp > XB_SPIN_CAP) { atomicAdd(&(bar)[XB_TMO], 1u); break; } } } } while (0)

__device__ __forceinline__ unsigned xb_lane_id() { unsigned t; asm volatile("v_mbcnt_lo_u32_b32 %0, -1, 0\n\tv_mbcnt_hi_u32_b32 %0, -1, %0" : "=v"(t)); return t; }
struct XcdBarrier {
    unsigned wv;
    unsigned G;
    unsigned* bar; unsigned x;
    volatile LAS unsigned* st;
};

__device__ __forceinline__ XcdBarrier xcd_barrier_post(unsigned* bar, volatile LAS unsigned* st) {
    XcdBarrier b; b.wv = 0u; b.G = 0u; b.bar = bar; b.x = xb_xcc_id(); b.st = st;
    if (threadIdx.x == 0) (void)xb_add(&bar[XB_XCNT(b.x)], 1u);
    return b;
}
__device__ __forceinline__ void xcd_barrier_complete(unsigned* bar, unsigned x, const unsigned G, unsigned& nloc, unsigned& nx) {
    unsigned sum, cnt, mine, sp = 0u;
    for (;;) {
        sum = 0u; cnt = 0u; mine = 0u;
#pragma unroll
        for (unsigned j = 0; j < 16; ++j) { const unsigned c = xb_ld(&bar[XB_XCNT(j)]); sum += c; cnt += (c > 0u) ? 1u : 0u; mine = (j == x) ? c : mine; }
        if (sum == G) break;
        __builtin_amdgcn_s_sleep(1);
        if ((++sp & 255u) == 0u) { if (xb_ld(&bar[XB_TMO])) break; if (sp > XB_SPIN_CAP) { atomicAdd(&bar[XB_TMO], 1u); break; } }
    }
    nloc = mine > 0u ? mine : 1u; nx = cnt > 0u ? cnt : 1u;
}

__device__ __forceinline__ void xcd_barrier(const XcdBarrier& b) {
    asm volatile("s_waitcnt vmcnt(0)" ::: "memory");
    __syncthreads();
    if (b.wv == 0u && xb_lane_id() == 0u) {
        unsigned* bar = b.bar;
        __builtin_amdgcn_s_waitcnt(0);
        unsigned nloc = b.st[0], nx = b.st[1];
        if (nloc == 0u) { xcd_barrier_complete(bar, b.x, b.G, nloc, nx); b.st[0] = nloc; b.st[1] = nx; }
        const unsigned old = xb_add(&bar[XB_XSUB(b.x)], 1u);
        const unsigned gen = old / nloc;
        if (old + 1u == (gen + 1u) * nloc) {
            __builtin_amdgcn_fence(__ATOMIC_RELEASE, "agent");
            asm volatile("s_waitcnt vmcnt(0)" ::: "memory");
            const unsigned og = xb_add(&bar[XB_TOP], 1u);
            const unsigned tg = og / nx;
            if (og + 1u == (tg + 1u) * nx) xb_add(&bar[XB_TOPGEN], 1u);
            else XB_SPIN(xb_ld(&bar[XB_TOPGEN]) == tg, bar);
            __builtin_amdgcn_fence(__ATOMIC_ACQUIRE, "agent");
            xb_add(&bar[XB_XGEN(b.x)], 1u);
            asm volatile("s_waitcnt vmcnt(0)" ::: "memory");
        } else {
            XB_SPIN(xb_ld(&bar[XB_XGEN(b.x)]) == gen, bar);
            __builtin_amdgcn_fence(__ATOMIC_ACQUIRE, "agent");
            asm volatile("s_waitcnt vmcnt(0)" ::: "memory");
        }
    }
    __syncthreads();
}

struct Frame { LAS unsigned char* lds; int wv, grp, gb; };
struct Ids { int tid, lane, wave, G, gw, NGW, bi; };
__device__ __forceinline__ Ids phase_ids(const int wv) { Ids I; int t; asm volatile("v_mbcnt_lo_u32_b32 %0, -1, 0\n\tv_mbcnt_hi_u32_b32 %0, -1, %0" : "=v"(t)); t += wv * 64; asm volatile("" : "+v"(t)); I.tid = t; I.lane = t & 63; I.wave = __builtin_amdgcn_readfirstlane(t >> 6);
    int g = gridDim.x; asm volatile("" : "+s"(g)); I.G = g; I.bi = blockIdx.x; I.gw = blockIdx.x * NWAVES + I.wave; I.NGW = g * NWAVES; return I; }
__device__ __forceinline__ Ids group_ids(const Frame& F) { Ids I = phase_ids(F.wv); int gb = F.gb; asm volatile("" : "+s"(gb)); I.G = 64; I.bi = gb; I.gw = gb * NWAVES + I.wave; I.NGW = 64 * NWAVES; return I; }
#define WSP(T, off) ((T*)(GAS T*)(kargs()->ws + (off)))
#define WSB(T, off) ((T*)(GAS T*)(kargs()->ws + WS_ARENA + (size_t)F.grp * ARENA + (off)))


__device__ __forceinline__ int win_src(int r) {
    if (r < 8192) { const int nb = r >> 6, T = nb >> 2, q = nb & 3, second = (r >> 5) & 1, ch0 = 64 * T + 32 * (q & 1);
        return (q < 2 ? (second ? 2048 : 0) : (second ? 16384 : 4096)) + ch0; }
    if (r < 10240) return 12288 + (r - 8192);
    if (r < 10496) return r == 10240 ? 18432 : -1;
    if (r < 14592) return 6144 + (r - 10496);
    if (r < 26880) return 18464 + (r - 14592);
    if (r < 28928) return 14336 + (r - 26880);
    return 10240 + (r - 28928);
}
__device__ __forceinline__ void tr_item(const float* W, size_t ldw, int K, int k0, int srcA, int srcB, bf16* WT, int n0, LAS float* scr, int lane, float qs = 0.f, bool f8 = false, bool cperm = false) {
    const int src = lane < 32 ? srcA : srcB; const int cl = lane & 31;
    if (src >= 0) { const float* p = W + (size_t)k0 * ldw + src + cl;
#pragma unroll 32
        for (int kk = 0; kk < 64; ++kk) { float v = __builtin_nontemporal_load(&p[(size_t)kk * ldw]); if (qs != 0.f) v = q8_e4m3(v * qs) / qs; scr[kk * 65 + lane] = v; }
    } else {
#pragma unroll 32
        for (int kk = 0; kk < 64; ++kk) scr[kk * 65 + lane] = 0.f;
    }
    LDS_WAIT(); asm volatile("" ::: "memory");
    const int c = lane & 7;
    if (f8) {
        unsigned char* W8 = (unsigned char*)WT;
#pragma unroll
        for (int j = 0; j < 8; ++j) { const int n = (lane >> 3) + 8 * j; const LAS float* s = scr + (8 * c) * 65 + n;
            v2u o; o.x = cvt4_fp8(s[0 * 65] * 64.f, s[1 * 65] * 64.f, s[2 * 65] * 64.f, s[3 * 65] * 64.f); o.y = cvt4_fp8(s[4 * 65] * 64.f, s[5 * 65] * 64.f, s[6 * 65] * 64.f, s[7 * 65] * 64.f);
            __builtin_nontemporal_store(o, (v2u*)(W8 + (size_t)(n0 + n) * K + k0 + 8 * c)); }
    } else {
#pragma unroll
    for (int j = 0; j < 8; ++j) { const int n = (lane >> 3) + 8 * j; const LAS float* s = scr + (8 * c) * 65 + n;
        v4u o; o.x = pk2(s[0 * 65], s[1 * 65]); o.y = pk2(s[2 * 65], s[3 * 65]); o.z = pk2(s[4 * 65], s[5 * 65]); o.w = pk2(s[6 * 65], s[7 * 65]);
        const int nr = cperm ? 32 * ((n >> 4) & 1) + 8 * ((n >> 2) & 3) + 4 * (n >> 5) + (n & 3) : n;
        __builtin_nontemporal_store(o, (v4u*)(WT + (size_t)(n0 + nr) * K + k0 + 8 * c)); }
    }
    LDS_WAIT(); asm volatile("" ::: "memory");
}
__device__ __forceinline__ void tr_item4(const float* W, size_t ldw, int K, int kbase, int srcA, int srcB, bf16* WT, int n0, LAS float* scr, int lane, bool f8, bool cperm) {
    const int src = lane < 32 ? srcA : srcB; const int cl = lane & 31;
    const bool live = src >= 0;
    const float* p = W + (size_t)kbase * ldw + (live ? src + cl : 0);
    const int c = lane & 7;
    auto emit = [&](int k0) {
        LDS_WAIT(); asm volatile("" ::: "memory");
        if (f8) {
            unsigned char* W8 = (unsigned char*)WT;
#pragma unroll
            for (int j = 0; j < 8; ++j) { const int n = (lane >> 3) + 8 * j; const LAS float* s = scr + (8 * c) * 65 + n;
                v2u o; o.x = cvt4_fp8(s[0 * 65] * 64.f, s[1 * 65] * 64.f, s[2 * 65] * 64.f, s[3 * 65] * 64.f); o.y = cvt4_fp8(s[4 * 65] * 64.f, s[5 * 65] * 64.f, s[6 * 65] * 64.f, s[7 * 65] * 64.f);
                __builtin_nontemporal_store(o, (v2u*)(W8 + (size_t)(n0 + n) * K + k0 + 8 * c)); }
        } else {
#pragma unroll
            for (int j = 0; j < 8; ++j) { const int n = (lane >> 3) + 8 * j; const LAS float* s = scr + (8 * c) * 65 + n;
                v4u o; o.x = pk2(s[0 * 65], s[1 * 65]); o.y = pk2(s[2 * 65], s[3 * 65]); o.z = pk2(s[4 * 65], s[5 * 65]); o.w = pk2(s[6 * 65], s[7 * 65]);
                const int nr = cperm ? 32 * ((n >> 4) & 1) + 8 * ((n >> 2) & 3) + 4 * (n >> 5) + (n & 3) : n;
                __builtin_nontemporal_store(o, (v4u*)(WT + (size_t)(n0 + nr) * K + k0 + 8 * c)); }
        }
        LDS_WAIT(); asm volatile("" ::: "memory");
    };
    float a[32], b[32];
#pragma unroll
    for (int kk = 0; kk < 32; ++kk) a[kk] = __builtin_nontemporal_load(&p[(size_t)kk * ldw]);
#pragma unroll 1
    for (int kq = 0; kq < 3; ++kq) {
        const float* pq = p + (size_t)(64 * kq) * ldw;
#pragma unroll
        for (int kk = 0; kk < 32; ++kk) b[kk] = __builtin_nontemporal_load(&pq[(size_t)(32 + kk) * ldw]);
        asm volatile("" ::: "memory");
#pragma unroll
        for (int kk = 0; kk < 32; ++kk) scr[kk * 65 + lane] = live ? a[kk] : 0.f;
        asm volatile("" ::: "memory");
#pragma unroll
        for (int kk = 0; kk < 32; ++kk) a[kk] = __builtin_nontemporal_load(&pq[(size_t)(64 + kk) * ldw]);
        asm volatile("" ::: "memory");
#pragma unroll
        for (int kk = 0; kk < 32; ++kk) scr[(32 + kk) * 65 + lane] = live ? b[kk] : 0.f;
        emit(kbase + 64 * kq);
    }
    { const float* pq = p + (size_t)(64 * 3) * ldw;
#pragma unroll
      for (int kk = 0; kk < 32; ++kk) b[kk] = __builtin_nontemporal_load(&pq[(size_t)(32 + kk) * ldw]);
      asm volatile("" ::: "memory");
#pragma unroll
      for (int kk = 0; kk < 32; ++kk) scr[kk * 65 + lane] = live ? a[kk] : 0.f;
#pragma unroll
      for (int kk = 0; kk < 32; ++kk) scr[(32 + kk) * 65 + lane] = live ? b[kk] : 0.f;
      emit(kbase + 64 * 3); }
}
__device__ __forceinline__ void tr_matrix(const Ids& I, const float* W, int K, int N, bf16* WT, LAS float* scr, bool f8 = false) {
    const int nnb = N / 64, items = (K / 256) * nnb;
    for (int it = I.gw; it < items; it += I.NGW) { const int kg = it / nnb, nb = it % nnb;
        tr_item4(W, (size_t)N, K, kg * 256, nb * 64, nb * 64 + 32, WT, nb * 64, scr, I.lane, f8, false); }
}
__device__ __forceinline__ void tr_win(const Ids& I, int gw, int NGW, int l, LAS float* scr) {
    unsigned char* wl = (unsigned char*)(kargs()->ws + WS_W + (size_t)l * SZ_WL);
    const float* W = INP(1) + (size_t)l * D * IN_WIDTH; unsigned char* WB = wl + OFF_WIN;
    const int nnb = NIN_PAD / 64, items = (D / 256) * nnb;
    for (int it = gw; it < items; it += NGW) { const int kg = it / nnb, nb = it % nnb, r = nb * 64; const int sa = win_src(r), sb = win_src(r + 32);
        bf16* dst; int drow; bool f8;
        if (r < N16A) { dst = (bf16*)(WB + WIN_16A); drow = r; f8 = false; }
        else if (r < N16A + N8A) { dst = (bf16*)(WB + WIN_8A); drow = r - N16A; f8 = true; }
        else if (r < N16A + N8A + N16V) { dst = (bf16*)(WB + WIN_16V); drow = r - (N16A + N8A); f8 = false; }
        else { dst = (bf16*)(WB + WIN_8V); drow = r - (N16A + N8A + N16V); f8 = true; }
        tr_item4(W, (size_t)IN_WIDTH, D, kg * 256, sa, sb, dst, drow, scr, I.lane, f8, r < 8192); }
}
__device__ __forceinline__ void tr_bro(Ids I, int gw, int NGW, int l, LAS float* scr) {
    unsigned char* wl = (unsigned char*)(kargs()->ws + WS_W + (size_t)l * SZ_WL);
    I.gw = gw; I.NGW = NGW;
    for (int i = 0; i < 3; ++i) tr_matrix(I, INP(8) + ((size_t)l * 3 + i) * BW * D, BW, D, (bf16*)(wl + OFF_WBR) + (size_t)i * D * BW, scr, i == 1);
    tr_matrix(I, INP(9) + (size_t)l * D * D, D, D, (bf16*)(wl + OFF_WO), scr);
}
__device__ __forceinline__ void tr_ffn(Ids I, int gw, int NGW, int l, LAS float* scr) {
    unsigned char* wl = (unsigned char*)(kargs()->ws + WS_W + (size_t)l * SZ_WL);
    I.gw = gw; I.NGW = NGW;
    { const float* W = INP(12) + (size_t)l * D * 2 * FF; bf16* WT = (bf16*)(wl + OFF_WFI);
      const int nnb = 2 * FF / 64, items = (D / 256) * nnb;
      for (int it = I.gw; it < items; it += I.NGW) { const int kg = it / nnb, nb = it % nnb, t = nb >> 2, q = nb & 3, src = q < 2 ? 128 * t + 64 * q : FF + 128 * t + 64 * (q - 2);
          tr_item4(W, (size_t)(2 * FF), D, kg * 256, src, src + 32, WT, nb * 64, scr, I.lane, false, false); } }
    tr_matrix(I, INP(15) + (size_t)l * FF * D, FF, D, (bf16*)(wl + OFF_WFO), scr);
}
__device__ __forceinline__ void p0_prologue_a(Frame& F) {
    const Ids I = phase_ids(F.wv);
    LAS float* scr = (LAS float*)(F.lds + I.wave * 16640);
    tr_win(I, I.gw, I.NGW, 0, scr);
    { const f32x4* x4 = (const f32x4*)INP(0); const size_t n8 = (size_t)M * D / 8, nb8 = (size_t)MB * D / 8, stride = (size_t)I.G * 512;
      for (size_t i = (size_t)blockIdx.x * 512 + I.tid; i < n8; i += stride) { const f32x4 a = x4[2 * i], b = x4[2 * i + 1]; v4u w; w.x = pk2(a[0], a[1]); w.y = pk2(a[2], a[3]); w.z = pk2(b[0], b[1]); w.w = pk2(b[2], b[3]);
          unsigned char* ar = (unsigned char*)(kargs()->ws + WS_ARENA + (i / nb8) * ARENA); const size_t li = i % nb8;
          ((v4u*)(ar + A_XB))[li] = w;
          v2u q; q.x = cvt4_fp8(a[0], a[1], a[2], a[3]); q.y = cvt4_fp8(b[0], b[1], b[2], b[3]); ((v2u*)(ar + A_XB8))[li] = q; } }
}
__device__ __forceinline__ void p0_prologue_full(Frame& F) {
    const Ids I = phase_ids(F.wv);
    LAS float* scr = (LAS float*)(F.lds + I.wave * 16640);
    p0_prologue_a(F);
#if defined(PROBE_HALF_CONV)
    if (blockIdx.x & 1) return;
    { const int g2 = (blockIdx.x >> 1) * NWAVES + I.wave, n2 = (I.G >> 1) * NWAVES;
      tr_bro(I, g2, n2, 0, scr); tr_ffn(I, g2, n2, 0, scr); tr_win(I, g2, n2, 1, scr); tr_bro(I, g2, n2, 1, scr); tr_ffn(I, g2, n2, 1, scr); }
#else
    tr_bro(I, I.gw, I.NGW, 0, scr); tr_ffn(I, I.gw, I.NGW, 0, scr);
    tr_win(I, I.gw, I.NGW, 1, scr); tr_bro(I, I.gw, I.NGW, 1, scr); tr_ffn(I, I.gw, I.NGW, 1, scr);
#endif
}
__device__ __forceinline__ void p0_prologue_b(Frame& F) {
    const Ids I = phase_ids(F.wv);
    LAS float* scr = (LAS float*)(F.lds + I.wave * 16640);
    const int gwv = F.gb * NWAVES + I.wave;
    if (F.grp == 1) { tr_bro(I, gwv, 512, 0, scr); tr_bro(I, gwv, 512, 1, scr); }
    else if (F.grp == 2) { tr_ffn(I, gwv, 512, 0, scr); }
    else if (F.grp == 3) { tr_win(I, gwv, 512, 1, scr); tr_ffn(I, gwv, 512, 1, scr); }
    asm volatile("s_waitcnt vmcnt(0)" ::: "memory"); __syncthreads();
    if (I.tid == 0) { __builtin_amdgcn_fence(__ATOMIC_RELEASE, "agent"); asm volatile("s_waitcnt vmcnt(0)" ::: "memory");
        __hip_atomic_fetch_add((unsigned*)(GAS unsigned*)(kargs()->ws + WS_CTL) + CW_CONV, 1u, __ATOMIC_RELAXED, __HIP_MEMORY_SCOPE_AGENT); }
}
__device__ __forceinline__ void wait_weights(Frame& F) {
    const Ids I = phase_ids(F.wv);
    if (I.tid == 0) { unsigned* c = (unsigned*)(GAS unsigned*)(kargs()->ws + WS_CTL) + CW_CONV; unsigned sp = 0;
        while (__hip_atomic_load(c, __ATOMIC_RELAXED, __HIP_MEMORY_SCOPE_AGENT) < 192u) { __builtin_amdgcn_s_sleep(8); if (++sp > (1u << 22)) break; }
        __builtin_amdgcn_fence(__ATOMIC_ACQUIRE, "agent"); asm volatile("s_waitcnt vmcnt(0)" ::: "memory"); }
    __syncthreads();
}

__device__ __forceinline__ void conv_fix_phase(Frame& F, int layer) {
    const Ids I = group_ids(F);
    const float* HALO = WSB(const float, A_HALOC); bf16* YC = WSB(bf16, A_YC);
    const float* wc = INP(3) + (size_t)layer * 3 * BW;
    constexpr int J = BW / 8, NIT = 15 * 2 * J;
    for (int it = I.gw * 64 + I.lane; it < NIT; it += I.NGW * 64) {
        const int c8 = (it % J) * 8, bs = it / J, side = bs & 1, t = 1 + (bs >> 1);
        const int tile = side ? t : t - 1, s_own = side ? 0 : 1, tile_nb = side ? t - 1 : t, s_nb = side ? 1 : 0, row = side ? 256 * t : 256 * t - 1;
        const float* own = HALO + ((size_t)(tile * 2 + s_own) * 3) * BW + c8; const float* nb = HALO + ((size_t)(tile_nb * 2 + s_nb) * 3) * BW + c8;
        const float* wt = wc + (side ? 0 : 2) * BW + c8;
        float o[8];
#pragma unroll
        for (int h = 0; h < 2; ++h) { const f32x4 part = *(const f32x4*)(own + BW + 4 * h), pn = *(const f32x4*)(nb + 4 * h), w4 = *(const f32x4*)(wt + 4 * h), b4 = *(const f32x4*)(own + 2 * BW + 4 * h);
            const f32x4 v = b4 * (part + w4 * pn); o[4 * h] = v[0]; o[4 * h + 1] = v[1]; o[4 * h + 2] = v[2]; o[4 * h + 3] = v[3]; }
        *(v4u*)(YC + (size_t)row * BW + c8) = pack8(o);
    }
}
__device__ __forceinline__ void ln_phase(Frame& F, const float* V, const float* g, const float* b, float* XF, bf16* XBo, bf16* XB8o = nullptr, float* st = nullptr) {
    const Ids I = group_ids(F);
    LAS f32x4* gl = (LAS f32x4*)F.lds; LAS f32x4* bl = gl + D / 4;
    __syncthreads();
    for (int i = I.tid; i < D / 4; i += NWAVES * 64) { gl[i] = ((const f32x4*)g)[i]; bl[i] = ((const f32x4*)b)[i]; }
    __syncthreads();
    f32x4 v[16], vn[16];
    if (I.gw < MB) { const f32x4* vr = (const f32x4*)(V + (size_t)I.gw * D) + I.lane;
#pragma unroll
        for (int j = 0; j < 16; ++j) vn[j] = __builtin_nontemporal_load(&vr[64 * j]); }
    for (int m = I.gw; m < MB; m += I.NGW) {
#pragma unroll
        for (int j = 0; j < 16; ++j) v[j] = vn[j];
        if (m + I.NGW < MB) { const f32x4* vr = (const f32x4*)(V + (size_t)(m + I.NGW) * D) + I.lane;
#pragma unroll
            for (int j = 0; j < 16; ++j) vn[j] = __builtin_nontemporal_load(&vr[64 * j]); }
        float s = 0.f;
#pragma unroll
        for (int j = 0; j < 16; ++j) s += (v[j][0] + v[j][1]) + (v[j][2] + v[j][3]);
        const float mean = wave_sum(s, I.lane) * (1.f / D); float s2 = 0.f;
#pragma unroll
        for (int j = 0; j < 16; ++j) { v[j] = v[j] - mean; s2 += (v[j][0] * v[j][0] + v[j][1] * v[j][1]) + (v[j][2] * v[j][2] + v[j][3] * v[j][3]); }
        const float rstd = 1.f / sqrtf(wave_sum(s2, I.lane) * (1.f / D) + LN_EPS);
        if (st && I.lane == 0) { st[2 * (size_t)m] = mean; st[2 * (size_t)m + 1] = rstd; }
        f32x4* xo = (f32x4*)(XF + (size_t)m * D) + I.lane; v2u* bo = (v2u*)(XBo + (size_t)m * D) + I.lane;
#pragma unroll
        for (int j = 0; j < 16; ++j) { const f32x4 gg = gl[I.lane + 64 * j], bb = bl[I.lane + 64 * j];
            const f32x4 o = v[j] * rstd * gg + bb; if (XF) __builtin_nontemporal_store(o, &xo[64 * j]); if (XBo) { v2u w; w.x = pk2(o[0], o[1]); w.y = pk2(o[2], o[3]); __builtin_nontemporal_store(w, &bo[64 * j]); }
            if (FP8_EMU && XB8o) { v2u q; q.x = pk2(q8_e4m3(o[0]), q8_e4m3(o[1])); q.y = pk2(q8_e4m3(o[2]), q8_e4m3(o[3])); ((v2u*)(XB8o + (size_t)m * D) + I.lane)[64 * j] = q; }
            if (FP8_GATES && XB8o) ((unsigned*)((unsigned char*)XB8o + (size_t)m * D) + I.lane)[64 * j] = cvt4_fp8(o[0], o[1], o[2], o[3]); }
    }
}
__device__ __forceinline__ void convglu_fix_phase(Frame& F, int layer) {
    const Ids I = group_ids(F);
    const float* HALO = WSB(const float, A_HALO); bf16* G = WSB(bf16, A_G);
    const float* wc = INP(13) + (size_t)layer * 3 * FF;
    constexpr int J = FF / 8, NIT = 15 * 2 * J;
    for (int it = I.gw * 64 + I.lane; it < NIT; it += I.NGW * 64) {
        const int c8 = (it % J) * 8, bs = it / J, side = bs & 1, t = 1 + (bs >> 1);
        const int tile = side ? t : t - 1, s_own = side ? 0 : 1, tile_nb = side ? t - 1 : t, s_nb = side ? 1 : 0, row = side ? 256 * t : 256 * t - 1;
        const float* own = HALO + ((size_t)(tile * 2 + s_own) * 3) * FF + c8; const float* nb = HALO + ((size_t)(tile_nb * 2 + s_nb) * 3) * FF + c8;
        const float* wt = wc + (side ? 0 : 2) * FF + c8;
        float o[8];
#pragma unroll
        for (int h = 0; h < 2; ++h) { const f32x4 pre = *(const f32x4*)(own + FF + 4 * h), an = *(const f32x4*)(nb + 4 * h), w4 = *(const f32x4*)(wt + 4 * h), u4 = *(const f32x4*)(own + 2 * FF + 4 * h);
            const f32x4 v = pre + w4 * an;
            const pg8::f32x2 g0 = pg8::gelu_pk((pg8::f32x2){v[0], v[1]}), g1 = pg8::gelu_pk((pg8::f32x2){v[2], v[3]});
            o[4 * h] = g0.x * u4[0]; o[4 * h + 1] = g0.y * u4[1]; o[4 * h + 2] = g1.x * u4[2]; o[4 * h + 3] = g1.y * u4[3]; }
        *(v4u*)(G + (size_t)row * FF + c8) = pack8(o);
    }
}
__device__ __forceinline__ void gla_combine_phase(Frame& F, int layer) {
    const Ids I = group_ids(F);
    const bf16* O0 = WSB(const bf16, A_O); const bf16* O1 = O0 + (size_t)MB * 2048; const bf16* HB = WSB(const bf16, A_HB); bf16* YG = WSB(bf16, A_YG);
    const float* ng = INP(7) + (size_t)layer * 2048;
    for (int idx = I.gw; idx < MB * 4; idx += 2 * I.NGW) {
        v4u a[2], bq[2], rr[2]; f32x4 g0[2], g1[2]; size_t off[2];
        asm volatile("" ::: "memory");
#pragma unroll
        for (int k = 0; k < 2; ++k) { const int id = min(idx + k * I.NGW, MB * 4 - 1), m = id >> 2, h = id & 3; off[k] = (size_t)m * 2048 + h * 512 + 8 * I.lane;
            a[k] = *(const v4u*)(O0 + off[k]); bq[k] = *(const v4u*)(O1 + off[k]); rr[k] = *(const v4u*)(HB + (size_t)m * LDH + H_GR + h * 512 + 8 * I.lane);
            g0[k] = *(const f32x4*)(ng + h * 512 + 8 * I.lane); g1[k] = *(const f32x4*)(ng + h * 512 + 8 * I.lane + 4); }
        asm volatile("" : "+v"(a[0]), "+v"(a[1]), "+v"(bq[0]), "+v"(bq[1]), "+v"(rr[0]), "+v"(rr[1]), "+v"(g0[0]), "+v"(g0[1]), "+v"(g1[0]), "+v"(g1[1]));
#pragma unroll
        for (int k = 0; k < 2; ++k) {
            float o[8], ob_[8]; unpack8(a[k], o); unpack8(bq[k], ob_);
#pragma unroll
            for (int e = 0; e < 8; ++e) o[e] += ob_[e];
            float ss = 0.f;
#pragma unroll
            for (int e = 0; e < 8; ++e) ss += o[e] * o[e];
            const float rs = 1.f / sqrtf(wave_sum(ss, I.lane) * (1.f / 512.f) + RMS_EPS);
            float r[8]; unpack8(rr[k], r);
            const float gg[8] = {g0[k][0], g0[k][1], g0[k][2], g0[k][3], g1[k][0], g1[k][1], g1[k][2], g1[k][3]};
#pragma unroll
            for (int e = 0; e < 8; ++e) o[e] = o[e] * rs * gg[e] * (r[e] / (1.f + __expf(-r[e])));
            if (idx + k * I.NGW < MB * 4) *(v4u*)(YG + off[k]) = pack8(o);
        }
    }
}

constexpr int NA_RPB_OFF = 15 * 8192;
__device__ __forceinline__ void na_phase(Frame& F, int layer) {
    const Ids I = group_ids(F);
    const bf16* HB = WSB(const bf16, A_HB); const bf16* VT = WSB(const bf16, A_VT); bf16* YN = WSB(bf16, A_YN);
    const float* rpb = INP(4) + (size_t)layer * 16 * 465;
    LAS float* rpbs = (LAS float*)(F.lds + NA_RPB_OFF);
    const int fr = I.lane & 15, q4 = I.lane >> 4;
    const int sb_ = I.lane * 16, swz = sb_ ^ (((sb_ >> 9) & 1) << 5), rl = swz >> 6, cl = (swz & 63) >> 1;
    const int ob = fr * 64 + 16 * q4, lo = ob ^ (((ob >> 9) & 1) << 5);
    for (int it = I.bi; it < 512; it += I.G) {
        const int rblk = it & 7, cblk = (it >> 3) & 3, h = (it >> 5) & 15, b = 0;
        const int r = rblk * 8 + I.wave, c0 = cblk * 16;
        const int krs = min(max(rblk * 8 - 4, 0), 49), rs = min(max(r - 4, 0), 56), cs = min(max(c0 - 8, 0), 32), koff = rs - krs;
        const int mq = b * SEQ + r * 64 + c0 + fr;
        asm volatile("s_waitcnt lgkmcnt(0)" ::: "memory"); __builtin_amdgcn_s_barrier(); asm volatile("" ::: "memory");
#pragma unroll
        for (int i = 0; i < 15; ++i) { const int q = I.wave * 15 + i, kr = q >> 3, pc = q & 7, slab = pc >> 2, j = pc & 3;
            const int key = pg8::perm32((j >> 1) * 16 + rl), col = slab * 64 + (j & 1) * 32 + cl;
            __builtin_amdgcn_global_load_lds((const GAS unsigned*)(HB + (size_t)(b * SEQ + (krs + kr) * 64 + cs + key) * LDH + H_NK + h * 128 + col), (LAS unsigned*)(F.lds + kr * 8192 + pc * 1024), 16, 0, 0); }
        for (int i = I.tid; i < 465; i += 512) rpbs[i] = rpb[h * 465 + i];
        const bf16* qp = HB + (size_t)mq * LDH + H_NQ + h * 128 + 8 * q4;
        bf16x8 qf[4];
#pragma unroll
        for (int s = 0; s < 4; ++s) qf[s] = *(const bf16x8*)(qp + 32 * s);
        asm volatile("s_waitcnt vmcnt(0) lgkmcnt(0)" ::: "memory"); __builtin_amdgcn_s_barrier(); asm volatile("" ::: "memory");
        const int cq = c0 + fr, ws = min(max(cq - 8, 0), 48);
        f32x4 sc[8][2];
        float mx = -1e30f;
        auto ldk = [&](bf16x8 (&f)[8], float (&bs)[8], int sp) {
            const LAS unsigned char* kb = F.lds + (koff + sp) * 8192 + lo; const int brow = (rs + sp - r + 7) * 31;
#pragma unroll
            for (int u = 0; u < 2; ++u)
#pragma unroll
                for (int s = 0; s < 4; ++s) f[4 * u + s] = *(const LAS bf16x8*)(kb + (s >> 1) * 4096 + (2 * u + (s & 1)) * 1024);
#pragma unroll
            for (int u = 0; u < 2; ++u)
#pragma unroll
                for (int j = 0; j < 4; ++j) { const int kc = cs + 8 * q4 + 4 * u + j; bs[4 * u + j] = rpbs[brow + min(max(kc - cq + 15, 0), 30)]; } };
        auto qk = [&](bf16x8 (&f)[8], float (&bs)[8], int sp) {
            asm volatile("" : "+v"(f[0]), "+v"(f[1]), "+v"(f[2]), "+v"(f[3]), "+v"(f[4]), "+v"(f[5]), "+v"(f[6]), "+v"(f[7]), "+v"(bs[0]), "+v"(bs[1]), "+v"(bs[2]), "+v"(bs[3]), "+v"(bs[4]), "+v"(bs[5]), "+v"(bs[6]), "+v"(bs[7]));
#pragma unroll
            for (int u = 0; u < 2; ++u) { f32x4 d = (f32x4){0.f, 0.f, 0.f, 0.f};
#pragma unroll
                for (int s = 0; s < 4; ++s) d = mfma16(f[4 * u + s], qf[s], d);
#pragma unroll
                for (int j = 0; j < 4; ++j) { const int kc = cs + 8 * q4 + 4 * u + j; const bool valid = (kc >= ws) && (kc < ws + 16);
                    const float v = valid ? d[j] * 0.08838834764831845f + bs[4 * u + j] : -1e30f;
                    sc[sp][u][j] = v; mx = fmaxf(mx, v); } } };
        { bf16x8 fa[8], fb[8]; float ba[8], bb2[8];
          ldk(fa, ba, 0);
#pragma unroll
          for (int sp = 0; sp < 8; sp += 2) {
              ldk(fb, bb2, sp + 1); qk(fa, ba, sp);
              if (sp + 2 < 8) ldk(fa, ba, sp + 2);
              qk(fb, bb2, sp + 1); } }
        mx = fmaxf(mx, shx(mx, 16, I.lane)); mx = fmaxf(mx, shx(mx, 32, I.lane));
        float sum = 0.f;
        bf16x8 pf[8];
#pragma unroll
        for (int sp = 0; sp < 8; ++sp) { float p[8];
#pragma unroll
            for (int u = 0; u < 2; ++u)
#pragma unroll
                for (int j = 0; j < 4; ++j) { const float e = __builtin_amdgcn_exp2f((sc[sp][u][j] - mx) * 1.44269504f); p[4 * u + j] = e; sum += e; }
            const v4u w = pack8(p); pf[sp] = __builtin_bit_cast(bf16x8, w); }
        sum += shx(sum, 16, I.lane); sum += shx(sum, 32, I.lane);
        const float inv = 1.f / sum;
        asm volatile("s_waitcnt lgkmcnt(0)" ::: "memory"); __builtin_amdgcn_s_barrier(); asm volatile("" ::: "memory");
#pragma unroll
        for (int i = 0; i < 15; ++i) { const int q = I.wave * 15 + i, kr = q >> 3, dt = q & 7;
            __builtin_amdgcn_global_load_lds((const GAS unsigned*)(VT + (size_t)(h * 128 + 16 * dt + rl) * MB + b * SEQ + (krs + kr) * 64 + cs + cl), (LAS unsigned*)(F.lds + kr * 8192 + dt * 1024), 16, 0, 0); }
        asm volatile("s_waitcnt vmcnt(0)" ::: "memory"); __builtin_amdgcn_s_barrier(); asm volatile("" ::: "memory");
        { const float i16 = inv * 16.f;
          auto ldv = [&](bf16x8 (&f)[8], int dt) {
#pragma unroll
              for (int sp = 0; sp < 8; ++sp) f[sp] = *(const LAS bf16x8*)(F.lds + (koff + sp) * 8192 + dt * 1024 + lo); };
          auto pv = [&](bf16x8 (&f)[8], int dt) {
              asm volatile("" : "+v"(f[0]), "+v"(f[1]), "+v"(f[2]), "+v"(f[3]), "+v"(f[4]), "+v"(f[5]), "+v"(f[6]), "+v"(f[7]));
              f32x4 o = (f32x4){0.f, 0.f, 0.f, 0.f};
#pragma unroll
              for (int sp = 0; sp < 8; ++sp) o = mfma16(f[sp], pf[sp], o);
              *(unsigned*)((unsigned char*)YN + (size_t)mq * BW + h * 128 + 16 * dt + 4 * q4) = cvt4_fp8(o[0] * i16, o[1] * i16, o[2] * i16, o[3] * i16); };
          bf16x8 va[8], vb[8];
          ldv(va, 0);
#pragma unroll
          for (int dt = 0; dt < 8; dt += 2) {
              ldv(vb, dt + 1); pv(va, dt);
              if (dt + 2 < 8) ldv(va, dt + 2);
              pv(vb, dt + 1); } }
    }
}

__device__ __forceinline__ float logsigmoid16(float z) { const float e = __builtin_amdgcn_exp2f(-1.44269504f * fabsf(z)); return (fminf(z, 0.f) - 0.69314718f * __builtin_amdgcn_logf(1.0f + e)) * 0.0625f; }
__device__ __forceinline__ void gla_prep_phase(Frame& F, int layer) {
    const Ids I = group_ids(F);
    constexpr int RS = 264;
    LAS bf16* qs = (LAS bf16*)F.lds; LAS bf16* ks = qs + 2 * 64 * RS; LAS float* gas = (LAS float*)(ks + 2 * 64 * RS);
    const bf16* HB = WSB(const bf16, A_HB); const bf16* XBp = WSB(const bf16, A_XB);
    const bf16* WGA = (const bf16*)(kargs()->ws + WS_W + (size_t)layer * SZ_WL + OFF_WIN + WIN_16A) + (size_t)10240 * D;
    bf16* QIN = WSB(bf16, A_QIN); bf16* KOT = WSB(bf16, A_KOT); bf16* ATT = WSB(bf16, A_ATT); float* DEC = WSB(float, A_DEC);
    const float* wdec = INP(5) + (size_t)layer * 2 * 16 * 1024; const float* bdec = INP(6) + (size_t)layer * 2 * 1024;
    const int dir = I.tid >> 8, c = I.tid & 255, fr = I.lane & 15, q4 = I.lane >> 4;
    for (int it2 = I.bi; it2 < 64; it2 += I.G) {
      const int chunk = it2, m0 = chunk * 64;
      __syncthreads();
      { f32x4 ga_acc[4][2];
#pragma unroll
        for (int mt = 0; mt < 4; ++mt)
#pragma unroll
            for (int nt = 0; nt < 2; ++nt) ga_acc[mt][nt] = (f32x4){0.f, 0.f, 0.f, 0.f};
        const bf16* xa = XBp + (size_t)(m0 + fr) * D + I.wave * 512 + 8 * q4; const bf16* wb = WGA + (size_t)fr * D + I.wave * 512 + 8 * q4;
#pragma unroll 1
        for (int kb = 0; kb < 4; ++kb) { bf16x8 af[4][4], bfr[4][2];
#pragma unroll
            for (int kk = 0; kk < 4; ++kk) {
#pragma unroll
                for (int mt = 0; mt < 4; ++mt) af[kk][mt] = *(const bf16x8*)(xa + (size_t)(16 * mt) * D + 32 * (4 * kb + kk));
#pragma unroll
                for (int nt = 0; nt < 2; ++nt) bfr[kk][nt] = *(const bf16x8*)(wb + (size_t)(16 * nt) * D + 32 * (4 * kb + kk)); }
            asm volatile("" : "+v"(af[0][0]), "+v"(af[0][1]), "+v"(af[0][2]), "+v"(af[0][3]), "+v"(af[1][0]), "+v"(af[1][1]), "+v"(af[1][2]), "+v"(af[1][3]),
                              "+v"(af[2][0]), "+v"(af[2][1]), "+v"(af[2][2]), "+v"(af[2][3]), "+v"(af[3][0]), "+v"(af[3][1]), "+v"(af[3][2]), "+v"(af[3][3]),
                              "+v"(bfr[0][0]), "+v"(bfr[0][1]), "+v"(bfr[1][0]), "+v"(bfr[1][1]), "+v"(bfr[2][0]), "+v"(bfr[2][1]), "+v"(bfr[3][0]), "+v"(bfr[3][1]));
#pragma unroll
            for (int kk = 0; kk < 4; ++kk)
#pragma unroll
                for (int mt = 0; mt < 4; ++mt)
#pragma unroll
                    for (int nt = 0; nt < 2; ++nt) ga_acc[mt][nt] = mfma16(af[kk][mt], bfr[kk][nt], ga_acc[mt][nt]); }
        LAS float* part = (LAS float*)F.lds + I.wave * 2048;
#pragma unroll
        for (int mt = 0; mt < 4; ++mt)
#pragma unroll
            for (int nt = 0; nt < 2; ++nt)
#pragma unroll
                for (int j = 0; j < 4; ++j) part[(16 * mt + 4 * q4 + j) * 32 + 16 * nt + fr] = ga_acc[mt][nt][j];
        __syncthreads();
        f32x4 s4 = ((const LAS f32x4*)F.lds)[I.tid];
#pragma unroll
        for (int w8 = 1; w8 < 8; ++w8) s4 += ((const LAS f32x4*)F.lds)[w8 * 512 + I.tid];
        { const int tk = I.tid >> 3, rr0 = (I.tid & 7) * 4;
#pragma unroll
          for (int j = 0; j < 4; ++j) gas[(rr0 + j) * 68 + tk] = s4[j]; } }
      for (int h = 0; h < 4; ++h) {
        const int ch = h * 256 + c;
        __syncthreads();
        float w[16];
#pragma unroll
        for (int r = 0; r < 16; ++r) w[r] = wdec[(dir * 16 + r) * 1024 + ch];
        const float bd = bdec[dir * 1024 + ch];
        __syncthreads();
        const LAS float* ga = gas + dir * 16 * 68;
        const bf16* qg = HB + (size_t)m0 * LDH + H_GQ + ch; const bf16* kg = HB + (size_t)m0 * LDH + H_GK + ch;
        unsigned qA[8], kA[8], qB[8], kB[8];
        auto ldqk = [&](unsigned (&q)[8], unsigned (&k)[8], int tb) {
#pragma unroll
            for (int e = 0; e < 8; ++e) { q[e] = qg[(size_t)(8 * tb + e) * LDH]; k[e] = kg[(size_t)(8 * tb + e) * LDH]; } };
        asm volatile("" ::: "memory"); ldqk(qA, kA, 0); asm volatile("" ::: "memory");
        float pre[64]; float run = 0.f;
#pragma unroll
        for (int tg = 0; tg < 16; ++tg) { pg8::f32x2 z01 = (pg8::f32x2){bd, bd}, z23 = (pg8::f32x2){bd, bd};
#pragma unroll
            for (int r = 0; r < 16; ++r) { const f32x4 g4 = *(const LAS f32x4*)(ga + r * 68 + 4 * tg); const pg8::f32x2 wr = (pg8::f32x2){w[r], w[r]};
                z01 += (pg8::f32x2){g4[0], g4[1]} * wr; z23 += (pg8::f32x2){g4[2], g4[3]} * wr; }
            run += logsigmoid16(z01.x); pre[4 * tg] = run; run += logsigmoid16(z01.y); pre[4 * tg + 1] = run;
            run += logsigmoid16(z23.x); pre[4 * tg + 2] = run; run += logsigmoid16(z23.y); pre[4 * tg + 3] = run; }
        const float tot = run, dec = __builtin_amdgcn_exp2f(tot * 1.44269504f);
        unsigned ko[32];
        bf16* qo = QIN + ((size_t)dir * MB + m0) * 1024 + ch;
        auto use = [&](unsigned (&qr)[8], unsigned (&kr)[8], int tb) {
            asm volatile("" : "+v"(qr[0]), "+v"(qr[1]), "+v"(qr[2]), "+v"(qr[3]), "+v"(qr[4]), "+v"(qr[5]), "+v"(qr[6]), "+v"(qr[7]),
                              "+v"(kr[0]), "+v"(kr[1]), "+v"(kr[2]), "+v"(kr[3]), "+v"(kr[4]), "+v"(kr[5]), "+v"(kr[6]), "+v"(kr[7]));
#pragma unroll
            for (int e2 = 0; e2 < 4; ++e2) { float kov[2];
#pragma unroll
                for (int e = 0; e < 2; ++e) { const int t = 8 * tb + 2 * e2 + e;
                    const float cum = dir == 0 ? pre[t] : tot - (t > 0 ? pre[t > 0 ? t - 1 : 0] : 0.f);
                    const float e1 = __builtin_amdgcn_exp2f(cum * 1.44269504f), einv = __builtin_amdgcn_rcpf(e1);
                    const float qv = __uint_as_float(qr[2 * e2 + e] << 16), kv = __uint_as_float(kr[2 * e2 + e] << 16);
                    const float q_in = qv * 0.0625f * e1, k_in = kv * einv; kov[e] = k_in * dec;
                    const unsigned qb = pk2(q_in, 0.f) & 0xffffu, kb = pk2(k_in, 0.f) & 0xffffu;
                    qs[(dir * 64 + t) * RS + c] = (bf16)qb; ks[(dir * 64 + t) * RS + c] = (bf16)kb; qo[(size_t)t * 1024] = (bf16)qb; }
                ko[4 * tb + e2] = pk2(kov[0], kov[1]); } };
#pragma unroll
        for (int tb = 0; tb < 8; tb += 2) {
            asm volatile("" ::: "memory"); ldqk(qB, kB, tb + 1); asm volatile("" ::: "memory");
            use(qA, kA, tb);
            asm volatile("" ::: "memory"); if (tb + 2 < 8) ldqk(qA, kA, tb + 2); asm volatile("" ::: "memory");
            use(qB, kB, tb + 1); }
        { v4u* kd = (v4u*)(KOT + ((size_t)dir * 1024 + ch) * MB + m0);
#pragma unroll
            for (int i = 0; i < 8; ++i) { v4u w4; w4.x = ko[4 * i]; w4.y = ko[4 * i + 1]; w4.z = ko[4 * i + 2]; w4.w = ko[4 * i + 3]; kd[i] = w4; } }
        DEC[((size_t)dir * 64 + chunk) * 1024 + ch] = dec;
        __syncthreads();
        { const int adir = I.wave >> 2, mt = I.wave & 3, i = 16 * mt + fr;
          const LAS bf16* qrow = qs + (adir * 64 + i) * RS + 8 * q4;
          bf16* arow = ATT + ((((size_t)adir * 4 + h) * 64 + chunk) * 64 + i) * 64;
          bf16x8 qf[8];
#pragma unroll
          for (int s = 0; s < 8; ++s) qf[s] = *(const LAS bf16x8*)(qrow + 32 * s);
          auto ldkt = [&](bf16x8 (&f)[8], int nt) { const LAS bf16* krow = ks + (adir * 64 + 16 * nt + fr) * RS + 8 * q4;
#pragma unroll
              for (int s = 0; s < 8; ++s) f[s] = *(const LAS bf16x8*)(krow + 32 * s); };
          auto att = [&](bf16x8 (&f)[8], int nt) {
              asm volatile("" : "+v"(f[0]), "+v"(f[1]), "+v"(f[2]), "+v"(f[3]), "+v"(f[4]), "+v"(f[5]), "+v"(f[6]), "+v"(f[7]));
              f32x4 d = (f32x4){0.f, 0.f, 0.f, 0.f};
#pragma unroll
              for (int s = 0; s < 8; ++s) d = mfma16(f[s], qf[s], d);
              const int j0 = 16 * nt + 4 * q4; float v[4];
#pragma unroll
              for (int jj = 0; jj < 4; ++jj) { const bool keep = adir == 0 ? (j0 + jj <= i) : (j0 + jj >= i); v[jj] = keep ? d[jj] : 0.f; }
              v2u w2; w2.x = pk2(v[0], v[1]); w2.y = pk2(v[2], v[3]); *(v2u*)(arow + j0) = w2; };
          bf16x8 ka[8], kb[8];
          ldkt(ka, 0); ldkt(kb, 1); att(ka, 0); ldkt(ka, 2); att(kb, 1); ldkt(kb, 3); att(ka, 2); att(kb, 3); }
      }
    }
}
constexpr int SCAN_Q = 0, SCAN_K = 32768, SCAN_A = 65536, SCAN_D = 73728, SCAN_BUF = 74752;
__device__ __forceinline__ void scan_stage(const bf16* QIN, const bf16* KOT, const bf16* ATT, const float* DEC, LAS unsigned char* buf, int lw, int lane, int dir, int h, int c) {
    const int m0 = c * 64;
    const int sb_ = lane * 16, swz = sb_ ^ (((sb_ >> 9) & 1) << 5), rl = swz >> 6, cl = (swz & 63) >> 1;
#pragma unroll
    for (int i = 0; i < 8; ++i) { const int q = lw * 8 + i, sl = q >> 3, j = q & 7, R = (j >> 1) * 16 + rl, C = (j & 1) * 32 + cl;
        __builtin_amdgcn_global_load_lds((const GAS unsigned*)(QIN + ((size_t)dir * MB + m0 + R) * 1024 + h * 256 + sl * 64 + C), (LAS unsigned*)(buf + SCAN_Q + sl * 8192 + j * 1024), 16, 0, 0); }
#pragma unroll
    for (int i = 0; i < 8; ++i) { const int k = lw * 8 + i, hh = k >> 4, j = k & 15, Rg = 128 * hh + (j >> 1) * 16 + rl, C = (j & 1) * 32 + cl, Rb = (Rg & ~31) + pg8::perm32(Rg & 31);
        __builtin_amdgcn_global_load_lds((const GAS unsigned*)(KOT + ((size_t)dir * 1024 + h * 256 + Rb) * MB + m0 + C), (LAS unsigned*)(buf + SCAN_K + hh * 16384 + j * 1024), 16, 0, 0); }
    const bf16* ab = ATT + (((size_t)dir * 4 + h) * 64 + c) * 4096;
#pragma unroll
    for (int i = 0; i < 2; ++i) { const int j = lw * 2 + i, R = (j >> 1) * 16 + rl, C = (j & 1) * 32 + cl;
        __builtin_amdgcn_global_load_lds((const GAS unsigned*)(ab + R * 64 + C), (LAS unsigned*)(buf + SCAN_A + j * 1024), 16, 0, 0); }
    if (lw == 0) __builtin_amdgcn_global_load_lds((const GAS unsigned*)(DEC + ((size_t)dir * 64 + c) * 1024 + h * 256 + lane * 4), (LAS unsigned*)(buf + SCAN_D), 16, 0, 0);
}
__device__ __forceinline__ void scan_load(v4u (&R)[19], const bf16* QIN, const bf16* KOT, const bf16* ATT, const float* DEC, int lw, int lane, int dir, int h, int c) {
    const int m0 = c * 64;
    const int sb_ = lane * 16, swz = sb_ ^ (((sb_ >> 9) & 1) << 5), rl = swz >> 6, cl = (swz & 63) >> 1;
#pragma unroll
    for (int i = 0; i < 8; ++i) { const int q = lw * 8 + i, sl = q >> 3, j = q & 7, Rr = (j >> 1) * 16 + rl, C = (j & 1) * 32 + cl;
        R[i] = *(const v4u*)(QIN + ((size_t)dir * MB + m0 + Rr) * 1024 + h * 256 + sl * 64 + C); }
#pragma unroll
    for (int i = 0; i < 8; ++i) { const int k = lw * 8 + i, hh = k >> 4, j = k & 15, Rg = 128 * hh + (j >> 1) * 16 + rl, C = (j & 1) * 32 + cl, Rb = (Rg & ~31) + pg8::perm32(Rg & 31);
        R[8 + i] = *(const v4u*)(KOT + ((size_t)dir * 1024 + h * 256 + Rb) * MB + m0 + C); }
    const bf16* ab = ATT + (((size_t)dir * 4 + h) * 64 + c) * 4096;
#pragma unroll
    for (int i = 0; i < 2; ++i) { const int j = lw * 2 + i, Rr = (j >> 1) * 16 + rl, C = (j & 1) * 32 + cl; R[16 + i] = *(const v4u*)(ab + Rr * 64 + C); }
    R[18] = *(const v4u*)(DEC + ((size_t)dir * 64 + c) * 1024 + h * 256 + lane * 4);
}
__device__ __forceinline__ void scan_write(const v4u (&R)[19], LAS unsigned char* buf, int lw, int lane) {
#pragma unroll
    for (int i = 0; i < 8; ++i) { const int q = lw * 8 + i, sl = q >> 3, j = q & 7; *(LAS v4u*)(buf + SCAN_Q + sl * 8192 + j * 1024 + lane * 16) = R[i]; }
#pragma unroll
    for (int i = 0; i < 8; ++i) { const int k = lw * 8 + i, hh = k >> 4, j = k & 15; *(LAS v4u*)(buf + SCAN_K + hh * 16384 + j * 1024 + lane * 16) = R[8 + i]; }
#pragma unroll
    for (int i = 0; i < 2; ++i) { const int j = lw * 2 + i; *(LAS v4u*)(buf + SCAN_A + j * 1024 + lane * 16) = R[16 + i]; }
    if (lw == 0) *(LAS v4u*)(buf + SCAN_D + lane * 16) = R[18];
}
__device__ __forceinline__ void gla_scan_phase(Frame& F) {
    const Ids I = group_ids(F);
    const bf16* VT = WSB(const bf16, A_VT); const bf16* QIN = WSB(const bf16, A_QIN); const bf16* KOT = WSB(const bf16, A_KOT); const bf16* ATT = WSB(const bf16, A_ATT);
    const float* DEC = WSB(const float, A_DEC); bf16* O = WSB(bf16, A_O);
    const int fr = I.lane & 15, q4 = I.lane >> 4;
    for (int bt = I.bi; bt < 64; bt += I.G) {
        const int x = bt & 1, y = bt >> 1, sc = x * 4 + (y >> 3), eq = y & 7;
        const int dir = sc & 1, h = sc >> 1;
        asm volatile("s_waitcnt vmcnt(0) lgkmcnt(0)" ::: "memory"); __builtin_amdgcn_s_barrier(); asm volatile("" ::: "memory");
        if (I.wave >= 4) {
            const int lw = I.wave - 4;
            v4u R[19];
            scan_stage(QIN, KOT, ATT, DEC, F.lds, lw, I.lane, dir, h, dir ? 63 : 0);
            asm volatile("s_waitcnt vmcnt(0)" ::: "memory");
            scan_load(R, QIN, KOT, ATT, DEC, lw, I.lane, dir, h, dir ? 62 : 1);
            __builtin_amdgcn_s_barrier(); asm volatile("" ::: "memory");
#pragma unroll 1
            for (int step = 0; step < 64; ++step) {
                if (step + 1 < 64) scan_write(R, F.lds + ((step + 1) & 1) * SCAN_BUF, lw, I.lane);
                asm volatile("" ::: "memory");
                if (step + 2 < 64) scan_load(R, QIN, KOT, ATT, DEC, lw, I.lane, dir, h, dir ? 61 - step : step + 2);
                asm volatile("s_waitcnt lgkmcnt(0)" ::: "memory"); __builtin_amdgcn_s_barrier(); asm volatile("" ::: "memory");
            }
        } else {
            const int es = eq * 4 + I.wave;
            f32x4 st[16];
#pragma unroll
            for (int t = 0; t < 16; ++t) st[t] = (f32x4){0.f, 0.f, 0.f, 0.f};
            const bf16* vrow = VT + (size_t)(2048 + h * 512 + es * 16 + fr) * MB + 8 * q4;
            const int ob = fr * 64 + 16 * q4, lo = ob ^ (((ob >> 9) & 1) << 5);
            bf16x8 vf[2];
            { const int c0 = dir ? 63 : 0;
#pragma unroll
              for (int sp = 0; sp < 2; ++sp) vf[sp] = *(const bf16x8*)(vrow + c0 * 64 + 32 * sp); }
            asm volatile("" ::: "memory"); __builtin_amdgcn_s_barrier(); asm volatile("" ::: "memory");
            for (int step = 0; step < 64; ++step) {
                const int c = dir ? 63 - step : step, m0 = c * 64;
                const LAS unsigned char* bb = F.lds + (step & 1) * SCAN_BUF + lo;
                bf16x8 vn[2];
                { const int cn = step + 1 < 64 ? (dir ? 62 - step : step + 1) : c;
#pragma unroll
                  for (int sp = 0; sp < 2; ++sp) vn[sp] = *(const bf16x8*)(vrow + cn * 64 + 32 * sp); }
                bf16x8 sb[8];
#pragma unroll
                for (int s = 0; s < 8; ++s) { v4u w; w.x = pk2(st[2 * s][0], st[2 * s][1]); w.y = pk2(st[2 * s][2], st[2 * s][3]); w.z = pk2(st[2 * s + 1][0], st[2 * s + 1][1]); w.w = pk2(st[2 * s + 1][2], st[2 * s + 1][3]); sb[s] = __builtin_bit_cast(bf16x8, w); }
                const LAS unsigned char* dbase = F.lds + (step & 1) * SCAN_BUF + SCAN_D + 32 * q4;
                auto ldq = [&](bf16x8 (&f)[10], int mt) {
#pragma unroll
                    for (int s = 0; s < 8; ++s) f[s] = *(const LAS bf16x8*)(bb + SCAN_Q + (s >> 1) * 8192 + (2 * mt + (s & 1)) * 1024);
#pragma unroll
                    for (int sp = 0; sp < 2; ++sp) f[8 + sp] = *(const LAS bf16x8*)(bb + SCAN_A + (2 * mt + sp) * 1024); };
                auto doq = [&](bf16x8 (&f)[10], int mt) {
                    asm volatile("" : "+v"(f[0]), "+v"(f[1]), "+v"(f[2]), "+v"(f[3]), "+v"(f[4]), "+v"(f[5]), "+v"(f[6]), "+v"(f[7]), "+v"(f[8]), "+v"(f[9]));
                    f32x4 o = (f32x4){0.f, 0.f, 0.f, 0.f};
#pragma unroll
                    for (int s = 0; s < 8; ++s) o = mfma16(sb[s], f[s], o);
#pragma unroll
                    for (int sp = 0; sp < 2; ++sp) o = mfma16(vf[sp], f[8 + sp], o);
                    { v2u w; w.x = pk2_sw(o[0], o[1]); w.y = pk2_sw(o[2], o[3]); *(v2u*)(O + ((size_t)dir * MB + m0 + 16 * mt + fr) * 2048 + h * 512 + es * 16 + 4 * q4) = w; } };
                auto ldk = [&](bf16x8 (&f)[4], f32x4 (&d)[2], int g) {
#pragma unroll
                    for (int i = 0; i < 2; ++i) { const int t = 2 * g + i, s = t >> 1, u = t & 1;
                        d[i] = *(const LAS f32x4*)(dbase + (32 * s + 4 * u) * 4);
#pragma unroll
                        for (int sp = 0; sp < 2; ++sp) f[2 * i + sp] = *(const LAS bf16x8*)(bb + SCAN_K + (s >> 2) * 16384 + ((2 * (s & 3) + u) * 2 + sp) * 1024); } };
                auto dok = [&](bf16x8 (&f)[4], f32x4 (&d)[2], int g) {
                    asm volatile("" : "+v"(f[0]), "+v"(f[1]), "+v"(f[2]), "+v"(f[3]), "+v"(d[0]), "+v"(d[1]));
#pragma unroll
                    for (int i = 0; i < 2; ++i) { const int t = 2 * g + i; f32x4 a = st[t] * d[i];
#pragma unroll
                        for (int sp = 0; sp < 2; ++sp) a = mfma16(f[2 * i + sp], vf[sp], a);
                        st[t] = a; } };
                { bf16x8 qa[10], qb[10], ka[4], kb[4]; f32x4 da[2], db[2];
                  ldq(qa, 0);
                  ldq(qb, 1); doq(qa, 0);
                  ldq(qa, 2); doq(qb, 1);
                  ldq(qb, 3); doq(qa, 2);
                  ldk(ka, da, 0); doq(qb, 3);
#pragma unroll
                  for (int g = 0; g < 8; g += 2) { ldk(kb, db, g + 1); dok(ka, da, g); if (g + 2 < 8) ldk(ka, da, g + 2); dok(kb, db, g + 1); } }
                vf[0] = vn[0]; vf[1] = vn[1];
                asm volatile("s_waitcnt lgkmcnt(0)" ::: "memory"); __builtin_amdgcn_s_barrier(); asm volatile("" ::: "memory");
            }
        }
    }
}

#ifndef PG8_SP2
#define PG8_SP2 true
#endif
#ifndef PG8_ALIGN
#define PG8_ALIGN true
#endif
struct GroupOrder {
    int nA, nB, r, p, swapped;
    __device__ void init(int nB_, int gb, int swapped_) { nB = nB_; r = gb >> 1; p = gb & 1; swapped = swapped_; nA = 8; }
    __device__ bool next(int i, pg8::Unit& u) const {
        const int L = i * 32 + r;
        if (!swapped) { if (L >= 8 * nB) return false; u.pm = 8 * p + (L & 7); u.pn = L >> 3; return true; }
        if (L >= 64) return false; u.pn = 8 * p + (L & 7); u.pm = L >> 3; return true;
    }
    __device__ __forceinline__ void a_ready(const pg8::Unit&) const {}
    __device__ __forceinline__ void done(const pg8::Unit&) const {}
};
__global__ void __launch_bounds__(NWAVES * 64, 2) enc_fwd(Args args) {
    extern __shared__ __attribute__((aligned(16))) unsigned char lds[];
    Frame F;
    F.lds = (LAS unsigned char*)lds; F.wv = __builtin_amdgcn_readfirstlane(threadIdx.x >> 6);
    { const int bx = blockIdx.x; F.grp = (bx & 7) >> 1; F.gb = ((bx >> 3) << 1) | (bx & 1); }
    volatile LAS unsigned* MISC = (volatile LAS unsigned*)(F.lds + MISC_OFF);
    if (threadIdx.x < 128) MISC[threadIdx.x] = 0u;
    __syncthreads();
    { unsigned* ctl = (unsigned*)(GAS unsigned*)(args.ws + WS_CTL);
      (void)xcd_barrier_post(ctl + CW_BAR, MISC + 8);
      (void)xcd_barrier_post(ctl + CW_BAR + (1 + F.grp) * XCD_BAR_WORDS, MISC + 12); }
#define GRID_BAR() do { XcdBarrier bb; bb.wv = (unsigned)F.wv; bb.G = gridDim.x; bb.bar = (unsigned*)(GAS unsigned*)(kargs()->ws + WS_CTL) + CW_BAR; bb.x = (unsigned)__builtin_amdgcn_readfirstlane((int)xb_xcc_id()); bb.st = (volatile LAS unsigned*)(F.lds + MISC_OFF) + 8; xcd_barrier(bb); } while (0)
#define SEAM() do { XcdBarrier bb; bb.wv = (unsigned)F.wv; bb.G = 64u; bb.bar = (unsigned*)(GAS unsigned*)(kargs()->ws + WS_CTL) + CW_BAR + (1 + F.grp) * XCD_BAR_WORDS; bb.x = (unsigned)__builtin_amdgcn_readfirstlane((int)xb_xcc_id()); bb.st = (volatile LAS unsigned*)(F.lds + MISC_OFF) + 12; xcd_barrier(bb); } while (0)
    LAS unsigned char* ring = F.lds;

#ifndef GROUP_STAGGER
#define GROUP_STAGGER 0
#endif
#if GROUP_STAGGER
    p0_prologue_a(F);
    GRID_BAR();
    if (F.grp != 0) p0_prologue_b(F);
#else
    p0_prologue_full(F);
    GRID_BAR();
#ifndef GROUP_DELAY_TICKS
#define GROUP_DELAY_TICKS 0
#endif
    if (GROUP_DELAY_TICKS) { const unsigned long long t0 = __builtin_amdgcn_s_memrealtime(), dl = (unsigned long long)F.grp * GROUP_DELAY_TICKS;
        while (__builtin_amdgcn_s_memrealtime() - t0 < dl) __builtin_amdgcn_s_sleep(32); }
#endif

    for (int layer = 0; layer < DEPTH; ++layer) {
#define WL ((unsigned char*)(kargs()->ws + WS_W + (size_t)layer * SZ_WL))
        const pg8::bf16_t* XB = WSB(const pg8::bf16_t, A_XB);
        if (GROUP_STAGGER && layer == 1) wait_weights(F);
        { const unsigned char* WB = WL + OFF_WIN;
          { pg8::Gemm g{XB, (const pg8::bf16_t*)(WB + WIN_16A), MB, 10240, D}; GroupOrder S; S.init(40, F.gb, 0);
            pg8::EpiConvIn E{WSB(pg8::bf16_t, A_HB), LDH, WSB(pg8::bf16_t, A_YC), WSB(float, A_HALOC), INP(3) + (size_t)layer * 3 * BW, F.lds + RING_BYTES + 4096};
            pg8::gemm_phase<pg8::EpiConvIn, GroupOrder, PG8_ALIGN, PG8_SP2>(ring, g, S, E, F.wv); }
          { pg8::Gemm g{WSB(const pg8::bf16_t, A_XB8), (const pg8::bf16_t*)(WB + WIN_8A), MB, N8A, D / 2}; GroupOrder S; S.init(64, F.gb, 0);
            pg8::EpiF8 E{WSB(pg8::bf16_t, A_HB), LDH, WSB(pg8::bf16_t, A_GATES), INP(2) + (size_t)layer * 3 * D, 0.015625f};
            pg8::gemm_phase<pg8::EpiF8, GroupOrder, PG8_ALIGN, PG8_SP2, true>(ring, g, S, E, F.wv); }
          { pg8::Gemm g{(const pg8::bf16_t*)(WB + WIN_16V), XB, N16V, MB, D}; GroupOrder S; S.init(16, F.gb, 1);
            pg8::EpiBf16 E{WSB(pg8::bf16_t, A_VT) + (size_t)2048 * MB, MB, 1.f};
            pg8::gemm_phase<pg8::EpiBf16, GroupOrder, PG8_ALIGN, PG8_SP2>(ring, g, S, E, F.wv); }
          { pg8::Gemm g{(const pg8::bf16_t*)(WB + WIN_8V), WSB(const pg8::bf16_t, A_XB8), N8V, MB, D / 2}; GroupOrder S; S.init(16, F.gb, 1);
            pg8::EpiBf16 E{WSB(pg8::bf16_t, A_VT), MB, 0.015625f};
            pg8::gemm_phase<pg8::EpiBf16, GroupOrder, PG8_ALIGN, PG8_SP2, true>(ring, g, S, E, F.wv); } }
        SEAM();
        conv_fix_phase(F, layer); gla_prep_phase(F, layer); na_phase(F, layer); SEAM();
        gla_scan_phase(F); SEAM();
        gla_combine_phase(F, layer); SEAM();
        if (GROUP_STAGGER && layer == 0) wait_weights(F);
        { GroupOrder S; S.init(16, F.gb, 0);
          { pg8::Gemm g{WSB(const pg8::bf16_t, A_YC), (const pg8::bf16_t*)(WL + OFF_WBR), MB, D, BW};
            pg8::EpiBranch<0> E{WSB(pg8::bf16_t, A_MIXED), WSB(const pg8::bf16_t, A_GATES), 1.f}; pg8::gemm_phase<pg8::EpiBranch<0>, GroupOrder, PG8_ALIGN, PG8_SP2>(ring, g, S, E, F.wv); }
          { pg8::Gemm g{WSB(const pg8::bf16_t, A_YN), (const pg8::bf16_t*)(WL + OFF_WBR) + (size_t)D * BW, MB, D, BW / 2};
            pg8::EpiBranch<1> E{WSB(pg8::bf16_t, A_MIXED), WSB(const pg8::bf16_t, A_GATES), 1.f / 1024.f}; pg8::gemm_phase<pg8::EpiBranch<1>, GroupOrder, PG8_ALIGN, PG8_SP2, true>(ring, g, S, E, F.wv); }
          { pg8::Gemm g{WSB(const pg8::bf16_t, A_YG), (const pg8::bf16_t*)(WL + OFF_WBR) + (size_t)2 * D * BW, MB, D, BW};
            pg8::EpiBranch<2> E{WSB(pg8::bf16_t, A_MIXED), WSB(const pg8::bf16_t, A_GATES), 1.f}; pg8::gemm_phase<pg8::EpiBranch<2>, GroupOrder, PG8_ALIGN, PG8_SP2>(ring, g, S, E, F.wv); } }
        SEAM();
        { pg8::Gemm g{WSB(const pg8::bf16_t, A_MIXED), (const pg8::bf16_t*)(WL + OFF_WO), MB, D, D}; GroupOrder S; S.init(16, F.gb, 0);
          if (layer == 0) { pg8::EpiResid<false> E{WSB(float, A_XR), INP(0) + (size_t)F.grp * MB * D, D, ALPHA, 0, 0, 0u, 0ull}; pg8::gemm_phase<pg8::EpiResid<false>, GroupOrder, PG8_ALIGN, PG8_SP2>(ring, g, S, E, F.wv); }
          else { pg8::EpiResid<true> E{WSB(float, A_XR), WSB(const float, A_XR), D, ALPHA, 16, 17, (unsigned)((layer - 1) * D), (unsigned long long)(WS_ARENA + (size_t)F.grp * ARENA + A_ST)};
                 pg8::gemm_phase<pg8::EpiResid<true>, GroupOrder, PG8_ALIGN, PG8_SP2>(ring, g, S, E, F.wv); } }
        SEAM();
#ifndef REP_LN
#define REP_LN 1
#endif
        for (int rep_ = 0; rep_ < REP_LN; ++rep_) ln_phase(F, WSB(const float, A_XR), INP(10) + (size_t)layer * D, INP(11) + (size_t)layer * D, nullptr, WSB(bf16, A_XB), nullptr, WSB(float, A_ST)); SEAM();
        { pg8::Gemm g{XB, (const pg8::bf16_t*)(WL + OFF_WFI), MB, 2 * FF, D}; GroupOrder S; S.init(86, F.gb, 0);
          pg8::EpiGlu E{WSB(pg8::bf16_t, A_G), WSB(float, A_HALO), INP(13) + (size_t)layer * 3 * FF, INP(14) + (size_t)layer * FF, F.lds + RING_BYTES};
          pg8::gemm_phase<pg8::EpiGlu, GroupOrder, PG8_ALIGN, PG8_SP2>(ring, g, S, E, F.wv); }
        SEAM();
        convglu_fix_phase(F, layer); SEAM();
        { pg8::Gemm g{WSB(const pg8::bf16_t, A_G), (const pg8::bf16_t*)(WL + OFF_WFO), MB, D, FF}; GroupOrder S; S.init(16, F.gb, 0);
          pg8::EpiResid<true> E{WSB(float, A_XR), WSB(const float, A_XR), D, ALPHA, 10, 11, (unsigned)(layer * D), (unsigned long long)(WS_ARENA + (size_t)F.grp * ARENA + A_ST)};
          pg8::gemm_phase<pg8::EpiResid<true>, GroupOrder, PG8_ALIGN, PG8_SP2>(ring, g, S, E, F.wv); }
        SEAM();
        if (layer == DEPTH - 1) ln_phase(F, WSB(const float, A_XR), INP(16) + (size_t)layer * D, INP(17) + (size_t)layer * D, OUTP + (size_t)F.grp * MB * D, nullptr, nullptr, nullptr);
        else { ln_phase(F, WSB(const float, A_XR), INP(16) + (size_t)layer * D, INP(17) + (size_t)layer * D, nullptr, WSB(bf16, A_XB), WSB(bf16, A_XB8), WSB(float, A_ST)); SEAM(); }
    }
#undef SEAM
#undef GRID_BAR
}

extern "C" void kernel_launch(void* const* d_in, const int* in_sizes, int n_in, void* d_out, int out_size, void* d_ws, size_t ws_size, hipStream_t stream) {
    static int grid = 0;
    if (grid == 0) {
        if (n_in != 18 || in_sizes[0] != M * D || out_size != M * D || ws_size < WS_END) { fprintf(stderr, "kernel_launch: unexpected sizes: n_in %d in0 %d out %d ws %zu (need %zu); nothing launched\n", n_in, n_in > 0 ? in_sizes[0] : -1, out_size, ws_size, (size_t)WS_END); grid = -1; return; }
        int dev = 0, cus = 0, per_cu = 0;
        if (hipGetDevice(&dev) != hipSuccess || hipDeviceGetAttribute(&cus, hipDeviceAttributeMultiprocessorCount, dev) != hipSuccess) { grid = -1; return; }
        if (hipFuncSetAttribute((const void*)enc_fwd, hipFuncAttributeMaxDynamicSharedMemorySize, LDS_BYTES) != hipSuccess) { fprintf(stderr, "kernel_launch: hipFuncSetAttribute failed\n"); grid = -1; return; }
        if (hipOccupancyMaxActiveBlocksPerMultiprocessor(&per_cu, (const void*)enc_fwd, NWAVES * 64, LDS_BYTES) != hipSuccess || per_cu < 1) { fprintf(stderr, "kernel_launch: occupancy query reports %d workgroups per CU\n", per_cu); grid = -1; (void)hipGetLastError(); return; }
        (void)hipGetLastError();
        grid = cus;
        if (grid != 256) { fprintf(stderr, "kernel_launch: built for a 256-CU device (4 groups of 64 workgroups), found %d CUs; nothing launched\n", cus); grid = -1; return; }
    }
    if (grid < 0) return;
    if (hipMemsetAsync((char*)d_ws + WS_CTL, 0, CTL_ZERO_BYTES, stream) != hipSuccess) return;
    Args a{};
    for (int i = 0; i < 18; ++i) a.in[i] = (GAS const float*)d_in[i];
    a.out = (GAS float*)d_out; a.ws = (GAS unsigned char*)d_ws;
    a.ph_lo = 0; a.ph_hi = N_PHASES;
    hipLaunchKernelGGL(enc_fwd, dim3(grid), dim3(NWAVES * 64), LDS_BYTES, stream, a);
}
```
